# Optimizing an MI355X kernel written in HIP

```python
import math
import jax, jax.numpy as jnp
from jax import lax
import numpy as np

D_MODEL = 1024
BATCH = 16
SEQ = 4096
DEPTH = 1

CHUNK = 64
Q_BLOCK = 128
MAX_STREAM_OFFSET = 65536

LRU_WIDTH = D_MODEL
LRU_BLOCKS = 8
CONV_WIDTH = 4
LRU_C = 8.0

ATTN_HEADS = 8
ATTN_HEAD_DIM = D_MODEL // (2 * ATTN_HEADS)
ATTN_V_DIM = 2 * ATTN_HEAD_DIM
ATTN_QK_WIDTH = ATTN_HEADS * 2 * ATTN_HEAD_DIM
ATTN_WIDTH = ATTN_HEADS * ATTN_V_DIM
ROPE_THETA = 500000.0
ROT_DIMS = ATTN_HEAD_DIM // 4

MEM_TOKENS = 256
MEM_HEADS = 4
MEM_HEAD_DIM = 128
MEM_WIDTH = MEM_HEADS * MEM_HEAD_DIM

N_GROUPS = 4
EXPERTS_PER_GROUP = 8
N_EXPERTS = N_GROUPS * EXPERTS_PER_GROUP
TOP_K = 2
EXPERT_FF = 512
EXPERT_BLOCK = 128

IN_WIDTHS = (LRU_WIDTH, LRU_WIDTH, ATTN_QK_WIDTH, ATTN_QK_WIDTH, ATTN_WIDTH, D_MODEL, D_MODEL)
EPS = 1e-6
NEG_INF = -1e30

kernel_name = "hybrid_rglru_diffattn_hiermoe_block"


def rms_norm(x, g):
    xf = x.astype(jnp.float32)
    y = xf * lax.rsqrt(jnp.mean(xf * xf, axis=-1, keepdims=True) + EPS)
    return (y * g.astype(jnp.float32)).astype(x.dtype)


def rotary_tables(positions):
    half = ROT_DIMS // 2
    inv_freq = jnp.exp(-math.log(ROPE_THETA) * jnp.arange(half, dtype=jnp.float32) / half)
    ang = positions.astype(jnp.float32)[..., None] * inv_freq
    return jnp.cos(ang)[:, :, None, None, :], jnp.sin(ang)[:, :, None, None, :]


def rope_partial(x, cos, sin):
    half = ROT_DIMS // 2
    xr = x[..., :ROT_DIMS].astype(jnp.float32)
    x1, x2 = xr[..., :half], xr[..., half:]
    rot = jnp.concatenate([x1 * cos - x2 * sin, x2 * cos + x1 * sin], axis=-1)
    return jnp.concatenate([rot.astype(x.dtype), x[..., ROT_DIMS:]], axis=-1)


def causal_depthwise_conv(x, w, b):
    k = w.shape[0]
    y = lax.conv_general_dilated(x, w[:, None, :].astype(x.dtype), window_strides=(1,),
                                 padding=((k - 1, 0),), dimension_numbers=('NWC', 'WIO', 'NWC'),
                                 feature_group_count=x.shape[-1])
    return y + b


def block_diag_linear(x, w, b):
    bsz, s, c = x.shape
    nb, bw, _ = w.shape
    y = jnp.einsum('bsnc,ncd->bsnd', x.reshape(bsz, s, nb, bw), w).reshape(bsz, s, c)
    return y + b


def rg_lru(x, wa, ba, wx, bx, lam):
    r = jax.nn.sigmoid(block_diag_linear(x, wa, ba).astype(jnp.float32))
    i = jax.nn.sigmoid(block_diag_linear(x, wx, bx).astype(jnp.float32))
    log_a = -LRU_C * r * jax.nn.softplus(-lam.astype(jnp.float32))
    a = jnp.exp(log_a)
    b = jnp.sqrt(-jnp.expm1(2.0 * log_a)) * i * x.astype(jnp.float32)

    def combine(left, right):
        a_l, b_l = left
        a_r, b_r = right
        return a_l * a_r, a_r * b_l + b_r

    _, h = lax.associative_scan(combine, (a, b), axis=1)
    return h.astype(x.dtype)


def diff_attention(q, k, v, cos, sin, q_norm, k_norm, lam, lambda_init, subln):
    bsz, s, _ = q.shape
    q = q.reshape(bsz, s, ATTN_HEADS, 2, ATTN_HEAD_DIM)
    k = k.reshape(bsz, s, ATTN_HEADS, 2, ATTN_HEAD_DIM)
    v = v.reshape(bsz, s, ATTN_HEADS, ATTN_V_DIM)
    q = rope_partial(rms_norm(q, q_norm), cos, sin) * (ATTN_HEAD_DIM ** -0.5)
    k = rope_partial(rms_norm(k, k_norm), cos, sin)
    outs = []
    for blk in range(s // Q_BLOCK):
        q0, q1 = blk * Q_BLOCK, (blk + 1) * Q_BLOCK
        sc = jnp.einsum('bqhmd,bkhmd->bhmqk', q[:, q0:q1], k[:, :q1]).astype(jnp.float32)
        mask = (jnp.arange(q1) // CHUNK)[None, :] <= (jnp.arange(q0, q1) // CHUNK)[:, None]
        p = jax.nn.softmax(jnp.where(mask, sc, NEG_INF), axis=-1)
        w = p[:, :, 0] - lam * p[:, :, 1]
        outs.append(jnp.einsum('bhqk,bkhd->bqhd', w.astype(v.dtype), v[:, :q1]))
    o = jnp.concatenate(outs, axis=1)
    o = rms_norm(o, subln) * (1.0 - lambda_init)
    return o.reshape(bsz, s, ATTN_WIDTH)


def memory_cross_attention(x, mem, norm_cx, norm_mem, w_cq, w_ckv, cq_norm, ck_norm, w_co):
    bsz, s, _ = x.shape
    m = mem.shape[1]
    q = (rms_norm(x, norm_cx) @ w_cq).reshape(bsz, s, MEM_HEADS, MEM_HEAD_DIM)
    kv = rms_norm(mem, norm_mem) @ w_ckv
    k = kv[..., :MEM_WIDTH].reshape(bsz, m, MEM_HEADS, MEM_HEAD_DIM)
    v = kv[..., MEM_WIDTH:].reshape(bsz, m, MEM_HEADS, MEM_HEAD_DIM)
    q = rms_norm(q, cq_norm) * (MEM_HEAD_DIM ** -0.5)
    k = rms_norm(k, ck_norm)
    p = jax.nn.softmax(jnp.einsum('bqhd,bkhd->bhqk', q, k).astype(jnp.float32), axis=-1)
    o = jnp.einsum('bhqk,bkhd->bqhd', p.astype(v.dtype), v).reshape(bsz, s, MEM_WIDTH)
    return o @ w_co


def hierarchical_moe(h, w_group, b_group, w_router, b_router, w_gate_up, w_down):
    bsz, s, d = h.shape
    n = bsz * s
    a_tot = n * TOP_K
    hf = h.reshape(n, d)
    gp = jax.nn.softmax((hf @ w_group).astype(jnp.float32) + b_group.astype(jnp.float32), axis=-1)
    gval, gidx = lax.top_k(gp, 1)
    el = ((hf @ w_router).astype(jnp.float32) + b_router.astype(jnp.float32))
    el = el.reshape(n, N_GROUPS, EXPERTS_PER_GROUP)
    el = jnp.take_along_axis(el, gidx[:, :, None], axis=1)[:, 0]
    ev, eidx = lax.top_k(el, TOP_K)
    ew = jax.nn.softmax(ev, axis=-1) * gval
    expert_id = (gidx * EXPERTS_PER_GROUP + eidx).reshape(-1)
    token_id = jnp.repeat(jnp.arange(n, dtype=jnp.int32), TOP_K)
    weight = ew.reshape(-1)
    order = jnp.argsort(expert_id)
    sorted_e = expert_id[order]
    counts = jnp.bincount(expert_id, length=N_EXPERTS)
    padded = (counts + EXPERT_BLOCK - 1) // EXPERT_BLOCK * EXPERT_BLOCK
    start = jnp.cumsum(counts) - counts
    pend = jnp.cumsum(padded)
    pstart = pend - padded
    dest = pstart[sorted_e] + jnp.arange(a_tot) - start[sorted_e]
    p_rows = a_tot + N_EXPERTS * EXPERT_BLOCK
    n_blk = p_rows // EXPERT_BLOCK
    buf_tok = jnp.full((p_rows,), n, jnp.int32).at[dest].set(token_id[order])
    buf_w = jnp.zeros((p_rows,), jnp.float32).at[dest].set(weight[order])
    blk_e = jnp.minimum(jnp.searchsorted(pend, jnp.arange(n_blk) * EXPERT_BLOCK, side='right'),
                        N_EXPERTS - 1)
    h_pad = jnp.concatenate([hf, jnp.zeros((1, d), hf.dtype)], axis=0)
    xs = h_pad[buf_tok].reshape(n_blk, EXPERT_BLOCK, d)

    def expert_block(args):
        xb, e = args
        gu = xb @ w_gate_up[e]
        return (jax.nn.silu(gu[:, :EXPERT_FF]) * gu[:, EXPERT_FF:]) @ w_down[e]

    ys = lax.map(expert_block, (xs, blk_e)).reshape(p_rows, d)
    out = jnp.zeros((n + 1, d), ys.dtype).at[buf_tok].add(ys * buf_w[:, None].astype(ys.dtype))
    return out[:n].reshape(bsz, s, d)


def setup_inputs(seed: int = 0) -> dict:
    key = jax.random.key(seed)
    keys = iter(jax.random.split(key, 48))

    def normal(shape, scale):
        return jax.random.normal(next(keys), shape, jnp.float32) * scale

    def gain(n):
        return 1.0 + normal((DEPTH, n), 0.02)

    bw = LRU_WIDTH // LRU_BLOCKS
    u = jax.random.uniform(next(keys), (DEPTH, LRU_WIDTH), jnp.float32, 0.9, 0.999)
    p = u ** (1.0 / LRU_C)
    lru_lambda = jnp.log(p) - jnp.log1p(-p)
    offset = jax.random.randint(next(keys), (BATCH, 1), 0, MAX_STREAM_OFFSET, jnp.int32)
    positions = offset + jnp.arange(SEQ, dtype=jnp.int32)[None, :]
    return {
        "x": normal((BATCH, SEQ, D_MODEL), 1.0),
        "mem": normal((BATCH, MEM_TOKENS, D_MODEL), 1.0),
        "positions": positions,
        "norm_mix": gain(D_MODEL),
        "w_in": normal((DEPTH, D_MODEL, sum(IN_WIDTHS)), D_MODEL ** -0.5),
        "conv_w": normal((DEPTH, CONV_WIDTH, LRU_WIDTH), CONV_WIDTH ** -0.5),
        "conv_b": normal((DEPTH, LRU_WIDTH), 0.01),
        "lru_wa": normal((DEPTH, LRU_BLOCKS, bw, bw), bw ** -0.5),
        "lru_ba": normal((DEPTH, LRU_WIDTH), 0.01),
        "lru_wx": normal((DEPTH, LRU_BLOCKS, bw, bw), bw ** -0.5),
        "lru_bx": normal((DEPTH, LRU_WIDTH), 0.01),
        "lru_lambda": lru_lambda,
        "w_lru_o": normal((DEPTH, LRU_WIDTH, D_MODEL), LRU_WIDTH ** -0.5),
        "q_norm": gain(ATTN_HEAD_DIM),
        "k_norm": gain(ATTN_HEAD_DIM),
        "lambda_q1": normal((DEPTH, ATTN_HEAD_DIM), 0.1),
        "lambda_k1": normal((DEPTH, ATTN_HEAD_DIM), 0.1),
        "lambda_q2": normal((DEPTH, ATTN_HEAD_DIM), 0.1),
        "lambda_k2": normal((DEPTH, ATTN_HEAD_DIM), 0.1),
        "subln": gain(ATTN_V_DIM),
        "w_attn_o": normal((DEPTH, ATTN_WIDTH, D_MODEL), ATTN_WIDTH ** -0.5),
        "w_out": normal((DEPTH, D_MODEL, D_MODEL), D_MODEL ** -0.5),
        "norm_cx": gain(D_MODEL),
        "norm_mem": gain(D_MODEL),
        "w_cq": normal((DEPTH, D_MODEL, MEM_WIDTH), D_MODEL ** -0.5),
        "w_ckv": normal((DEPTH, D_MODEL, 2 * MEM_WIDTH), D_MODEL ** -0.5),
        "cq_norm": gain(MEM_HEAD_DIM),
        "ck_norm": gain(MEM_HEAD_DIM),
        "w_co": normal((DEPTH, MEM_WIDTH, D_MODEL), MEM_WIDTH ** -0.5),
        "norm_ffn": gain(D_MODEL),
        "w_group": normal((DEPTH, D_MODEL, N_GROUPS), D_MODEL ** -0.5),
        "b_group": normal((DEPTH, N_GROUPS), 0.01),
        "w_router": normal((DEPTH, D_MODEL, N_EXPERTS), D_MODEL ** -0.5),
        "b_router": normal((DEPTH, N_EXPERTS), 0.01),
        "w_gate_up": normal((DEPTH, N_EXPERTS, D_MODEL, 2 * EXPERT_FF), D_MODEL ** -0.5),
        "w_down": normal((DEPTH, N_EXPERTS, EXPERT_FF, D_MODEL), EXPERT_FF ** -0.5),
    }


def reference(x, mem, positions, norm_mix, w_in, conv_w, conv_b, lru_wa, lru_ba, lru_wx, lru_bx,
              lru_lambda, w_lru_o, q_norm, k_norm, lambda_q1, lambda_k1, lambda_q2, lambda_k2,
              subln, w_attn_o, w_out, norm_cx, norm_mem, w_cq, w_ckv, cq_norm, ck_norm, w_co,
              norm_ffn, w_group, b_group, w_router, b_router, w_gate_up, w_down):
    cos, sin = rotary_tables(positions)
    splits = np.cumsum(IN_WIDTHS)[:-1].tolist()
    for layer in range(DEPTH):
        lambda_init = 0.8 - 0.6 * math.exp(-0.3 * layer)
        h = rms_norm(x, norm_mix[layer])
        proj = h @ w_in[layer]
        lru_in, lru_gate, q, k, v, g_lru, g_attn = jnp.split(proj, splits, axis=-1)
        xc = causal_depthwise_conv(lru_in, conv_w[layer], conv_b[layer])
        hr = rg_lru(xc, lru_wa[layer], lru_ba[layer], lru_wx[layer], lru_bx[layer], lru_lambda[layer])
        y_lru = (jax.nn.gelu(lru_gate) * hr) @ w_lru_o[layer]
        lam = (jnp.exp(jnp.sum(lambda_q1[layer].astype(jnp.float32) * lambda_k1[layer].astype(jnp.float32)))
               - jnp.exp(jnp.sum(lambda_q2[layer].astype(jnp.float32) * lambda_k2[layer].astype(jnp.float32)))
               + lambda_init)
        o_attn = diff_attention(q, k, v, cos, sin, q_norm[layer], k_norm[layer], lam, lambda_init,
                                subln[layer])
        y_attn = o_attn @ w_attn_o[layer]
        mixed = jax.nn.sigmoid(g_lru) * y_lru + jax.nn.sigmoid(g_attn) * y_attn
        x = x + mixed @ w_out[layer]
        x = x + memory_cross_attention(x, mem, norm_cx[layer], norm_mem[layer], w_cq[layer],
                                       w_ckv[layer], cq_norm[layer], ck_norm[layer], w_co[layer])
        x = x + hierarchical_moe(rms_norm(x, norm_ffn[layer]), w_group[layer], b_group[layer],
                                 w_router[layer], b_router[layer], w_gate_up[layer], w_down[layer])
    return x
```

```cpp
#include <hip/hip_runtime.h>
#include <cstdio>
#include <cstdint>
#include <cmath>

#define GAS __attribute__((address_space(1)))
#define LAS __attribute__((address_space(3)))
typedef unsigned short bf16;
typedef short bf16x8 __attribute__((ext_vector_type(8)));
typedef short s16x4 __attribute__((ext_vector_type(4)));
typedef float f32x2 __attribute__((ext_vector_type(2)));
typedef float f32x4 __attribute__((ext_vector_type(4)));
typedef float f32x16 __attribute__((ext_vector_type(16)));
typedef unsigned u32x2 __attribute__((ext_vector_type(2)));
typedef unsigned u32x4 __attribute__((ext_vector_type(4)));

constexpr int NB = 16, SEQ = 4096, DM = 1024, MTOK = NB * SEQ;
constexpr int NWIN = 7168;
constexpr int MEMTOK = 256, MEMROWS = NB * MEMTOK;
constexpr int NEXP = 32, EFF = 512;
constexpr float EPS = 1e-6f;
constexpr float LOG2E = 1.4426950408889634f;
constexpr int NWAVES = 8;

constexpr size_t MiB = 1u << 20;
constexpr size_t WS_CTL = 0, CTL_ZERO_BYTES = 1 * MiB;
constexpr size_t WS_WIN = 2 * MiB;
constexpr size_t WS_WLRUO = 16 * MiB, WS_WATTNO = 18 * MiB, WS_WOUT = 20 * MiB;
constexpr size_t WS_WCQ = 22 * MiB;
constexpr size_t WS_WCKV = 23 * MiB;
constexpr size_t WS_WCO = 25 * MiB;
constexpr size_t WS_WRT = 26 * MiB;
constexpr size_t WS_WLRU = 26 * MiB + 512 * 1024;
constexpr size_t WS_WGU = 27 * MiB;
constexpr size_t WS_WDN = 91 * MiB;
constexpr size_t WS_S0 = 128 * MiB, WS_S1 = 256 * MiB, WS_S2 = 384 * MiB, WS_S3 = 512 * MiB, WS_S4 = 640 * MiB;
constexpr size_t WS_MEMN = 768 * MiB;
constexpr size_t WS_KVC = 776 * MiB;
constexpr size_t WS_QC = 784 * MiB;
constexpr size_t WS_OC = 848 * MiB;
constexpr size_t WS_IDX = 912 * MiB;
constexpr size_t WS_WTS = 928 * MiB;
constexpr size_t WS_RSS1 = 929 * MiB;
constexpr size_t WS_RSS2 = 933 * MiB;
constexpr size_t WS_RSTD2 = 937 * MiB;
constexpr size_t WS_XS = 937 * MiB + 256 * 1024;
constexpr size_t WS_WSC = 937 * MiB + 512 * 1024;
constexpr size_t WS_LOGIT = 938 * MiB;
constexpr size_t WS_ROPE = 954 * MiB;
constexpr size_t WS_XS2 = 958 * MiB + 512 * 1024;
constexpr size_t WS_WSC2 = 958 * MiB + 768 * 1024;
constexpr size_t WS_ASG = 958 * MiB;
constexpr size_t WS_END = 959 * MiB;
constexpr size_t WS_XN = WS_S0, WS_MIX = WS_S0, WS_LIN = WS_S1, WS_Q = WS_S1, WS_X2B = WS_S1, WS_GG = WS_S2, WS_K = WS_S2, WS_SGL = WS_S2,
                 WS_H = WS_S2, WS_V = WS_S3, WS_SGA = WS_S3, WS_U = WS_S4, WS_X1B = WS_S4;
constexpr size_t WS_X2Q = WS_S0;
constexpr size_t WS_SG8 = WS_QC;
constexpr size_t SLOT_ELEMS = (WS_S2 - WS_S1) / 2;
constexpr int CW_CNT = 1024;
constexpr int CW_WMAX2 = 139264;
constexpr int CW_WMAX = 131072;
constexpr int CW_BAR = 4096;
constexpr int MAX_LAUNCHES = 24;

constexpr int RING_BYTES = 131072;
constexpr int MISC_OFF = RING_BYTES;
constexpr int LDS_BYTES = 147456;

__device__ __forceinline__ unsigned cvt_pk_bf16(float lo, float hi) { unsigned r; asm volatile("v_cvt_pk_bf16_f32 %0, %1, %2" : "=v"(r) : "v"(lo), "v"(hi)); return r; }
__device__ __forceinline__ float bflo(unsigned w) { return __uint_as_float(w << 16); }
__device__ __forceinline__ float bfhi(unsigned w) { return __uint_as_float(w & 0xffff0000u); }
__device__ __forceinline__ float bf2f(bf16 h) { return __uint_as_float((unsigned)h << 16); }
__device__ __forceinline__ float fast_exp2(float x) { return __builtin_amdgcn_exp2f(x); }
__device__ __forceinline__ float fast_rcp(float x) { return __builtin_amdgcn_rcpf(x); }
__device__ __forceinline__ float sigmoid_f(float v) { return fast_rcp(1.0f + fast_exp2(-LOG2E * v)); }
__device__ __forceinline__ float gelu_tanh_f(float v) { const float u = v + 0.044715f * v * v * v; return v * fast_rcp(1.0f + fast_exp2(-2.0f * 0.7978845608028654f * LOG2E * u)); }
__device__ __forceinline__ float wave_sum(float v) {
#pragma unroll
    for (int o = 1; o < 64; o <<= 1) v += __shfl_xor(v, o);
    return v;
}
__device__ __forceinline__ float wave_max(float v) {
#pragma unroll
    for (int o = 1; o < 64; o <<= 1) v = fmaxf(v, __shfl_xor(v, o));
    return v;
}
#define LDS_WAIT() asm volatile("s_waitcnt lgkmcnt(0)" ::: "memory")
#define KEEP_AB(r, a, b) asm volatile("" : "+v"(r) : "v"(a), "v"(b))
#define VM_WAIT() asm volatile("s_waitcnt vmcnt(0)" ::: "memory")

namespace pg8 {
constexpr int BM = 256, BK = 64, HALF = 128, HTB = HALF * BK * 2, STAGE_BYTES = 8 * HTB;
__host__ __device__ __forceinline__ int lds_byte(int r, int c) { const int st = (r >> 4) * 2 + (c >> 5), rr = r & 15, cc = c & 31, ob = rr * 64 + cc * 2; return st * 1024 + (ob ^ (((ob >> 9) & 1) << 5)); }
__host__ __device__ __forceinline__ void stage_rc(int b, int& R, int& C) { const int st = b / 1024, sb = b % 1024, swz = sb ^ (((sb >> 9) & 1) << 5); R = (st >> 1) * 16 + swz / 64; C = (st & 1) * 32 + (swz % 64) / 2; }
__host__ __device__ __forceinline__ int perm32(int rho) { const int n = rho >> 4, i = rho & 15; return 8 * (i >> 2) + 4 * n + (i & 3); }

struct Unit { int pm, pn, aux, nvalid, crow0; const char* a; const char* b; const int* rows; };

typedef int v4i32 __attribute__((ext_vector_type(4)));
template <class Epi, class Sched, bool ALIGN_EPI, bool GATHER, bool I8 = false, bool PAIRACC = false>
__device__ __forceinline__ void gemm_phase(LAS unsigned char* lds, const int K, const Sched& S, const Epi& E) {
    const int tid = threadIdx.x, wid = __builtin_amdgcn_readfirstlane(tid >> 6), lane = tid & 63, wr = wid >> 2, wc = wid & 3, fr = lane & 15, fq = lane >> 4;
    const int nt = K / BK;
    unsigned voffA[2][2], nvoffA[2][2], voffB[2]; int RA[2], CA[2];
#pragma unroll
    for (int i = 0; i < 2; ++i) { int R, C; stage_rc(tid * 16 + i * 8192, R, C); const int Rb = Epi::PERM ? ((R & ~31) + perm32(R & 31)) : R;
        RA[i] = R; CA[i] = C; voffB[i] = (unsigned)(Rb * K + C) * 2u;
#pragma unroll
        for (int h = 0; h < 2; ++h) { voffA[h][i] = (unsigned)((R + HALF * h) * K + C) * 2u; nvoffA[h][i] = voffA[h][i]; } }
    const size_t kstep = (size_t)(BK * 2);
    const size_t hstep = (size_t)HALF * K * 2;
    const unsigned ldsw = (unsigned)wid * 1024u;
    const int aoff = lds_byte(wr * 64 + fr, fq * 8), boff = lds_byte(wc * 32 + fr, fq * 8);
#define PG8_SA(b, h) (((b) * 2 + (h)) * HTB)
#define PG8_SB(b, h) ((4 + (b) * 2 + (h)) * HTB)
#define PG8_STAGE_B(bufoff, gbase) do { _Pragma("unroll") for (int _i = 0; _i < 2; ++_i) \
        __builtin_amdgcn_global_load_lds((const unsigned*)((const char*)(gbase) + voffB[_i]), (LAS unsigned*)(lds + (bufoff) + ldsw + _i * 8192), 16, 0, 0); } while (0)
#define PG8_STAGE_A(bufoff, gbase, h, NX) do { _Pragma("unroll") for (int _i = 0; _i < 2; ++_i) { const unsigned _o = (GATHER && (NX)) ? nvoffA[h][_i] : voffA[h][_i]; \
        __builtin_amdgcn_global_load_lds((const unsigned*)((const char*)(gbase) + _o), (LAS unsigned*)(lds + (bufoff) + ldsw + _i * 8192), 16, 0, 0); } } while (0)
#define PG8_LDA(dst, b, h) do { _Pragma("unroll") for (int m = 0; m < 4; ++m) _Pragma("unroll") for (int k = 0; k < 2; ++k) dst[m][k] = *(const LAS bf16x8*)(lds + PG8_SA(b, h) + aoff + m * 2048 + k * 1024); } while (0)
#define PG8_LDB(dst, b, h) do { _Pragma("unroll") for (int n = 0; n < 2; ++n) _Pragma("unroll") for (int k = 0; k < 2; ++k) dst[n][k] = *(const LAS bf16x8*)(lds + PG8_SB(b, h) + boff + n * 2048 + k * 1024); } while (0)
#define PG8_MMA(ai, bj, At, Bt) do { __builtin_amdgcn_s_setprio(1); _Pragma("unroll") for (int m = 0; m < 4; ++m) _Pragma("unroll") for (int n = 0; n < 2; ++n) _Pragma("unroll") for (int k = 0; k < 2; ++k) \
        { if constexpr (I8) acc[ai][bj][m][n] = __builtin_bit_cast(f32x4, __builtin_amdgcn_mfma_i32_16x16x64_i8(__builtin_bit_cast(v4i32, Bt[n][k]), __builtin_bit_cast(v4i32, At[m][k]), __builtin_bit_cast(v4i32, acc[ai][bj][m][n]), 0, 0, 0)); \
          else acc[ai][bj][m][n] = __builtin_amdgcn_mfma_f32_16x16x32_bf16(Bt[n][k], At[m][k], acc[ai][bj][m][n], 0, 0, 0); } __builtin_amdgcn_s_setprio(0); } while (0)
#define PG8_WAIT_V(n) asm volatile("s_waitcnt vmcnt(" #n ")" ::: "memory")
#define PG8_WAIT_L(n) asm volatile("s_waitcnt lgkmcnt(" #n ")" ::: "memory")
#define PG8_BAR __builtin_amdgcn_s_barrier()
#define PG8_SCHED __builtin_amdgcn_sched_barrier(0)
#define PG8_GATHER_OFFS(dst, u) do { _Pragma("unroll") for (int _i = 0; _i < 2; ++_i) _Pragma("unroll") for (int _h = 0; _h < 2; ++_h) { const int _r = RA[_i] + HALF * _h; \
        const int _tok = (_r < (u).nvalid) ? (u).rows[_r] : 0; dst[_h][_i] = (unsigned)(_tok * K + CA[_i]) * 2u; } } while (0)
    Unit cur, nxt; int ui = 0;
    if (!S.next(0, cur)) return;
    if constexpr (GATHER) { PG8_GATHER_OFFS(voffA, cur); }
    f32x4 acc[2][2][4][2];
#pragma unroll
    for (int a = 0; a < 2; ++a)
#pragma unroll
        for (int b = 0; b < 2; ++b)
#pragma unroll
            for (int m = 0; m < 4; ++m)
#pragma unroll
                for (int n = 0; n < 2; ++n) acc[a][b][m][n] = (f32x4){0.f, 0.f, 0.f, 0.f};
    bf16x8 At[4][2], B0[2][2], B1[2][2];
    const char* cA = cur.a; const char* cB = cur.b;
    PG8_STAGE_B(PG8_SB(0, 0), cB); PG8_STAGE_B(PG8_SB(0, 1), cB + hstep); PG8_STAGE_A(PG8_SA(0, 0), cA, 0, false); PG8_STAGE_A(PG8_SA(0, 1), cA, 1, false);
    if (wr == 1) PG8_BAR;
    PG8_WAIT_V(2); PG8_BAR;
    PG8_STAGE_B(PG8_SB(1, 0), cB + kstep); PG8_STAGE_A(PG8_SA(1, 0), cA + kstep, 0, false); PG8_STAGE_B(PG8_SB(1, 1), cB + hstep + kstep);
    PG8_WAIT_V(6); PG8_BAR;
    for (;;) {
        const bool has_next = S.next(ui + 1, nxt);
        if constexpr (GATHER) { if (has_next) { PG8_GATHER_OFFS(nvoffA, nxt); } else {
#pragma unroll
            for (int h = 0; h < 2; ++h)
#pragma unroll
                for (int i = 0; i < 2; ++i) nvoffA[h][i] = voffA[h][i]; } }
        const char* nA = has_next ? nxt.a : cA; const char* nB = has_next ? nxt.b : cB;
        for (int t = 0; t < nt; t += 2) {
            const bool last = (t == nt - 2);
            const char* a1 = cA + (size_t)(t + 1) * kstep;
            const char* a2 = last ? nA : cA + (size_t)(t + 2) * kstep; const char* b2 = last ? nB : cB + (size_t)(t + 2) * kstep;
            const char* a3 = a2 + kstep; const char* b3 = b2 + kstep;
            PG8_LDB(B0, 0, 0); PG8_LDB(B1, 0, 1); PG8_SCHED; PG8_LDA(At, 0, 0); PG8_STAGE_A(PG8_SA(1, 1), a1, 1, false);
            PG8_WAIT_V(8); PG8_WAIT_L(0); PG8_BAR; PG8_MMA(0, 0, At, B0); PG8_MMA(0, 1, At, B1); PG8_BAR; PG8_SCHED;
            PG8_LDA(At, 0, 1); PG8_STAGE_B(PG8_SB(0, 0), b2); PG8_STAGE_B(PG8_SB(0, 1), b2 + hstep); PG8_STAGE_A(PG8_SA(0, 0), a2, 0, last);
            PG8_WAIT_V(8); PG8_WAIT_L(0); PG8_BAR; PG8_MMA(1, 0, At, B0); PG8_MMA(1, 1, At, B1); PG8_BAR; PG8_SCHED;
            PG8_LDB(B0, 1, 0); PG8_LDB(B1, 1, 1); PG8_SCHED; PG8_LDA(At, 1, 0); PG8_STAGE_A(PG8_SA(0, 1), a2, 1, last);
            PG8_WAIT_V(8); PG8_WAIT_L(0); PG8_BAR; PG8_MMA(0, 0, At, B0); PG8_MMA(0, 1, At, B1); PG8_BAR; PG8_SCHED;
            PG8_LDA(At, 1, 1); PG8_STAGE_B(PG8_SB(1, 0), b3); PG8_STAGE_B(PG8_SB(1, 1), b3 + hstep); PG8_STAGE_A(PG8_SA(1, 0), a3, 0, last);
            PG8_WAIT_V(8); PG8_WAIT_L(0); PG8_BAR; PG8_MMA(1, 0, At, B0); PG8_MMA(1, 1, At, B1); PG8_BAR; PG8_SCHED;
        }
        if constexpr (ALIGN_EPI) { if (wr == 0) PG8_BAR; }
        bool keep = false;
        if constexpr (PAIRACC) { if (cur.aux == 0) { E.mid(acc, cur, wr, wc, fr, fq); keep = true; } }
        if (!keep) E(acc, cur, wr, wc, fr, fq);
        if (!has_next) break;
        if (!keep) {
#pragma unroll
        for (int a = 0; a < 2; ++a)
#pragma unroll
            for (int b = 0; b < 2; ++b)
#pragma unroll
                for (int m = 0; m < 4; ++m)
#pragma unroll
                    for (int n = 0; n < 2; ++n) acc[a][b][m][n] = (f32x4){0.f, 0.f, 0.f, 0.f}; }
        cur = nxt; cA = nA; cB = nB; ++ui;
        if constexpr (GATHER) {
#pragma unroll
            for (int h = 0; h < 2; ++h)
#pragma unroll
                for (int i = 0; i < 2; ++i) voffA[h][i] = nvoffA[h][i]; }
        if constexpr (ALIGN_EPI) { if (wr == 1) PG8_BAR; }
    }
    PG8_WAIT_V(0);
    if constexpr (!ALIGN_EPI) { if (wr == 0) PG8_BAR; }
    PG8_BAR;
#undef PG8_SA
#undef PG8_SB
#undef PG8_STAGE_A
#undef PG8_STAGE_B
#undef PG8_LDA
#undef PG8_LDB
#undef PG8_MMA
#undef PG8_WAIT_V
#undef PG8_WAIT_L
#undef PG8_BAR
#undef PG8_SCHED
#undef PG8_GATHER_OFFS
}

constexpr int NXCD = 8, WGM = 8;
struct DenseOrder {
    int nM, nN, nwg, G, c; const char* A; const char* B; size_t tstep;
    __device__ void init(const void* A_, const void* B_, int M, int N, int K, int G_, int c_) { A = (const char*)A_; B = (const char*)B_; nM = M / BM; nN = N / BM; nwg = nM * nN; G = G_; c = c_; tstep = (size_t)BM * K * 2; }
    __device__ bool next(int i, Unit& u) const {
        const long L = (long)i * G + c; if (L >= nwg) return false;
        int wgid = (int)L; { const int q = nwg / NXCD, r = nwg % NXCD, xcd = wgid % NXCD, off = wgid / NXCD; wgid = (xcd < r ? xcd * (q + 1) : r * (q + 1) + (xcd - r) * q) + off; }
        const int nig = WGM * nN, gid = wgid / nig, fm = gid * WGM, gsz = (nM - fm) < WGM ? (nM - fm) : WGM;
        u.pm = fm + ((wgid % nig) % gsz); u.pn = (wgid % nig) / gsz; u.aux = 0; u.nvalid = BM; u.crow0 = 0; u.rows = nullptr;
        u.a = A + (size_t)u.pm * tstep; u.b = B + (size_t)u.pn * tstep; return true;
    }
};
struct PairOrder {
    int nM, nN, ntile, G, c; const char* A0; const char* B0; const char* A1; const char* B1; size_t tstep;
    __device__ bool next(int i, Unit& u) const {
        const long L = (long)(i >> 1) * G + c; if (L >= ntile) return false;
        int wgid = (int)L; { const int q = ntile / NXCD, r = ntile % NXCD, xcd = wgid % NXCD, off = wgid / NXCD; wgid = (xcd < r ? xcd * (q + 1) : r * (q + 1) + (xcd - r) * q) + off; }
        const int nig = WGM * nN, gid = wgid / nig, fm = gid * WGM, gsz = (nM - fm) < WGM ? (nM - fm) : WGM;
        u.pm = fm + ((wgid % nig) % gsz); u.pn = (wgid % nig) / gsz; u.aux = i & 1; u.nvalid = BM; u.crow0 = 0; u.rows = nullptr;
        u.a = ((i & 1) ? A1 : A0) + (size_t)u.pm * tstep; u.b = ((i & 1) ? B1 : B0) + (size_t)u.pn * tstep; return true;
    }
};
struct MoeOrder {
    const LAS int* pblk; const LAS int* cnt; int rb_lo, rb_hi, G, c, K, gather;
    const char* Abase; const char* Wbase; size_t wstride; const int* idx; int kpass;
    __device__ bool next(int i, Unit& u) const {
        const long L = (long)i * G + c; const int rb = rb_lo + (int)(L >> 2);
        if (rb >= rb_hi) return false;
        int bkt = 0;
#pragma unroll
        for (int st = 32; st > 0; st >>= 1) if (pblk[bkt + st] <= rb) bkt += st;
        const int j = rb - pblk[bkt], e = bkt & 31;
        u.pm = rb; u.pn = (int)(L & 3); u.aux = bkt >> 5; const int left = cnt[bkt] - 256 * j; u.nvalid = left < 256 ? left : 256; u.crow0 = gather ? e : cnt[64 + bkt] + 256 * j;
        u.rows = idx + (size_t)bkt * MTOK + 256 * j;
        u.a = gather ? Abase : Abase + (size_t)rb * 256 * K * 2;
        u.b = Wbase + (size_t)e * wstride + (size_t)u.pn * 256 * K * 2;
        return true;
    }
};

struct EpiAct {
    static constexpr bool PERM = true;
    bf16* o0; size_t gstride; int acts; int ldc;
    const float* sa; const float* sb;
    __device__ __forceinline__ void operator()(const f32x4 (&acc)[2][2][4][2], const Unit& u, int wr, int wc, int fr, int fq) const {
        const int grp = (u.pn * BM) >> 10; const int colt = u.pn * BM - (grp << 10);
        bf16* base = o0 + (size_t)grp * gstride; const int act = (acts >> (4 * grp)) & 15;
        const int row0 = u.pm * BM + wr * 64 + fr, col0 = colt + wc * 32 + 8 * fq;
        float sbv[2][8];
        if (sa) {
#pragma unroll
            for (int bj = 0; bj < 2; ++bj) { const f32x4 b0 = *(const f32x4*)(sb + u.pn * BM + bj * HALF + wc * 32 + 8 * fq), b1 = *(const f32x4*)(sb + u.pn * BM + bj * HALF + wc * 32 + 8 * fq + 4);
                sbv[bj][0] = b0[0]; sbv[bj][1] = b0[1]; sbv[bj][2] = b0[2]; sbv[bj][3] = b0[3]; sbv[bj][4] = b1[0]; sbv[bj][5] = b1[1]; sbv[bj][6] = b1[2]; sbv[bj][7] = b1[3]; } }
        float sarv[8];
#pragma unroll
        for (int g = 0; g < 8; ++g) sarv[g] = sa ? sa[row0 + (g >> 2) * HALF + (g & 3) * 16] : 1.0f;
#pragma unroll
        for (int ai = 0; ai < 2; ++ai)
#pragma unroll
            for (int m = 0; m < 4; ++m) { const int row = row0 + ai * HALF + m * 16; bf16* rowp = base + (size_t)row * ldc + col0; const float sar = sarv[ai * 4 + m];
#pragma unroll
                for (int bj = 0; bj < 2; ++bj) { const f32x4 a0 = acc[ai][bj][m][0], a1 = acc[ai][bj][m][1];
                    float v[8] = {a0[0], a0[1], a0[2], a0[3], a1[0], a1[1], a1[2], a1[3]};
                    if (sa) {
#pragma unroll
                        for (int e = 0; e < 8; ++e) v[e] = (float)__float_as_int(v[e]) * (sar * sbv[bj][e]); }
                    if (act == 1) {
#pragma unroll
                        for (int e = 0; e < 8; ++e) v[e] = gelu_tanh_f(v[e]); }
                    else if (act == 2) {
#pragma unroll
                        for (int e = 0; e < 8; ++e) v[e] = sigmoid_f(v[e]); }
                    u32x4 w; w.x = cvt_pk_bf16(v[0], v[1]); w.y = cvt_pk_bf16(v[2], v[3]); w.z = cvt_pk_bf16(v[4], v[5]); w.w = cvt_pk_bf16(v[6], v[7]);
                    *(u32x4*)(rowp + bj * HALF) = w; } }
    }
};
struct EpiQKV {
    static constexpr bool PERM = true;
    bf16* o0; size_t gstride; const float* sa; const float* sb; const float* qg; const float* kg; const float* rope; float qscale; unsigned char* sg8;
    __device__ __forceinline__ void operator()(const f32x4 (&acc)[2][2][4][2], const Unit& u, int wr, int wc, int fr, int fq) const {
        const int grp = (u.pn * BM) >> 10; const int pnl = u.pn & 3;
        bf16* base = o0 + (size_t)grp * gstride;
        const int row0 = u.pm * BM + wr * 64 + fr;
        float sbv[2][8];
#pragma unroll
        for (int bj = 0; bj < 2; ++bj) { const f32x4 b0 = *(const f32x4*)(sb + u.pn * BM + bj * HALF + wc * 32 + 8 * fq), b1 = *(const f32x4*)(sb + u.pn * BM + bj * HALF + wc * 32 + 8 * fq + 4);
            sbv[bj][0] = b0[0]; sbv[bj][1] = b0[1]; sbv[bj][2] = b0[2]; sbv[bj][3] = b0[3]; sbv[bj][4] = b1[0]; sbv[bj][5] = b1[1]; sbv[bj][6] = b1[2]; sbv[bj][7] = b1[3]; }
#define QKV_SARV float sarv[8]; _Pragma("unroll") for (int g = 0; g < 8; ++g) sarv[g] = sa[row0 + (g >> 2) * HALF + (g & 3) * 16]
        if (grp >= 3) { QKV_SARV;
            unsigned char* b8 = sg8 + (size_t)(grp - 3) * ((size_t)MTOK * DM) + ((size_t)(u.pm * 4 + pnl) << 16) + (wr * 4 + wc) * 8192 + (fq * 16 + fr) * 16;
            f32x2 sbn[2][4];
#pragma unroll
            for (int bj = 0; bj < 2; ++bj)
#pragma unroll
                for (int p = 0; p < 4; ++p) sbn[bj][p] = (f32x2){sbv[bj][2 * p], sbv[bj][2 * p + 1]} * (-LOG2E);
#pragma unroll
            for (int ai = 0; ai < 2; ++ai)
#pragma unroll
                for (int m = 0; m < 4; ++m) { const float sar = sarv[ai * 4 + m]; u32x4 w4;
#pragma unroll
                    for (int bj = 0; bj < 2; ++bj) { const f32x4 a0 = acc[ai][bj][m][0], a1 = acc[ai][bj][m][1];
                        const float v[8] = {a0[0], a0[1], a0[2], a0[3], a1[0], a1[1], a1[2], a1[3]};
                        unsigned pw_[4];
#pragma unroll
                        for (int p = 0; p < 4; ++p) {
                            const f32x2 z = (f32x2){(float)__float_as_int(v[2 * p]), (float)__float_as_int(v[2 * p + 1])} * (sbn[bj][p] * sar);
                            const f32x2 d = (f32x2){fast_exp2(z.x), fast_exp2(z.y)} * (1.0f / 255.0f) + (1.0f / 255.0f);
                            const f32x2 qf = (f32x2){fast_rcp(d.x), fast_rcp(d.y)} + 12582912.0f;
                            pw_[p] = __builtin_amdgcn_perm(__float_as_uint(qf.y), __float_as_uint(qf.x), 0x0c0c0400u); }
                        const unsigned lo = __builtin_amdgcn_perm(pw_[1], pw_[0], 0x05040100u), hi = __builtin_amdgcn_perm(pw_[3], pw_[2], 0x05040100u);
                        if (bj == 0) { w4.x = lo; w4.y = hi; } else { w4.z = lo; w4.w = hi; } }
                    *(u32x4*)(b8 + (ai * 4 + m) * 1024) = w4; }
            return;
        }
        if (grp == 2) { QKV_SARV;
            const int col0 = pnl * BM + wc * 32 + 8 * fq;
#pragma unroll
            for (int ai = 0; ai < 2; ++ai)
#pragma unroll
                for (int m = 0; m < 4; ++m) { const int row = row0 + ai * HALF + m * 16; const float sar = sarv[ai * 4 + m]; bf16* rowp = base + (size_t)row * DM + col0;
#pragma unroll
                    for (int bj = 0; bj < 2; ++bj) { const f32x4 a0 = acc[ai][bj][m][0], a1 = acc[ai][bj][m][1];
                        float v[8] = {a0[0], a0[1], a0[2], a0[3], a1[0], a1[1], a1[2], a1[3]};
#pragma unroll
                        for (int e = 0; e < 8; ++e) v[e] = (float)__float_as_int(v[e]) * (sar * sbv[bj][e]);
                        u32x4 w; w.x = cvt_pk_bf16(v[0], v[1]); w.y = cvt_pk_bf16(v[2], v[3]); w.z = cvt_pk_bf16(v[4], v[5]); w.w = cvt_pk_bf16(v[6], v[7]);
                        *(u32x4*)(rowp + bj * HALF) = w; } }
            return;
        }
        const float* gp = grp == 0 ? qg : kg; const float gs = grp == 0 ? qscale : 1.0f;
        float gv[2][8];
#pragma unroll
        for (int bj = 0; bj < 2; ++bj) { const f32x4 g0 = *(const f32x4*)(gp + 32 * bj + 8 * fq), g1 = *(const f32x4*)(gp + 32 * bj + 8 * fq + 4);
            gv[bj][0] = g0[0] * gs; gv[bj][1] = g0[1] * gs; gv[bj][2] = g0[2] * gs; gv[bj][3] = g0[3] * gs; gv[bj][4] = g1[0] * gs; gv[bj][5] = g1[1] * gs; gv[bj][6] = g1[2] * gs; gv[bj][7] = g1[3] * gs; }
        const int colL = (pnl * 4 + wc) * 64 + 8 * fq;
        f32x4 rp[4];
#pragma unroll
        for (int q = 0; q < 4; ++q) rp[q] = *(const f32x4*)(rope + (size_t)row0 * 16 + 4 * q);
        float sarn = sa[row0];
#pragma unroll
        for (int ai = 0; ai < 2; ++ai)
#pragma unroll
            for (int m = 0; m < 4; ++m) { const int row = row0 + ai * HALF + m * 16; const float sar = sarn;
                const int gi = ai * 4 + m;
                float y[2][8]; float ss = 0.f;
#pragma unroll
                for (int bj = 0; bj < 2; ++bj) { const f32x4 a0 = acc[ai][bj][m][0], a1 = acc[ai][bj][m][1];
                    const float t[8] = {a0[0], a0[1], a0[2], a0[3], a1[0], a1[1], a1[2], a1[3]};
#pragma unroll
                    for (int e = 0; e < 8; ++e) { y[bj][e] = (float)__float_as_int(t[e]) * (sar * sbv[bj][e]); ss += y[bj][e] * y[bj][e]; } }
                ss += __shfl_xor(ss, 16); ss += __shfl_xor(ss, 32);
                const float rstd = rsqrtf(ss * (1.f / 64.f) + EPS);
#pragma unroll
                for (int bj = 0; bj < 2; ++bj)
#pragma unroll
                    for (int e = 0; e < 8; ++e) y[bj][e] *= rstd * gv[bj][e];
                const f32x4 c0 = rp[0], c1 = rp[1], s0 = rp[2], s1 = rp[3];
                const float cs[8] = {c0[0], c0[1], c0[2], c0[3], c1[0], c1[1], c1[2], c1[3]}, sn[8] = {s0[0], s0[1], s0[2], s0[3], s1[0], s1[1], s1[2], s1[3]};
#pragma unroll
                for (int e = 0; e < 8; ++e) { const float px = __shfl_xor(y[0][e], 16);
                    const float r0 = y[0][e] * cs[e] - px * sn[e], r1 = y[0][e] * cs[e] + px * sn[e];
                    y[0][e] = fq == 0 ? r0 : (fq == 1 ? r1 : y[0][e]); }
                if (gi < 7) { const int rown = row0 + ((gi + 1) >> 2) * HALF + ((gi + 1) & 3) * 16;
#pragma unroll
                    for (int q = 0; q < 4; ++q) rp[q] = *(const f32x4*)(rope + (size_t)rown * 16 + 4 * q);
                    sarn = sa[rown]; }
                bf16* rowp = base + (size_t)row * DM + colL;
#pragma unroll
                for (int bj = 0; bj < 2; ++bj) { u32x4 w; w.x = cvt_pk_bf16(y[bj][0], y[bj][1]); w.y = cvt_pk_bf16(y[bj][2], y[bj][3]); w.z = cvt_pk_bf16(y[bj][4], y[bj][5]); w.w = cvt_pk_bf16(y[bj][6], y[bj][7]);
                    *(u32x4*)(rowp + 32 * bj) = w; } }
#undef QKV_SARV
    }
};
struct EpiRowScale {
    static constexpr bool PERM = true;
    bf16* out; int ldc; const float* rss;
    __device__ __forceinline__ void operator()(const f32x4 (&acc)[2][2][4][2], const Unit& u, int wr, int wc, int fr, int fq) const {
        const int row0 = u.pm * BM + wr * 64 + fr, col0 = u.pn * BM + wc * 32 + 8 * fq;
        float rstdv[8];
#pragma unroll
        for (int g = 0; g < 8; ++g) { const f32x4* p = (const f32x4*)(rss + (size_t)(row0 + (g >> 2) * HALF + (g & 3) * 16) * 16);
            const f32x4 s0 = p[0], s1 = p[1], s2 = p[2], s3 = p[3];
            const float ss = ((s0[0] + s0[1]) + (s0[2] + s0[3])) + ((s1[0] + s1[1]) + (s1[2] + s1[3])) + ((s2[0] + s2[1]) + (s2[2] + s2[3])) + ((s3[0] + s3[1]) + (s3[2] + s3[3]));
            rstdv[g] = rsqrtf(ss * (1.0f / DM) + EPS); }
#pragma unroll
        for (int ai = 0; ai < 2; ++ai)
#pragma unroll
            for (int m = 0; m < 4; ++m) { const int row = row0 + ai * HALF + m * 16; const float rstd = rstdv[ai * 4 + m];
                bf16* rowp = out + (size_t)row * ldc + col0;
#pragma unroll
                for (int bj = 0; bj < 2; ++bj) { const f32x4 v0 = acc[ai][bj][m][0] * rstd, v1 = acc[ai][bj][m][1] * rstd;
                    u32x4 w; w.x = cvt_pk_bf16(v0[0], v0[1]); w.y = cvt_pk_bf16(v0[2], v0[3]); w.z = cvt_pk_bf16(v1[0], v1[1]); w.w = cvt_pk_bf16(v1[2], v1[3]);
                    *(u32x4*)(rowp + bj * HALF) = w; } }
    }
};
struct EpiMix {
    static constexpr bool PERM = true;
    const unsigned char* g0; const unsigned char* g1; bf16* mix;
    __device__ __forceinline__ void mid(f32x4 (&acc)[2][2][4][2], const Unit& u, int wr, int wc, int fr, int fq) const {
        const size_t goff = ((size_t)(u.pm * 4 + u.pn) << 16) + (wr * 4 + wc) * 8192 + (fq * 16 + fr) * 16;
#pragma unroll
        for (int ai = 0; ai < 2; ++ai)
#pragma unroll
            for (int m = 0; m < 4; ++m) { const u32x4 a4 = *(const u32x4*)(g0 + goff + (ai * 4 + m) * 1024), b4 = *(const u32x4*)(g1 + goff + (ai * 4 + m) * 1024);
#pragma unroll
                for (int bj = 0; bj < 2; ++bj) {
#pragma unroll
                    for (int e = 0; e < 8; ++e) { const unsigned aw = bj == 0 ? (e < 4 ? a4.x : a4.y) : (e < 4 ? a4.z : a4.w), bw = bj == 0 ? (e < 4 ? b4.x : b4.y) : (e < 4 ? b4.z : b4.w); const int sh = 8 * (e & 3);
                        const float ga = (float)((aw >> sh) & 0xffu), gb = fmaxf((float)((bw >> sh) & 0xffu), 1.0f);
                        acc[ai][bj][m][e >> 2][e & 3] *= ga * fast_rcp(gb); } } }
    }
    __device__ __forceinline__ void operator()(const f32x4 (&acc)[2][2][4][2], const Unit& u, int wr, int wc, int fr, int fq) const {
        const int row0 = u.pm * BM + wr * 64 + fr, col0 = u.pn * BM + wc * 32 + 8 * fq;
        const size_t goff = ((size_t)(u.pm * 4 + u.pn) << 16) + (wr * 4 + wc) * 8192 + (fq * 16 + fr) * 16;
        u32x4 gb8[8];
#pragma unroll
        for (int g = 0; g < 8; ++g) gb8[g] = *(const u32x4*)(g1 + goff + g * 1024);
#pragma unroll
        for (int ai = 0; ai < 2; ++ai)
#pragma unroll
            for (int m = 0; m < 4; ++m) { const size_t off = (size_t)(row0 + ai * HALF + m * 16) * DM + col0; const u32x4 b4 = gb8[ai * 4 + m];
#pragma unroll
                for (int bj = 0; bj < 2; ++bj) { float v[8];
#pragma unroll
                    for (int e = 0; e < 8; ++e) { const unsigned bw = bj == 0 ? (e < 4 ? b4.x : b4.y) : (e < 4 ? b4.z : b4.w); const float gb = fmaxf((float)((bw >> (8 * (e & 3))) & 0xffu), 1.0f) * (1.0f / 255.0f);
                        v[e] = acc[ai][bj][m][e >> 2][e & 3] * gb; }
                    u32x4 w; w.x = cvt_pk_bf16(v[0], v[1]); w.y = cvt_pk_bf16(v[2], v[3]); w.z = cvt_pk_bf16(v[4], v[5]); w.w = cvt_pk_bf16(v[6], v[7]);
                    *(u32x4*)(mix + off + bj * HALF) = w; } }
    }
};
template <bool XF32> struct EpiResid {
    static constexpr bool PERM = true;
    const void* xin; bf16* xb; float* rss; float* amx;
    __device__ __forceinline__ void operator()(const f32x4 (&acc)[2][2][4][2], const Unit& u, int wr, int wc, int fr, int fq) const {
        const int row0 = u.pm * BM + wr * 64 + fr, col0 = u.pn * BM + wc * 32 + 8 * fq;
        constexpr int D = XF32 ? 3 : 4;
        f32x4 xv[D][XF32 ? 4 : 1]; u32x4 xw[D][XF32 ? 1 : 2];
#define ER_LOAD(g) do { const size_t o_ = (size_t)(row0 + ((g) >> 2) * HALF + ((g) & 3) * 16) * DM + col0; _Pragma("unroll") for (int q_ = 0; q_ < 2; ++q_) { const size_t oo_ = o_ + q_ * HALF; \
            if (XF32) { xv[(g) % D][XF32 ? 2 * q_ : 0] = __builtin_nontemporal_load((const f32x4*)((const float*)xin + oo_)); xv[(g) % D][XF32 ? 2 * q_ + 1 : 0] = __builtin_nontemporal_load((const f32x4*)((const float*)xin + oo_ + 4)); } \
            else xw[(g) % D][XF32 ? 0 : q_] = *(const u32x4*)((const bf16*)xin + oo_); } } while (0)
#pragma unroll
        for (int g = 0; g < D - 1; ++g) ER_LOAD(g);
#pragma unroll
        for (int ai = 0; ai < 2; ++ai)
#pragma unroll
            for (int m = 0; m < 4; ++m) { const int row = row0 + ai * HALF + m * 16; const size_t off = (size_t)row * DM + col0; float ss = 0.f, am = 0.f;
                const int gi = ai * 4 + m;
                if (gi + D - 1 < 8) ER_LOAD(gi + D - 1);
#pragma unroll
                for (int bj = 0; bj < 2; ++bj) { f32x4 v0, v1;
                    if (XF32) { v0 = xv[gi % D][XF32 ? 2 * bj : 0]; v1 = xv[gi % D][XF32 ? 2 * bj + 1 : 0]; }
                    else { const u32x4 w = xw[gi % D][XF32 ? 0 : bj]; v0 = (f32x4){bflo(w.x), bfhi(w.x), bflo(w.y), bfhi(w.y)}; v1 = (f32x4){bflo(w.z), bfhi(w.z), bflo(w.w), bfhi(w.w)}; }
                    v0 = v0 + acc[ai][bj][m][0]; v1 = v1 + acc[ai][bj][m][1];
                    u32x4 w; w.x = cvt_pk_bf16(v0[0], v0[1]); w.y = cvt_pk_bf16(v0[2], v0[3]); w.z = cvt_pk_bf16(v1[0], v1[1]); w.w = cvt_pk_bf16(v1[2], v1[3]); *(u32x4*)(xb + off + bj * HALF) = w;
                    ss += ((v0[0] * v0[0] + v0[1] * v0[1]) + (v0[2] * v0[2] + v0[3] * v0[3])) + ((v1[0] * v1[0] + v1[1] * v1[1]) + (v1[2] * v1[2] + v1[3] * v1[3]));
                    am = fmaxf(am, fmaxf(fmaxf(fmaxf(fabsf(v0[0]), fabsf(v0[1])), fmaxf(fabsf(v0[2]), fabsf(v0[3]))), fmaxf(fmaxf(fabsf(v1[0]), fabsf(v1[1])), fmaxf(fabsf(v1[2]), fabsf(v1[3]))))); }
                ss += __shfl_xor(ss, 16); ss += __shfl_xor(ss, 32);
                if (fq == 0) rss[(size_t)row * 16 + u.pn * 4 + wc] = ss;
                if (amx) { am = fmaxf(am, __shfl_xor(am, 16)); am = fmaxf(am, __shfl_xor(am, 32)); if (fq == 0) amx[(size_t)row * 16 + u.pn * 4 + wc] = am; } }
#undef ER_LOAD
    }
};
struct EpiLogit {
    static constexpr bool PERM = false;
    float* logit;
    __device__ __forceinline__ void operator()(const f32x4 (&acc)[2][2][4][2], const Unit& u, int wr, int wc, int fr, int fq) const {
        if (wc >= 2) return;
        const int row0 = u.pm * BM + wr * 64 + fr, col0 = wc * 32 + 4 * fq;
#pragma unroll
        for (int ai = 0; ai < 2; ++ai)
#pragma unroll
            for (int m = 0; m < 4; ++m) { float* rowp = logit + (size_t)(row0 + ai * HALF + m * 16) * 64 + col0;
#pragma unroll
                for (int n = 0; n < 2; ++n) *(f32x4*)(rowp + n * 16) = acc[ai][0][m][n]; }
    }
};
struct EpiGateUp {
    static constexpr bool PERM = true;
    bf16* H; const float* rstd; const float* xs; const float* wsc;
    __device__ __forceinline__ void operator()(const f32x4 (&acc)[2][2][4][2], const Unit& u, int wr, int wc, int fr, int fq) const {
        const int col0 = u.pn * 128 + wc * 32 + 8 * fq;
        int tok[8]; float rs[8];
#pragma unroll
        for (int i = 0; i < 8; ++i) { const int rt = (i >> 2) * HALF + wr * 64 + (i & 3) * 16 + fr; tok[i] = u.rows[rt < u.nvalid ? rt : 0]; }
#pragma unroll
        for (int i = 0; i < 8; ++i) rs[i] = rstd[tok[i]] * xs[tok[i]];
        const float* wcol = wsc + (size_t)u.crow0 * 1024 + u.pn * BM + wc * 32 + 8 * fq;
        float sg[8], su[8];
        { const f32x4 g0 = *(const f32x4*)wcol, g1 = *(const f32x4*)(wcol + 4), u0 = *(const f32x4*)(wcol + HALF), u1 = *(const f32x4*)(wcol + HALF + 4);
          sg[0] = g0[0]; sg[1] = g0[1]; sg[2] = g0[2]; sg[3] = g0[3]; sg[4] = g1[0]; sg[5] = g1[1]; sg[6] = g1[2]; sg[7] = g1[3];
          su[0] = u0[0]; su[1] = u0[1]; su[2] = u0[2]; su[3] = u0[3]; su[4] = u1[0]; su[5] = u1[1]; su[6] = u1[2]; su[7] = u1[3]; }
#pragma unroll
        for (int ai = 0; ai < 2; ++ai)
#pragma unroll
            for (int m = 0; m < 4; ++m) { const int rt = ai * HALF + wr * 64 + m * 16 + fr; const float r_ = rt < u.nvalid ? rs[ai * 4 + m] : 0.f;
                float h[8];
#pragma unroll
                for (int n = 0; n < 2; ++n)
#pragma unroll
                    for (int e = 0; e < 4; ++e) { const float g = (float)__float_as_int(acc[ai][0][m][n][e]) * (r_ * sg[n * 4 + e]), up = (float)__float_as_int(acc[ai][1][m][n][e]) * (r_ * su[n * 4 + e]); h[n * 4 + e] = g * sigmoid_f(g) * up; }
                u32x4 w; w.x = cvt_pk_bf16(h[0], h[1]); w.y = cvt_pk_bf16(h[2], h[3]); w.z = cvt_pk_bf16(h[4], h[5]); w.w = cvt_pk_bf16(h[6], h[7]);
                *(u32x4*)(H + (size_t)(u.pm * BM + rt) * EFF + col0) = w; }
    }
};
struct EpiY {
    static constexpr bool PERM = true;
    bf16* y0; bf16* y1;
    __device__ __forceinline__ void operator()(const f32x4 (&acc)[2][2][4][2], const Unit& u, int wr, int wc, int fr, int fq) const {
        bf16* base = (u.aux ? y1 : y0) + (size_t)u.crow0 * DM + u.pn * BM;
        const unsigned loff = (unsigned)((wr * 64 + fr) * DM + wc * 32 + 8 * fq); const int rt0 = wr * 64 + fr;
#pragma unroll
        for (int ai = 0; ai < 2; ++ai)
#pragma unroll
            for (int m = 0; m < 4; ++m) {
                if (rt0 + ai * HALF + m * 16 < u.nvalid) {
#pragma unroll
                    for (int bj = 0; bj < 2; ++bj) { const f32x4 v0 = acc[ai][bj][m][0], v1 = acc[ai][bj][m][1];
                        u32x4 w; w.x = cvt_pk_bf16(v0[0], v0[1]); w.y = cvt_pk_bf16(v0[2], v0[3]); w.z = cvt_pk_bf16(v1[0], v1[1]); w.w = cvt_pk_bf16(v1[2], v1[3]);
                        *(u32x4*)(base + loff + (unsigned)((ai * HALF + m * 16) * DM + bj * HALF)) = w; } } }
    }
};
}

#define XB_TMO      128
#define XB_XCNT(j)  (256  + 64 * (j))
#define XB_XSUB(j)  (1280 + 64 * (j))
#define XB_XGEN(j)  (2304 + 64 * (j))
#define XB_TOP      3328
#define XB_TOPGEN   3392
#define XCD_BAR_WORDS 3456
#define XB_SPIN_CAP (1u << 18)
__device__ __forceinline__ unsigned xb_ld(unsigned* p)              { return __hip_atomic_load(p, __ATOMIC_RELAXED, __HIP_MEMORY_SCOPE_AGENT); }
__device__ __forceinline__ unsigned xb_add(unsigned* p, unsigned v) { return __hip_atomic_fetch_add(p, v, __ATOMIC_RELAXED, __HIP_MEMORY_SCOPE_AGENT); }
__device__ __forceinline__ unsigned xb_xcc_id() { return (unsigned)__builtin_amdgcn_s_getreg((3 << 11) | 20) & 0xFu; }
#define XB_SPIN(cond, bar) do { unsigned _sp = 0; while (cond) { __builtin_amdgcn_s_sleep(1); \
    if ((++_sp & 255u) == 0u) { if (xb_ld(&(bar)[XB_TMO])) break; if (_sp > XB_SPIN_CAP) { atomicAdd(&(bar)[XB_TMO], 1u); break; } } } } while (0)
struct XcdBarrier { unsigned* bar; unsigned x; volatile LAS unsigned* st; };
__device__ __forceinline__ XcdBarrier xcd_barrier_post(unsigned* bar, volatile LAS unsigned* st) {
    XcdBarrier b; b.bar = bar; b.x = xb_xcc_id(); b.st = st;
    if (threadIdx.x == 0) (void)xb_add(&bar[XB_XCNT(b.x)], 1u);
    return b;
}
__device__ __forceinline__ void xcd_barrier_complete(unsigned* bar, unsigned x, unsigned& nloc, unsigned& nx) {
    const unsigned G = gridDim.x * gridDim.y * gridDim.z;
    unsigned sum, cnt, mine, sp = 0u;
    for (;;) {
        sum = 0u; cnt = 0u; mine = 0u;
#pragma unroll
        for (unsigned j = 0; j < 16; ++j) { const unsigned c = xb_ld(&bar[XB_XCNT(j)]); sum += c; cnt += (c > 0u) ? 1u : 0u; mine = (j == x) ? c : mine; }
        if (sum == G) break;
        __builtin_amdgcn_s_sleep(1);
        if ((++sp & 255u) == 0u) { if (xb_ld(&bar[XB_TMO])) break; if (sp > XB_SPIN_CAP) { atomicAdd(&bar[XB_TMO], 1u); break; } }
    }
    nloc = mine > 0u ? mine : 1u; nx = cnt > 0u ? cnt : 1u;
}
__device__ __forceinline__ void xcd_barrier(const XcdBarrier& b) {
    asm volatile("s_waitcnt vmcnt(0)" ::: "memory");
    __syncthreads();
    if (threadIdx.x == 0) {
        unsigned* bar = b.bar;
        __builtin_amdgcn_s_waitcnt(0);
        unsigned nloc = b.st[0], nx = b.st[1];
        if (nloc == 0u) { xcd_barrier_complete(bar, b.x, nloc, nx); b.st[0] = nloc; b.st[1] = nx; }
        const unsigned old = xb_add(&bar[XB_XSUB(b.x)], 1u);
        const unsigned gen = old / nloc;
        if (old + 1u == (gen + 1u) * nloc) {
            __builtin_amdgcn_fence(__ATOMIC_RELEASE, "agent");
            asm volatile("s_waitcnt vmcnt(0)" ::: "memory");
            const unsigned og = xb_add(&bar[XB_TOP], 1u);
            const unsigned tg = og / nx;
            if (og + 1u == (tg + 1u) * nx) xb_add(&bar[XB_TOPGEN], 1u);
            else XB_SPIN(xb_ld(&bar[XB_TOPGEN]) == tg, bar);
            __builtin_amdgcn_fence(__ATOMIC_ACQUIRE, "agent");
            xb_add(&bar[XB_XGEN(b.x)], 1u);
            asm volatile("s_waitcnt vmcnt(0)" ::: "memory");
        } else {
            XB_SPIN(xb_ld(&bar[XB_XGEN(b.x)]) == gen, bar);
            __builtin_amdgcn_fence(__ATOMIC_ACQUIRE, "agent");
            asm volatile("s_waitcnt vmcnt(0)" ::: "memory");
        }
    }
    __syncthreads();
}

struct Args { const void* in[36]; float* out; unsigned char* ws; int ph_lo, ph_hi, li, pad; };
enum { I_X = 0, I_MEM, I_POS, I_NORM_MIX, I_W_IN, I_CONV_W, I_CONV_B, I_LRU_WA, I_LRU_BA, I_LRU_WX, I_LRU_BX, I_LRU_LAMBDA, I_W_LRU_O, I_Q_NORM, I_K_NORM,
       I_LQ1, I_LK1, I_LQ2, I_LK2, I_SUBLN, I_W_ATTN_O, I_W_OUT, I_NORM_CX, I_NORM_MEM, I_W_CQ, I_W_CKV, I_CQ_NORM, I_CK_NORM, I_W_CO, I_NORM_FFN,
       I_W_GROUP, I_B_GROUP, I_W_ROUTER, I_B_ROUTER, I_W_GATE_UP, I_W_DOWN };

template <int MODE>
__device__ __forceinline__ void transpose_item(const float* W, int K, int N, bf16* WT, int row_off, const float* gain, LAS float* scr, int item, int lane) {
    const int nblk = N / 32, kb = item / nblk, nb = item % nblk, k0 = 64 * kb, n0 = 32 * nb;
    float tv[32];
#pragma unroll
    for (int i = 0; i < 32; ++i) { const int kk = 2 * i + (lane >> 5); tv[i] = W[(size_t)(k0 + kk) * N + n0 + (lane & 31)]; }
#pragma unroll
    for (int i = 0; i < 32; ++i) { const int kk = 2 * i + (lane >> 5); float v = tv[i]; if (gain) v *= gain[k0 + kk]; scr[kk * 33 + (lane & 31)] = v; }
    LDS_WAIT(); asm volatile("" ::: "memory");
    const int c = lane & 7;
#pragma unroll
    for (int j = 0; j < 4; ++j) { const int n = (lane >> 3) + 8 * j; const LAS float* s = scr + (8 * c) * 33 + n;
        u32x4 o; o.x = cvt_pk_bf16(s[0 * 33], s[1 * 33]); o.y = cvt_pk_bf16(s[2 * 33], s[3 * 33]); o.z = cvt_pk_bf16(s[4 * 33], s[5 * 33]); o.w = cvt_pk_bf16(s[6 * 33], s[7 * 33]);
        const int ng = n0 + n; int dr;
        if (MODE == 0) dr = row_off + ng; else { const int jj = ng & 511, up = ng >> 9; dr = row_off + (jj >> 7) * 256 + up * 128 + (jj & 127); }
        *(u32x4*)(WT + (size_t)dr * K + k0 + 8 * c) = o; }
    LDS_WAIT(); asm volatile("" ::: "memory");
}
__device__ __forceinline__ unsigned pack_i8x4(float a, float b, float c, float d) {
    const int ia = max(-127, min(127, __float2int_rn(a))), ib = max(-127, min(127, __float2int_rn(b))), ic = max(-127, min(127, __float2int_rn(c))), id = max(-127, min(127, __float2int_rn(d)));
    return (unsigned)(ia & 0xff) | ((unsigned)(ib & 0xff) << 8) | ((unsigned)(ic & 0xff) << 16) | ((unsigned)(id & 0xff) << 24);
}
__device__ __forceinline__ void rms_row_to_i8(const float* xrow, const float* g, unsigned char* orow, float* xs, int lane) {
    const f32x4* xr = (const f32x4*)xrow + lane; const f32x4* gr = (const f32x4*)g + lane;
    f32x4 v[4]; float s = 0.f;
#pragma unroll
    for (int j = 0; j < 4; ++j) { v[j] = __builtin_nontemporal_load(xr + 64 * j); s += (v[j].x * v[j].x + v[j].y * v[j].y) + (v[j].z * v[j].z + v[j].w * v[j].w); }
    const float rstd = rsqrtf(wave_sum(s) * (1.f / DM) + EPS); float mx = 0.f;
#pragma unroll
    for (int j = 0; j < 4; ++j) { const f32x4 gg = gr[64 * j]; v[j] = v[j] * gg * rstd; mx = fmaxf(mx, fmaxf(fmaxf(fabsf(v[j].x), fabsf(v[j].y)), fmaxf(fabsf(v[j].z), fabsf(v[j].w)))); }
    mx = wave_max(mx); const float sc = mx > 0.f ? mx * (1.0f / 127.0f) : 1.0f, inv = 1.0f / sc;
    if (lane == 0) *xs = sc;
    unsigned* o4 = (unsigned*)orow + lane;
#pragma unroll
    for (int j = 0; j < 4; ++j) o4[64 * j] = pack_i8x4(v[j].x * inv, v[j].y * inv, v[j].z * inv, v[j].w * inv);
}
__device__ __forceinline__ int win_dest(int n0) { if (n0 >= 2048 && n0 < 4096) { const int l0 = n0 & 255; return (n0 & ~255) + 128 * ((l0 >> 5) & 1) + 32 * (l0 >> 6); } return n0; }
__device__ __forceinline__ void win_absmax_item(const float* W, unsigned* wmax, int item, int lane) {
    constexpr int nblk = NWIN / 32; const int kb = item / nblk, nb = item % nblk, k0 = 64 * kb, n0 = 32 * nb;
    float tv[32], mx = 0.f;
#pragma unroll
    for (int i = 0; i < 32; ++i) { const int kk = 2 * i + (lane >> 5); tv[i] = W[(size_t)(k0 + kk) * NWIN + n0 + (lane & 31)]; }
#pragma unroll
    for (int i = 0; i < 32; ++i) mx = fmaxf(mx, fabsf(tv[i]));
    mx = fmaxf(mx, __shfl_xor(mx, 32));
    if (lane < 32) atomicMax(wmax + win_dest(n0) + lane, __float_as_uint(mx));
}
__device__ __forceinline__ void win_quant_item(const float* W, unsigned char* WT, const unsigned* wmax, float* wsc, LAS float* scr, int item, int lane) {
    constexpr int nblk = NWIN / 32; const int kb = item / nblk, nb = item % nblk, k0 = 64 * kb, n0 = 32 * nb, d0 = win_dest(n0);
    float tv[32];
#pragma unroll
    for (int i = 0; i < 32; ++i) { const int kk = 2 * i + (lane >> 5); tv[i] = W[(size_t)(k0 + kk) * NWIN + n0 + (lane & 31)]; }
    if (lane < 32) { const float mx = __uint_as_float(__hip_atomic_load(wmax + d0 + lane, __ATOMIC_RELAXED, __HIP_MEMORY_SCOPE_AGENT)); const float sc = mx > 0.f ? mx * (1.0f / 127.0f) : 1.0f;
        scr[64 * 33 + lane] = 1.0f / sc; if (kb == 0) wsc[d0 + lane] = sc; }
#pragma unroll
    for (int i = 0; i < 32; ++i) { const int kk = 2 * i + (lane >> 5); scr[kk * 33 + (lane & 31)] = tv[i]; }
    LDS_WAIT(); asm volatile("" ::: "memory");
    const int c = lane & 7;
#pragma unroll
    for (int j = 0; j < 4; ++j) { const int n = (lane >> 3) + 8 * j; const LAS float* sp = scr + (8 * c) * 33 + n; const float inv = scr[64 * 33 + n];
        u32x2 o; o.x = pack_i8x4(sp[0 * 33] * inv, sp[1 * 33] * inv, sp[2 * 33] * inv, sp[3 * 33] * inv); o.y = pack_i8x4(sp[4 * 33] * inv, sp[5 * 33] * inv, sp[6 * 33] * inv, sp[7 * 33] * inv);
        *(u32x2*)(WT + (size_t)(d0 + n) * DM + k0 + 8 * c) = o; }
    LDS_WAIT(); asm volatile("" ::: "memory");
}
__device__ __forceinline__ int gu_dest(int n) { const int jj = n & 511, up = n >> 9; return (jj >> 7) * 256 + up * 128 + (jj & 127); }
__device__ __forceinline__ void gu_absmax_item(const float* W, const float* gain, unsigned* wmax  , int item, int lane) {
    const int kb = item >> 5, nb = item & 31, k0 = 64 * kb, n0 = 32 * nb;
    float tv[32], mx = 0.f;
#pragma unroll
    for (int i = 0; i < 32; ++i) { const int kk = 2 * i + (lane >> 5); tv[i] = W[(size_t)(k0 + kk) * 1024 + n0 + (lane & 31)]; }
#pragma unroll
    for (int i = 0; i < 32; ++i) { const int kk = 2 * i + (lane >> 5); mx = fmaxf(mx, fabsf(tv[i] * gain[k0 + kk])); }
    mx = fmaxf(mx, __shfl_xor(mx, 32));
    if (lane < 32) atomicMax(wmax + gu_dest(n0) + lane, __float_as_uint(mx));
}
__device__ __forceinline__ void gu_quant_item(const float* W, const float* gain, unsigned char* WT  , const unsigned* wmax, float* wsc, LAS float* scr, int item, int lane) {
    const int kb = item >> 5, nb = item & 31, k0 = 64 * kb, n0 = 32 * nb, d0 = gu_dest(n0);
    float tv[32];
#pragma unroll
    for (int i = 0; i < 32; ++i) { const int kk = 2 * i + (lane >> 5); tv[i] = W[(size_t)(k0 + kk) * 1024 + n0 + (lane & 31)]; }
    if (lane < 32) { const float mx = __uint_as_float(__hip_atomic_load(wmax + d0 + lane, __ATOMIC_RELAXED, __HIP_MEMORY_SCOPE_AGENT)); const float sc = mx > 0.f ? mx * (1.0f / 127.0f) : 1.0f;
        scr[64 * 33 + lane] = 1.0f / sc; if (kb == 0) wsc[d0 + lane] = sc; }
#pragma unroll
    for (int i = 0; i < 32; ++i) { const int kk = 2 * i + (lane >> 5); scr[kk * 33 + (lane & 31)] = tv[i] * gain[k0 + kk]; }
    LDS_WAIT(); asm volatile("" ::: "memory");
    const int c = lane & 7;
#pragma unroll
    for (int j = 0; j < 4; ++j) { const int n = (lane >> 3) + 8 * j; const LAS float* sp = scr + (8 * c) * 33 + n; const float inv = scr[64 * 33 + n];
        u32x2 o; o.x = pack_i8x4(sp[0 * 33] * inv, sp[1 * 33] * inv, sp[2 * 33] * inv, sp[3 * 33] * inv); o.y = pack_i8x4(sp[4 * 33] * inv, sp[5 * 33] * inv, sp[6 * 33] * inv, sp[7 * 33] * inv);
        *(u32x2*)(WT + (size_t)(d0 + n) * DM + k0 + 8 * c) = o; }
    LDS_WAIT(); asm volatile("" ::: "memory");
}
__device__ __forceinline__ void rms_row_to_bf16(const float* xrow, const float* g, bf16* orow, int lane) {
    const f32x4* xr = (const f32x4*)xrow + lane; const f32x4* gr = (const f32x4*)g + lane;
    f32x4 v[4]; float s = 0.f;
#pragma unroll
    for (int j = 0; j < 4; ++j) { v[j] = xr[64 * j]; s += (v[j].x * v[j].x + v[j].y * v[j].y) + (v[j].z * v[j].z + v[j].w * v[j].w); }
    const float rstd = rsqrtf(wave_sum(s) * (1.f / DM) + EPS);
    u32x2* o8 = (u32x2*)orow + lane;
#pragma unroll
    for (int j = 0; j < 4; ++j) { const f32x4 gg = gr[64 * j]; u32x2 w; w.x = cvt_pk_bf16(v[j].x * rstd * gg.x, v[j].y * rstd * gg.y); w.y = cvt_pk_bf16(v[j].z * rstd * gg.z, v[j].w * rstd * gg.w); o8[64 * j] = w; }
}
__device__ __forceinline__ void colquant_wg_item(const float* W, int N, int n0, int d0, const LAS float* gain_l  , unsigned char* WT, float* wsc, LAS float* red, int tid) {
    const int ks = tid >> 5, nl = tid & 31;
    float v[64];
    const float* src = W + (size_t)(64 * ks) * N + n0 + nl;
#pragma unroll
    for (int i = 0; i < 64; ++i) v[i] = src[(size_t)i * N];
    if (gain_l) {
#pragma unroll
        for (int i = 0; i < 16; ++i) { const f32x4 g4 = *(const LAS f32x4*)(gain_l + 64 * ks + 4 * i); v[4 * i] *= g4[0]; v[4 * i + 1] *= g4[1]; v[4 * i + 2] *= g4[2]; v[4 * i + 3] *= g4[3]; } }
    float mx = 0.f;
#pragma unroll
    for (int i = 0; i < 64; ++i) mx = fmaxf(mx, fabsf(v[i]));
    red[ks * 32 + nl] = mx;
    __syncthreads();
    float cm = 0.f;
#pragma unroll
    for (int j = 0; j < 16; ++j) cm = fmaxf(cm, red[j * 32 + nl]);
    const float sc = cm > 0.f ? cm * (1.0f / 127.0f) : 1.0f, inv = 1.0f / sc;
    if (ks == 0) wsc[d0 + nl] = sc;
    unsigned char* dst = WT + (size_t)(d0 + nl) * DM + 64 * ks;
#pragma unroll
    for (int q = 0; q < 4; ++q) { u32x4 o;
        o.x = pack_i8x4(v[16 * q] * inv, v[16 * q + 1] * inv, v[16 * q + 2] * inv, v[16 * q + 3] * inv); o.y = pack_i8x4(v[16 * q + 4] * inv, v[16 * q + 5] * inv, v[16 * q + 6] * inv, v[16 * q + 7] * inv);
        o.z = pack_i8x4(v[16 * q + 8] * inv, v[16 * q + 9] * inv, v[16 * q + 10] * inv, v[16 * q + 11] * inv); o.w = pack_i8x4(v[16 * q + 12] * inv, v[16 * q + 13] * inv, v[16 * q + 14] * inv, v[16 * q + 15] * inv);
        *(u32x4*)(dst + 16 * q) = o; }
    __syncthreads();
}
__device__ __forceinline__ void prologue_phase(const Args& args, LAS unsigned char* lds, int vcu, int G, int wave, int lane) {
    unsigned char* ws = args.ws;
    LAS float* scr = (LAS float*)(lds + wave * 16384);
    const int gw = vcu * NWAVES + wave, NGW = G * NWAVES;
    constexpr int I0 = 0  , I1 = 512, I4 = 256, I5 = 512, I6 = 256, I7 = 0, I8 = 256  , I9 = 8  ;
    constexpr int E0 = I0, E1 = E0 + 3 * I1, E4 = E1 + I4, E5 = E4 + I5, E6 = E5 + I6, E7 = E6 + NEXP * I7, E8 = E7 + NEXP * I8, E9 = E8 + 16 * I9;
    for (int it = gw; it < E9; it += NGW) {
        if (it < E0) { win_absmax_item((const float*)args.in[I_W_IN], (unsigned*)(ws + WS_CTL) + CW_WMAX, it, lane); continue; }
        if (it < E1) { const int r = it - E0, w = r / I1; const float* src = (const float*)args.in[w == 0 ? I_W_LRU_O : (w == 1 ? I_W_ATTN_O : I_W_OUT)];
            bf16* dst = (bf16*)(ws + (w == 0 ? WS_WLRUO : (w == 1 ? WS_WATTNO : WS_WOUT))); transpose_item<0>(src, DM, DM, dst, 0, nullptr, scr, r % I1, lane); continue; }
        if (it < E4) { transpose_item<0>((const float*)args.in[I_W_CQ], DM, 512, (bf16*)(ws + WS_WCQ), 0, (const float*)args.in[I_NORM_CX], scr, it - E1, lane); continue; }
        if (it < E5) { transpose_item<0>((const float*)args.in[I_W_CKV], DM, DM, (bf16*)(ws + WS_WCKV), 0, nullptr, scr, it - E4, lane); continue; }
        if (it < E6) { transpose_item<0>((const float*)args.in[I_W_CO], 512, DM, (bf16*)(ws + WS_WCO), 0, nullptr, scr, it - E5, lane); continue; }
        if (it < E7) { const int r = it - E6, e = r / I7; gu_absmax_item((const float*)args.in[I_W_GATE_UP] + (size_t)e * DM * 1024, (const float*)args.in[I_NORM_FFN], (unsigned*)(ws + WS_CTL) + CW_WMAX2 + e * 1024, r % I7, lane); continue; }
        if (it < E8) { const int r = it - E7, e = r / I8; transpose_item<0>((const float*)args.in[I_W_DOWN] + (size_t)e * EFF * DM, EFF, DM, (bf16*)(ws + WS_WDN) + (size_t)e * DM * EFF, 0, nullptr, scr, r % I8, lane); continue; }
        { const int r = it - E8, blk = r / (2 * I9), which = (r / I9) & 1; const float* src = (const float*)args.in[which ? I_LRU_WX : I_LRU_WA] + (size_t)blk * 128 * 128;
          transpose_item<0>(src, 128, 128, (bf16*)(ws + WS_WLRU) + (size_t)blk * 256 * 128, which * 128, nullptr, scr, r % I9, lane); }
    }
    { const float* wg = (const float*)args.in[I_W_GROUP]; const float* wr_ = (const float*)args.in[I_W_ROUTER]; const float* gf = (const float*)args.in[I_NORM_FFN]; bf16* dst = (bf16*)(ws + WS_WRT);
      for (int idx = gw * 64 + lane; idx < 256 * DM; idx += NGW * 64) { const int n = idx >> 10, k = idx & 1023; float v = 0.f;
          if (n < 4) v = wg[k * 4 + n] * gf[k]; else if (n < 36) v = wr_[k * 32 + (n - 4)] * gf[k];
          dst[idx] = (bf16)(cvt_pk_bf16(v, 0.f) & 0xffffu); } }
    { const int* pos = (const int*)args.in[I_POS]; float* rope = (float*)(ws + WS_ROPE);
      for (int idx = gw * 64 + lane; idx < MTOK * 8; idx += NGW * 64) { const int row = idx >> 3, i = idx & 7;
          const float invf = expf(-13.122363377404328f * (float)i * 0.125f); float sn, cs; sincosf((float)pos[row] * invf, &sn, &cs);
          rope[(size_t)row * 16 + i] = cs; rope[(size_t)row * 16 + 8 + i] = sn; } }
    for (int m = gw; m < MTOK; m += 2 * NGW) {
        rms_row_to_i8((const float*)args.in[I_X] + (size_t)m * DM, (const float*)args.in[I_NORM_MIX], ws + WS_XN + (size_t)m * DM, (float*)(ws + WS_XS) + m, lane);
        if (m + NGW < MTOK) rms_row_to_i8((const float*)args.in[I_X] + (size_t)(m + NGW) * DM, (const float*)args.in[I_NORM_MIX], ws + WS_XN + (size_t)(m + NGW) * DM, (float*)(ws + WS_XS) + m + NGW, lane); }
    for (int m = gw; m < MEMROWS; m += NGW) rms_row_to_bf16((const float*)args.in[I_MEM] + (size_t)m * DM, (const float*)args.in[I_NORM_MEM], (bf16*)(ws + WS_MEMN) + (size_t)m * DM, lane);
}

__device__ __forceinline__ void qk16_process(const bf16* p, bf16* po, const float (&g)[16], const float (&cs)[8], const float (&sn)[8], int lane) {
    const u32x4 w0 = *(const u32x4*)p, w1 = *(const u32x4*)(p + 8);
    float v[16] = { bflo(w0.x), bfhi(w0.x), bflo(w0.y), bfhi(w0.y), bflo(w0.z), bfhi(w0.z), bflo(w0.w), bfhi(w0.w), bflo(w1.x), bfhi(w1.x), bflo(w1.y), bfhi(w1.y), bflo(w1.z), bfhi(w1.z), bflo(w1.w), bfhi(w1.w) };
    float ss = 0.f;
#pragma unroll
    for (int d = 0; d < 16; ++d) ss += v[d] * v[d];
    ss += __shfl_xor(ss, 1); ss += __shfl_xor(ss, 2);
    const float rstd = rsqrtf(ss * (1.f / 64.f) + EPS);
#pragma unroll
    for (int d = 0; d < 16; ++d) v[d] = v[d] * rstd * g[d];
    if ((lane & 3) == 0) {
#pragma unroll
        for (int i = 0; i < 8; ++i) { const float x1 = v[i], x2 = v[8 + i]; v[i] = x1 * cs[i] - x2 * sn[i]; v[8 + i] = x2 * cs[i] + x1 * sn[i]; } }
    u32x4 o0, o1; o0.x = cvt_pk_bf16(v[0], v[1]); o0.y = cvt_pk_bf16(v[2], v[3]); o0.z = cvt_pk_bf16(v[4], v[5]); o0.w = cvt_pk_bf16(v[6], v[7]);
    o1.x = cvt_pk_bf16(v[8], v[9]); o1.y = cvt_pk_bf16(v[10], v[11]); o1.z = cvt_pk_bf16(v[12], v[13]); o1.w = cvt_pk_bf16(v[14], v[15]);
    *(u32x4*)po = o0; *(u32x4*)(po + 8) = o1;
}
__device__ __forceinline__ void qknorm_phase(const bf16* Q, const bf16* Kb, bf16* Qo, bf16* Ko, const int* pos, const float* qg, const float* kg, int gw, int NGW, int lane) {
    float gq[16], gk[16];
#pragma unroll
    for (int d = 0; d < 16; ++d) { gq[d] = qg[16 * (lane & 3) + d] * (0.125f * LOG2E); gk[d] = kg[16 * (lane & 3) + d]; }
    const float invf = expf(-13.122363377404328f * (float)(lane & 7) * 0.125f);
    for (int row = gw; row < MTOK; row += NGW) {
        const float ang = (float)pos[row] * invf; float s_, c_; sincosf(ang, &s_, &c_);
        float cs[8], sn[8];
#pragma unroll
        for (int i = 0; i < 8; ++i) { cs[i] = __uint_as_float(__builtin_amdgcn_readlane(__float_as_uint(c_), i)); sn[i] = __uint_as_float(__builtin_amdgcn_readlane(__float_as_uint(s_), i)); }
        qk16_process(Q + (size_t)row * DM + 16 * lane, Qo + (size_t)row * DM + 16 * lane, gq, cs, sn, lane);
        qk16_process(Kb + (size_t)row * DM + 16 * lane, Ko + (size_t)row * DM + 16 * lane, gk, cs, sn, lane);
    }
}
__device__ __forceinline__ void headnorm128_phase(const bf16* X, bf16* Xo, int pitch, int nrows, const float* g, float scale, int gw, int NGW, int lane) {
    float gg[8];
#pragma unroll
    for (int e = 0; e < 8; ++e) gg[e] = g[8 * (lane & 15) + e] * scale;
    for (int row = gw; row < nrows; row += NGW) {
        const bf16* p = X + (size_t)row * pitch + 8 * lane; const u32x4 w = *(const u32x4*)p;
        float v[8] = { bflo(w.x), bfhi(w.x), bflo(w.y), bfhi(w.y), bflo(w.z), bfhi(w.z), bflo(w.w), bfhi(w.w) };
        float ss = 0.f;
#pragma unroll
        for (int e = 0; e < 8; ++e) ss += v[e] * v[e];
        ss += __shfl_xor(ss, 1); ss += __shfl_xor(ss, 2); ss += __shfl_xor(ss, 4); ss += __shfl_xor(ss, 8);
        const float rstd = rsqrtf(ss * (1.f / 128.f) + EPS);
        u32x4 o; o.x = cvt_pk_bf16(v[0] * rstd * gg[0], v[1] * rstd * gg[1]); o.y = cvt_pk_bf16(v[2] * rstd * gg[2], v[3] * rstd * gg[3]);
        o.z = cvt_pk_bf16(v[4] * rstd * gg[4], v[5] * rstd * gg[5]); o.w = cvt_pk_bf16(v[6] * rstd * gg[6], v[7] * rstd * gg[7]);
        *(u32x4*)(Xo + (size_t)row * pitch + 8 * lane) = o;
    }
}

constexpr int LRU_RAW = 0, LRU_RAWP = 528  , LRU_XC = 128 * LRU_RAWP, LRU_XCP = 272, LRU_GG = LRU_XC + 64 * 272, LRU_GGP = 144, LRU_UT = LRU_GG + 2 * 64 * 144;
static_assert(LRU_UT + 64 * 144 <= RING_BYTES, "LRU LDS map");
__device__ __forceinline__ float dpp_shr(float v, float old, int n) {
    const int o = __float_as_int(old), s = __float_as_int(v); int r;
    switch (n) { case 1: r = __builtin_amdgcn_update_dpp(o, s, 0x111, 0xf, 0xf, false); break; case 2: r = __builtin_amdgcn_update_dpp(o, s, 0x112, 0xf, 0xf, false); break;
                 case 4: r = __builtin_amdgcn_update_dpp(o, s, 0x114, 0xf, 0xf, false); break; default: r = __builtin_amdgcn_update_dpp(o, s, 0x118, 0xf, 0xf, false); break; }
    return __int_as_float(r);
}
__device__ __forceinline__ void lru_phase(const Args& args, LAS unsigned char* lds, int vcu, int G) {
    unsigned char* ws = args.ws;
    const int tid = threadIdx.x, lane = tid & 63, wid = __builtin_amdgcn_readfirstlane(tid >> 6), j16 = lane & 15, g4 = lane >> 4;
    const bf16* LIN = (const bf16*)(ws + WS_LIN); const bf16* GGb = (const bf16*)(ws + WS_GG); bf16* U = (bf16*)(ws + WS_U);
    const float* convw = (const float*)args.in[I_CONV_W]; const float* convb = (const float*)args.in[I_CONV_B];
    for (int unit = vcu; unit < NB * 16; unit += G) {
        const int b = unit >> 4, n = (unit >> 1) & 7, hh = unit & 1;
        const int cg = tid & 15;
        float cw[4][8], cb[8];
#pragma unroll
        for (int e = 0; e < 8; ++e) { cb[e] = convb[128 * n + 8 * cg + e];
#pragma unroll
            for (int k = 0; k < 4; ++k) cw[k][e] = convw[k * DM + 128 * n + 8 * cg + e]; }
        bf16x8 wf[4];
        { const int i = j16, grp = i >> 2, chl = (grp >> 1) * 4 + (i & 3), iswx = grp & 1, col = iswx * 128 + 64 * hh + 8 * wid + chl;
          const bf16* wp = (const bf16*)(ws + WS_WLRU) + ((size_t)n * 256 + col) * 128 + 8 * g4;
#pragma unroll
          for (int ks = 0; ks < 4; ++ks) wf[ks] = *(const bf16x8*)(wp + 32 * ks); }
        const int chl0 = 8 * wid + 4 * (g4 >> 1) + 2 * (g4 & 1);
        const int chg0 = 128 * n + 64 * hh + chl0;
        float ba[2], bx[2], sp8[2];
#pragma unroll
        for (int q = 0; q < 2; ++q) { ba[q] = ((const float*)args.in[I_LRU_BA])[chg0 + q]; bx[q] = ((const float*)args.in[I_LRU_BX])[chg0 + q];
            const float lam = ((const float*)args.in[I_LRU_LAMBDA])[chg0 + q]; sp8[q] = 8.0f * log1pf(expf(-lam)); }
        float hprev[2] = {0.f, 0.f};
        const size_t rowbase = (size_t)b * SEQ;
        const int lrow[2] = { tid >> 4, (tid + 512) >> 4 }, lpc = tid & 15;
        const int grow = tid >> 3, gpc = tid & 7, grho = (grow & 3) * 16 + (grow >> 2);
        u32x4 rl[2], rg;
#define LRU_FILL(row_, pc_, w_) do { LAS unsigned char* d_ = lds + LRU_RAW + (row_) * LRU_RAWP + (pc_) * 16; \
            *(LAS f32x4*)d_ = (f32x4){bflo((w_).x), bfhi((w_).x), bflo((w_).y), bfhi((w_).y)}; *(LAS f32x4*)(d_ + 256) = (f32x4){bflo((w_).z), bfhi((w_).z), bflo((w_).w), bfhi((w_).w)}; } while (0)
        if (tid < 3 * 32) *(LAS u32x4*)(lds + LRU_RAW + (125 + tid / 32) * LRU_RAWP + (tid & 31) * 16) = (u32x4){0u, 0u, 0u, 0u};
#pragma unroll
        for (int i = 0; i < 2; ++i) rl[i] = *(const u32x4*)(LIN + (rowbase + lrow[i]) * DM + 128 * n + 8 * lpc);
        rg = *(const u32x4*)(GGb + (rowbase + grow) * DM + 128 * n + 64 * hh + 8 * gpc);
#pragma unroll
        for (int i = 0; i < 2; ++i) LRU_FILL(lrow[i], lpc, rl[i]);
        *(LAS u32x4*)(lds + LRU_GG + grho * LRU_GGP + gpc * 16) = rg;
#pragma unroll
        for (int i = 0; i < 2; ++i) rl[i] = *(const u32x4*)(LIN + (rowbase + 64 + lrow[i]) * DM + 128 * n + 8 * lpc);
        rg = *(const u32x4*)(GGb + (rowbase + 64 + grow) * DM + 128 * n + 64 * hh + 8 * gpc);
        __syncthreads();
        for (int it = 0; it < SEQ / 64; ++it) {
            const int t0 = 64 * it;
#pragma unroll
            for (int i = 0; i < 2; ++i) { const int t = (tid >> 4) + 32 * i; f32x2 a2[4];
#pragma unroll
                for (int e = 0; e < 4; ++e) a2[e] = (f32x2){cb[2 * e], cb[2 * e + 1]};
#pragma unroll
                for (int k = 0; k < 4; ++k) { const int rr = (t0 + t - 3 + k) & 127; const LAS unsigned char* rp_ = lds + LRU_RAW + rr * LRU_RAWP + cg * 16;
                    const f32x4 xa = *(const LAS f32x4*)rp_, xb4 = *(const LAS f32x4*)(rp_ + 256);
                    a2[0] = __builtin_elementwise_fma((f32x2){cw[k][0], cw[k][1]}, (f32x2){xa.x, xa.y}, a2[0]); a2[1] = __builtin_elementwise_fma((f32x2){cw[k][2], cw[k][3]}, (f32x2){xa.z, xa.w}, a2[1]);
                    a2[2] = __builtin_elementwise_fma((f32x2){cw[k][4], cw[k][5]}, (f32x2){xb4.x, xb4.y}, a2[2]); a2[3] = __builtin_elementwise_fma((f32x2){cw[k][6], cw[k][7]}, (f32x2){xb4.z, xb4.w}, a2[3]); }
                u32x4 o; o.x = cvt_pk_bf16(a2[0].x, a2[0].y); o.y = cvt_pk_bf16(a2[1].x, a2[1].y); o.z = cvt_pk_bf16(a2[2].x, a2[2].y); o.w = cvt_pk_bf16(a2[3].x, a2[3].y);
                const int rho = (t & 3) * 16 + (t >> 2);
                *(LAS u32x4*)(lds + LRU_XC + rho * LRU_XCP + cg * 16) = o; }
            __syncthreads();
            if (it + 1 < SEQ / 64) {
#pragma unroll
                for (int i = 0; i < 2; ++i) LRU_FILL((t0 + 64 + lrow[i]) & 127, lpc, rl[i]);
                *(LAS u32x4*)(lds + LRU_GG + ((it + 1) & 1) * 64 * LRU_GGP + grho * LRU_GGP + gpc * 16) = rg;
                if (it + 2 < SEQ / 64) {
#pragma unroll
                    for (int i = 0; i < 2; ++i) rl[i] = *(const u32x4*)(LIN + (rowbase + t0 + 128 + lrow[i]) * DM + 128 * n + 8 * lpc);
                    rg = *(const u32x4*)(GGb + (rowbase + t0 + 128 + grow) * DM + 128 * n + 64 * hh + 8 * gpc); } }
            f32x4 acc[4];
#pragma unroll
            for (int tb = 0; tb < 4; ++tb) { acc[tb] = (f32x4){0.f, 0.f, 0.f, 0.f};
#pragma unroll
                for (int ks = 0; ks < 4; ++ks) { const bf16x8 xf = *(const LAS bf16x8*)(lds + LRU_XC + (tb * 16 + j16) * LRU_XCP + (32 * ks + 8 * g4) * 2);
                    acc[tb] = __builtin_amdgcn_mfma_f32_16x16x32_bf16(wf[ks], xf, acc[tb], 0, 0, 0); } }
            float pr[4][2], pi[4][2];
#pragma unroll
            for (int tb = 0; tb < 4; ++tb)
#pragma unroll
                for (int q = 0; q < 2; ++q) {
                    const auto sw_ = __builtin_amdgcn_permlane16_swap(__float_as_uint(acc[tb][q]), __float_as_uint(acc[tb][2 + q]), false, false);
                    pr[tb][q] = __uint_as_float(sw_[0]); pi[tb][q] = __uint_as_float(sw_[1]); }
            const LAS unsigned char* ggp = lds + LRU_GG + (it & 1) * 64 * LRU_GGP;
            unsigned uo[4];
            f32x2 hq2[4];
            { const f32x2 ba2 = (f32x2){ba[0], ba[1]}, bx2 = (f32x2){bx[0], bx[1]}, nsp2 = (f32x2){-sp8[0], -sp8[1]};
              f32x2 a2v[4], bb2[4];
#pragma unroll
              for (int tb = 0; tb < 4; ++tb) {
                  const f32x2 zr = ((f32x2){pr[tb][0], pr[tb][1]} + ba2) * (-LOG2E), zi = ((f32x2){pi[tb][0], pi[tb][1]} + bx2) * (-LOG2E);
                  const f32x2 er = (f32x2){fast_exp2(zr.x), fast_exp2(zr.y)} + 1.0f, ei = (f32x2){fast_exp2(zi.x), fast_exp2(zi.y)} + 1.0f;
                  const f32x2 r = (f32x2){fast_rcp(er.x), fast_rcp(er.y)}, ig = (f32x2){fast_rcp(ei.x), fast_rcp(ei.y)};
                  const f32x2 la = nsp2 * r, lal = la * LOG2E, x2v = la + la;
                  const f32x2 av = (f32x2){fast_exp2(lal.x), fast_exp2(lal.y)}; a2v[tb] = av;
                  f32x2 pe = x2v * 0.0013888889f + 0.0083333338f; pe = pe * x2v + 0.041666668f; pe = pe * x2v + 0.16666667f; pe = pe * x2v + 0.5f; pe = pe * x2v + 1.0f;
                  f32x2 emv = -x2v * pe;
                  if (__builtin_amdgcn_ballot_w64(fminf(x2v.x, x2v.y) <= -0.25f) != 0ull) { const f32x2 dv = 1.0f - av * av;
                      emv.x = x2v.x > -0.25f ? emv.x : dv.x; emv.y = x2v.y > -0.25f ? emv.y : dv.y; }
                  const f32x2 coef = (f32x2){__builtin_amdgcn_sqrtf(emv.x), __builtin_amdgcn_sqrtf(emv.y)};
                  const unsigned xw = *(const LAS unsigned*)(lds + LRU_XC + (tb * 16 + j16) * LRU_XCP + (64 * hh + chl0) * 2);
                  bb2[tb] = coef * ig * (f32x2){bflo(xw), bfhi(xw)}; }
              f32x2 A = a2v[0], H = bb2[0];
#pragma unroll
              for (int tb = 1; tb < 4; ++tb) { H = __builtin_elementwise_fma(a2v[tb], H, bb2[tb]); A = A * a2v[tb]; }
#pragma unroll
              for (int sft = 1; sft < 16; sft <<= 1) { const f32x2 As = (f32x2){dpp_shr(A.x, 1.0f, sft), dpp_shr(A.y, 1.0f, sft)}, Hs = (f32x2){dpp_shr(H.x, 0.0f, sft), dpp_shr(H.y, 0.0f, sft)};
                  H = __builtin_elementwise_fma(A, Hs, H); A = A * As; }
              const f32x2 Aex = (f32x2){dpp_shr(A.x, 1.0f, 1), dpp_shr(A.y, 1.0f, 1)}, Hex = (f32x2){dpp_shr(H.x, 0.0f, 1), dpp_shr(H.y, 0.0f, 1)};
              f32x2 h = __builtin_elementwise_fma(Aex, (f32x2){hprev[0], hprev[1]}, Hex);
#pragma unroll
              for (int tb = 0; tb < 4; ++tb) { h = __builtin_elementwise_fma(a2v[tb], h, bb2[tb]); hq2[tb] = h; }
              hprev[0] = __shfl(h.x, (lane & 48) | 15); hprev[1] = __shfl(h.y, (lane & 48) | 15);
            }
#pragma unroll
            for (int tb = 0; tb < 4; ++tb) { const unsigned gw2 = *(const LAS unsigned*)(ggp + (tb * 16 + j16) * LRU_GGP + chl0 * 2);
                const f32x2 gv = (f32x2){bflo(gw2), bfhi(gw2)};
                const f32x2 uu = (gv + (gv * gv * gv) * 0.044715f) * (-2.0f * 0.7978845608028654f * LOG2E);
                const f32x2 den = (f32x2){fast_exp2(uu.x), fast_exp2(uu.y)} + 1.0f;
                const f32x2 outv = hq2[tb] * gv * (f32x2){fast_rcp(den.x), fast_rcp(den.y)};
                uo[tb] = cvt_pk_bf16(outv.x, outv.y);
                *(LAS unsigned*)(lds + LRU_UT + (tb * 16 + j16) * LRU_GGP + chl0 * 2) = uo[tb]; }
            __syncthreads();
            { const u32x4 v = *(const LAS u32x4*)(lds + LRU_UT + grho * LRU_GGP + gpc * 16);
              *(u32x4*)(U + (rowbase + t0 + grow) * DM + 128 * n + 64 * hh + 8 * gpc) = v; }
        }
        __syncthreads();
    }
}

constexpr int AT_SLOT = 32768, AT_V = 16384, AT_STG = 3 * AT_SLOT;
static_assert(AT_STG + 8 * 4096 <= RING_BYTES, "attention LDS map");
__device__ __forceinline__ void glds16(const void* gsrc, unsigned lds_dst) { unsigned keep;
    asm volatile("s_mov_b32 %0, m0\n\ts_mov_b32 m0, %2\n\ts_nop 0\n\tglobal_load_lds_dwordx4 %1, off\n\ts_mov_b32 m0, %0" : "=&s"(keep) : "v"(gsrc), "s"(lds_dst) : "memory"); }
__device__ __forceinline__ int crow(int r, int hi) { return (r & 3) + 8 * (r >> 2) + 4 * hi; }
typedef short v4i16_t __attribute__((ext_vector_type(4)));
__device__ __forceinline__ s16x4 vtr(const LAS unsigned char* p) { return __builtin_bit_cast(s16x4, __builtin_amdgcn_ds_read_tr16_b64_v4i16((LAS v4i16_t*)p)); }

template <int K> __device__ __forceinline__ float swz_xor(float v) { return __int_as_float(__builtin_amdgcn_ds_swizzle(__float_as_int(v), (K << 10) | 0x1f)); }
__device__ __forceinline__ float xor32_sum(float v) { auto rr = __builtin_amdgcn_permlane32_swap(__float_as_uint(v), __float_as_uint(v), false, false); return __uint_as_float(rr[0]) + __uint_as_float(rr[1]); }
template <int NMAP>
__device__ __forceinline__ void attn_unit(LAS unsigned char* ldsb, const bf16* Qw  , int pitchQ,
                                          const bf16* Kp, int pitchK, const bf16* Vp, int pitchV, int NT, int ntv,
                                          bf16* Ow, int pitchO, float cref, float lam, const float* subln, float oscale, const float* qgain = nullptr, float qscale = 1.0f) {
    int tid = threadIdx.x; asm volatile("" : "+v"(tid));
    const int lane = tid & 63, r32 = lane & 31, hi = lane >> 5; const int wid = __builtin_amdgcn_readfirstlane(tid >> 6);
    const unsigned lds0 = (unsigned)(size_t)ldsb;
    constexpr int NQR = (NMAP == 2) ? 4 : 8;
    bf16x8 qr[NQR];
#pragma unroll
    for (int j = 0; j < NQR; ++j) qr[j] = *(const bf16x8*)(Qw + (size_t)r32 * pitchQ + 16 * j + 8 * hi);
    if (NMAP == 1 && qgain) {
        float ss = 0.f;
#pragma unroll
        for (int j = 0; j < 8; ++j) { const u32x4 w = __builtin_bit_cast(u32x4, qr[j]);
            ss += bflo(w.x) * bflo(w.x) + bfhi(w.x) * bfhi(w.x) + bflo(w.y) * bflo(w.y) + bfhi(w.y) * bfhi(w.y) + bflo(w.z) * bflo(w.z) + bfhi(w.z) * bfhi(w.z) + bflo(w.w) * bflo(w.w) + bfhi(w.w) * bfhi(w.w); }
        ss = xor32_sum(ss);
        const float rs = rsqrtf(ss * (1.f / 128.f) + EPS) * qscale;
#pragma unroll
        for (int j = 0; j < 8; ++j) { const u32x4 w = __builtin_bit_cast(u32x4, qr[j]); const f32x4 g0 = *(const f32x4*)(qgain + 16 * j + 8 * hi), g1 = *(const f32x4*)(qgain + 16 * j + 8 * hi + 4);
            u32x4 o; o.x = cvt_pk_bf16(bflo(w.x) * rs * g0[0], bfhi(w.x) * rs * g0[1]); o.y = cvt_pk_bf16(bflo(w.y) * rs * g0[2], bfhi(w.y) * rs * g0[3]);
            o.z = cvt_pk_bf16(bflo(w.z) * rs * g1[0], bfhi(w.z) * rs * g1[1]); o.w = cvt_pk_bf16(bflo(w.w) * rs * g1[2], bfhi(w.w) * rs * g1[3]);
            qr[j] = __builtin_bit_cast(bf16x8, o); }
    }
    const LAS unsigned char* qpark = ldsb + AT_STG + wid * 4096 + lane * 16;
    if (NMAP == 2) {
#pragma unroll
        for (int j = 4; j < 8; ++j) { const bf16x8 t_ = *(const bf16x8*)(Qw + (size_t)r32 * pitchQ + 16 * j + 8 * hi); *(LAS bf16x8*)(ldsb + AT_STG + wid * 4096 + lane * 16 + (j - 4) * 1024) = t_; } }
    const bf16* ksrc = Kp + (size_t)lane * pitchK + wid * 8;
    const bf16* vsrc = Vp + (size_t)(16 * (wid & 3) + (lane >> 2)) * pitchV + (wid >> 2) * 32 + (lane & 3) * 8;
#define AT_DMA(t, slot) do { const unsigned _sb = lds0 + (unsigned)(slot) * AT_SLOT; \
        glds16(ksrc + (size_t)(t) * 64 * pitchK, (unsigned)__builtin_amdgcn_readfirstlane(_sb + wid * 1024)); \
        glds16(ksrc + (size_t)(t) * 64 * pitchK + 64, (unsigned)__builtin_amdgcn_readfirstlane(_sb + (wid + 8) * 1024)); \
        glds16(vsrc + (size_t)(t) * 64 * pitchV, (unsigned)__builtin_amdgcn_readfirstlane(_sb + AT_V + wid * 1024)); \
        glds16(vsrc + (size_t)(t) * 64 * pitchV + 64, (unsigned)__builtin_amdgcn_readfirstlane(_sb + AT_V + (wid + 8) * 1024)); } while (0)
    const LAS unsigned char* kp0 = ldsb + hi * 1024 + r32 * 16;
    const LAS unsigned char* vp0 = ldsb + AT_V + ((lane >> 4) & 1) * 32 + (lane & 3) * 8 + (4 * hi + ((lane & 15) >> 2)) * 64;
    f32x16 o[NMAP][4];
#pragma unroll
    for (int m = 0; m < NMAP; ++m)
#pragma unroll
        for (int d = 0; d < 4; ++d) o[m][d] = (f32x16){};
    float lsum[NMAP];
#pragma unroll
    for (int m = 0; m < NMAP; ++m) lsum[m] = 0.f;
    AT_DMA(0, 0);
    if (NT > 1) AT_DMA(1, 1);
    int slot = 0;
#pragma unroll 1
    for (int t = 0; t < NT; ++t) {
        if (t + 1 < NT) asm volatile("s_waitcnt vmcnt(4)" ::: "memory"); else asm volatile("s_waitcnt vmcnt(0)" ::: "memory");
        __builtin_amdgcn_s_barrier(); asm volatile("" ::: "memory");
        if (t + 2 < NT) { const int s2 = slot == 0 ? 2 : slot - 1; AT_DMA(t + 2, s2); }
        if (t < ntv) {
            const LAS unsigned char* kp = kp0 + slot * AT_SLOT; const LAS unsigned char* vp = vp0 + slot * AT_SLOT;
#define AT_SB() __builtin_amdgcn_sched_barrier(0)
#pragma unroll
            for (int m = 0; m < NMAP; ++m) {
                constexpr int JN = 8 / NMAP;
#pragma unroll
                for (int hk = 0; hk < 2; ++hk) {
                    f32x16 p = (f32x16){};
                    bf16x8 kb = *(const LAS bf16x8*)(kp + (m * JN) * 2048 + hk * 512);
                    AT_SB();
#pragma unroll
                    for (int jj = 0; jj < JN; ++jj) { const int j = m * JN + jj; bf16x8 nb = kb;
                        if (jj + 1 < JN) nb = *(const LAS bf16x8*)(kp + (j + 1) * 2048 + hk * 512);
                        const bf16x8 qf = (NMAP == 2 && m == 1) ? *(const LAS bf16x8*)(qpark + jj * 1024) : qr[(NMAP == 2 && m == 1) ? 0 : j];
                        p = __builtin_amdgcn_mfma_f32_32x32x16_bf16(kb, qf, p, 0, 0, 0);
                        AT_SB(); kb = nb; }
                    s16x4 lo = vtr(vp + (2 * hk) * 1024), hh = vtr(vp + (2 * hk) * 1024 + 512);
                    float s = 0.f;
#pragma unroll
                    for (int r = 0; r < 16; ++r) { p[r] = fast_exp2(p[r]); s += p[r]; }
                    lsum[m] += s;
                    u32x4 pw[2];
                    pw[0] = (u32x4){cvt_pk_bf16(p[0], p[1]), cvt_pk_bf16(p[2], p[3]), cvt_pk_bf16(p[4], p[5]), cvt_pk_bf16(p[6], p[7])};
                    pw[1] = (u32x4){cvt_pk_bf16(p[8], p[9]), cvt_pk_bf16(p[10], p[11]), cvt_pk_bf16(p[12], p[13]), cvt_pk_bf16(p[14], p[15])};
                    AT_SB();
#pragma unroll
                    for (int idx = 0; idx < 8; ++idx) { const int d0 = idx >> 1, ksl = idx & 1;
                        const bf16x8 vf = (bf16x8){lo[0], lo[1], lo[2], lo[3], hh[0], hh[1], hh[2], hh[3]};
                        if (idx + 1 < 8) { const int nd0 = (idx + 1) >> 1, nks = 2 * hk + ((idx + 1) & 1); lo = vtr(vp + (nd0 * 4 + nks) * 1024); hh = vtr(vp + (nd0 * 4 + nks) * 1024 + 512); }
                        o[m][d0] = __builtin_amdgcn_mfma_f32_32x32x16_bf16(__builtin_bit_cast(bf16x8, pw[ksl]), vf, o[m][d0], 0, 0, 0);
                        AT_SB(); }
                }
            }
#undef AT_SB
        }
        slot = slot == 2 ? 0 : slot + 1;
    }
#undef AT_DMA
    int hie = hi, r32e = r32, lanee = lane;
    asm volatile("" : "+v"(hie), "+v"(r32e), "+v"(lanee));
    float inv[NMAP];
#pragma unroll
    for (int m = 0; m < NMAP; ++m) { const float l = xor32_sum(lsum[m]); inv[m] = 1.0f / l; }
    float gsub[4];
#pragma unroll
    for (int d0 = 0; d0 < 4; ++d0) gsub[d0] = (NMAP == 2) ? subln[32 * d0 + r32e] * oscale : oscale;
    LAS bf16* stg = (LAS bf16*)(ldsb + AT_STG + wid * 4096);
#pragma unroll
    for (int half = 0; half < 2; ++half) {
#pragma unroll
        for (int rr = 0; rr < 8; ++rr) { const int r = half * 8 + rr; const int orow = crow(r, hie);
            const float i0 = __shfl(inv[0], orow); float val[4];
            if (NMAP == 2) { const float i1 = __shfl(inv[NMAP - 1], orow) * lam; float ss = 0.f;
#pragma unroll
                for (int d0 = 0; d0 < 4; ++d0) { val[d0] = o[0][d0][r] * i0 - o[NMAP - 1][d0][r] * i1; ss += val[d0] * val[d0]; }
                ss += swz_xor<1>(ss); ss += swz_xor<2>(ss); ss += swz_xor<4>(ss); ss += swz_xor<8>(ss); ss += swz_xor<16>(ss);
                const float rstd = rsqrtf(ss * (1.f / 128.f) + EPS);
#pragma unroll
                for (int d0 = 0; d0 < 4; ++d0) val[d0] *= rstd;
            } else {
#pragma unroll
                for (int d0 = 0; d0 < 4; ++d0) val[d0] = o[0][d0][r] * i0; }
#pragma unroll
            for (int d0 = 0; d0 < 4; ++d0) stg[(orow & 15) * 128 + d0 * 32 + r32e] = (bf16)(cvt_pk_bf16(val[d0] * gsub[d0], 0.f) & 0xffffu);
            __builtin_amdgcn_sched_barrier(0); }
        LDS_WAIT();
#pragma unroll
        for (int i = 0; i < 4; ++i) { const int id = i * 64 + lanee, row = id >> 4, ch = id & 15; const u32x4 v = *(const LAS u32x4*)(stg + row * 128 + ch * 8);
            *(u32x4*)(Ow + (size_t)(16 * half + row) * pitchO + ch * 8) = v; }
        LDS_WAIT();
    }
    asm volatile("s_waitcnt lgkmcnt(0)" ::: "memory"); __builtin_amdgcn_s_barrier(); asm volatile("" ::: "memory");
}

__device__ __forceinline__ float softmax_cref(const float* gq, const float* gk, int n, float dotscale, int lane) {
    float a = 0.f, b = 0.f;
    for (int d = lane; d < n; d += 64) { a = fmaxf(a, fabsf(gq[d])); b = fmaxf(b, fabsf(gk[d])); }
    a = wave_max(a); b = wave_max(b);
    return fmaxf(0.f, (float)n * dotscale * a * b * LOG2E - 100.f);
}

#ifndef PROBE_VAR
#define PROBE_VAR 0
#endif
constexpr int A2_KS = 16384, A2_V = 3 * 16384, A2_NV = 5;
static_assert(A2_V + A2_NV * 16384 <= RING_BYTES, "attention LDS map");
#define A2_SB() __builtin_amdgcn_sched_barrier(0)
#define A2_ITER(t, PC0, PC1, PN0, PN1, PW, PWN) do { \
        if ((t) < NT) { \
            if ((t) + 1 < NT) asm volatile("s_waitcnt vmcnt(4)" ::: "memory"); else asm volatile("s_waitcnt vmcnt(0)" ::: "memory"); \
            __builtin_amdgcn_s_barrier(); asm volatile("" ::: "memory"); \
            if ((t) + 2 < NT) { A2_DMA((t) + 2, ((t) + 2) % 3, ((t) + 2) % A2_NV); } \
        } \
        const bool vis_ = (t) < ntv; \
        const LAS unsigned char* kp_ = ldsb + ((t) % 3) * A2_KS; \
        const LAS unsigned char* vp_ = vp0 + (((t) >= 2 ? (t) - 2 : 0) % A2_NV) * 16384; \
        PN0 = (f32x16){}; PN1 = (f32x16){}; \
        bf16x8 kq_[2]; s16x4 vl_[2], vh_[2]; \
        kq_[0] = *(const LAS bf16x8*)(kp_ + kad[0]); kq_[1] = *(const LAS bf16x8*)(kp_ + kad[0] + 8192); \
        _Pragma("unroll") for (int i_ = 0; i_ < 2; ++i_) { vl_[i_] = vtr(vp_ + (i_ * 4) * 1024); vh_[i_] = vtr(vp_ + (i_ * 4) * 1024 + 512); } \
        A2_SB(); \
        _Pragma("unroll") for (int i_ = 0; i_ < 8; ++i_) { \
            { const bf16x8 kf_ = kq_[i_ & 1]; \
              if (i_ + 2 < 8) kq_[i_ & 1] = *(const LAS bf16x8*)(kp_ + kad[(i_ + 2) >> 1] + ((i_ + 2) & 1) * 8192); \
              if (vis_) { if (i_ & 1) PN1 = __builtin_amdgcn_mfma_f32_32x32x16_bf16(kf_, qr[i_ >> 1], PN1, 0, 0, 0); else PN0 = __builtin_amdgcn_mfma_f32_32x32x16_bf16(kf_, qr[i_ >> 1], PN0, 0, 0, 0); } \
              if (i_ == 0) KEEP_AB(PN0, kf_, qr[0]); if (i_ == 1) KEEP_AB(PN1, kf_, qr[0]); } \
            _Pragma("unroll") for (int h_ = 0; h_ < 2; ++h_) { const int s_ = 2 * i_ + h_; \
              const bf16x8 vf_ = (bf16x8){vl_[s_ & 1][0], vl_[s_ & 1][1], vl_[s_ & 1][2], vl_[s_ & 1][3], vh_[s_ & 1][0], vh_[s_ & 1][1], vh_[s_ & 1][2], vh_[s_ & 1][3]}; \
              if (s_ + 2 < 16) { const int pc_ = ((s_ + 2) & 3) * 4 + ((s_ + 2) >> 2); vl_[s_ & 1] = vtr(vp_ + pc_ * 1024); vh_[s_ & 1] = vtr(vp_ + pc_ * 1024 + 512); } \
              o[s_ & 3] = __builtin_amdgcn_mfma_f32_32x32x16_bf16(__builtin_bit_cast(bf16x8, PW[s_ >> 2]), vf_, o[s_ & 3], 0, 0, 0); } \
            { const float e0_ = fast_exp2(PC0[2 * i_]), e1_ = fast_exp2(PC0[2 * i_ + 1]), e2_ = fast_exp2(PC1[2 * i_]), e3_ = fast_exp2(PC1[2 * i_ + 1]); \
              s0 += e0_ + e1_; s1 += e2_ + e3_; \
              PWN[i_ >> 2][i_ & 3] = cvt_pk_bf16(e0_, e1_); PWN[2 + (i_ >> 2)][i_ & 3] = cvt_pk_bf16(e2_, e3_); } \
            A2_SB(); \
        } \
        if (!vis_) { _Pragma("unroll") for (int r_ = 0; r_ < 16; ++r_) { PN0[r_] = -INFINITY; PN1[r_] = -INFINITY; } } \
    } while (0)
template <int VAR>
__device__ __forceinline__ void attn2_unit(LAS unsigned char* ldsb, const bf16* Qw  , const bf16* Kp, const bf16* Vp,
                                           int NT, int ntv, bf16* Ow  , float lam, const float* subln) {
    int tid = threadIdx.x; asm volatile("" : "+v"(tid));
    const int lane = tid & 63, r32 = lane & 31, hi = lane >> 5; const int wid = __builtin_amdgcn_readfirstlane(tid >> 6); const int g = wid & 3, m = wid >> 2;
    const unsigned lds0 = (unsigned)(size_t)ldsb;
    bf16x8 qr[4];
#pragma unroll
    for (int j = 0; j < 4; ++j) qr[j] = *(const bf16x8*)(Qw + (size_t)r32 * DM + 16 * j + 8 * hi);
    asm volatile("s_waitcnt vmcnt(0)" : "+v"(qr[0]), "+v"(qr[1]), "+v"(qr[2]), "+v"(qr[3]) :: "memory");
    const int kkey = 4 * wid + (lane >> 4);
    const bf16* ksrc = Kp + (size_t)kkey * DM + (((lane & 15) ^ (kkey & 15)) << 3);
    const bf16* vsrc = Vp + (size_t)(16 * (wid & 3) + (lane >> 2)) * DM + (wid >> 2) * 32 + (lane & 3) * 8;
#define A2_DMA(t, ks, vs) do { const unsigned _kb = lds0 + (unsigned)(ks) * A2_KS, _vb = lds0 + A2_V + (unsigned)(vs) * 16384; \
        glds16(ksrc + (size_t)(t) * 64 * DM, (unsigned)__builtin_amdgcn_readfirstlane(_kb + wid * 1024)); \
        glds16(ksrc + (size_t)((t) * 64 + 32) * DM, (unsigned)__builtin_amdgcn_readfirstlane(_kb + (wid + 8) * 1024)); \
        glds16(vsrc + (size_t)(t) * 64 * DM, (unsigned)__builtin_amdgcn_readfirstlane(_vb + wid * 1024)); \
        glds16(vsrc + (size_t)(t) * 64 * DM + 64, (unsigned)__builtin_amdgcn_readfirstlane(_vb + (wid + 8) * 1024)); } while (0)
    unsigned kad[4];
#pragma unroll
    for (int jj = 0; jj < 4; ++jj) kad[jj] = (unsigned)(r32 * 256 + ((((8 * m + 2 * jj + hi) ^ (r32 & 15))) << 4));
    const LAS unsigned char* vp0 = ldsb + A2_V + ((lane >> 4) & 1) * 32 + (lane & 3) * 8 + (4 * hi + ((lane & 15) >> 2)) * 64;
    f32x16 o[4];
#pragma unroll
    for (int d = 0; d < 4; ++d) o[d] = (f32x16){};
    float s0 = 0.f, s1 = 0.f;
    u32x4 pwA[4], pwB[4];
#pragma unroll
    for (int i = 0; i < 4; ++i) { pwA[i] = (u32x4){0u, 0u, 0u, 0u}; pwB[i] = (u32x4){0u, 0u, 0u, 0u}; }
    f32x16 pA0, pA1, pB0, pB1;
#pragma unroll
    for (int r = 0; r < 16; ++r) { pA0[r] = -INFINITY; pA1[r] = -INFINITY; pB0[r] = -INFINITY; pB1[r] = -INFINITY; }
    A2_DMA(0, 0, 0);
    if (NT > 1) A2_DMA(1, 1, 1);
#pragma unroll 1
    for (int t = 0; t < NT + 2; t += 2) {
        A2_ITER(t,     pA0, pA1, pB0, pB1, pwA, pwB);
        A2_ITER(t + 1, pB0, pB1, pA0, pA1, pwB, pwA);
    }
#undef A2_DMA
    asm volatile("s_waitcnt lgkmcnt(0)" ::: "memory"); __builtin_amdgcn_s_barrier(); asm volatile("" ::: "memory");
    int tid2 = threadIdx.x; asm volatile("" : "+v"(tid2));
    const int lanee = tid2 & 63, r32e = lanee & 31, hie = lanee >> 5;
    const float inv = 1.0f / xor32_sum(s0 + s1);
    LAS float* exch = (LAS float*)(ldsb + g * 16384) + lanee;
    if (m == 1) {
#pragma unroll
        for (int r = 0; r < 16; ++r) { const float ir = __shfl(inv, crow(r, hie)) * lam;
#pragma unroll
            for (int d0 = 0; d0 < 4; ++d0) exch[(d0 * 16 + r) * 64] = o[d0][r] * ir; }
    }
    asm volatile("s_waitcnt lgkmcnt(0)" ::: "memory"); __builtin_amdgcn_s_barrier(); asm volatile("" ::: "memory");
    if (m == 0) {
        float gsub[4];
#pragma unroll
        for (int d0 = 0; d0 < 4; ++d0) gsub[d0] = subln[32 * d0 + r32e] * 0.8f;
        LAS bf16* stg = (LAS bf16*)(ldsb + 65536 + g * 4096);
#pragma unroll
        for (int half = 0; half < 2; ++half) {
#pragma unroll
            for (int rr = 0; rr < 8; ++rr) { const int r = half * 8 + rr; const int orow = crow(r, hie);
                const float i0 = __shfl(inv, orow); float val[4]; float ss = 0.f;
#pragma unroll
                for (int d0 = 0; d0 < 4; ++d0) { val[d0] = o[d0][r] * i0 - exch[(d0 * 16 + r) * 64]; ss += val[d0] * val[d0]; }
                ss += swz_xor<1>(ss); ss += swz_xor<2>(ss); ss += swz_xor<4>(ss); ss += swz_xor<8>(ss); ss += swz_xor<16>(ss);
                const float rstd = rsqrtf(ss * (1.f / 128.f) + EPS);
#pragma unroll
                for (int d0 = 0; d0 < 4; ++d0) stg[(orow & 15) * 128 + d0 * 32 + r32e] = (bf16)(cvt_pk_bf16(val[d0] * rstd * gsub[d0], 0.f) & 0xffffu);
                __builtin_amdgcn_sched_barrier(0); }
            LDS_WAIT();
#pragma unroll
            for (int i = 0; i < 4; ++i) { const int id = i * 64 + lanee, row = id >> 4, ch = id & 15; const u32x4 v = *(const LAS u32x4*)(stg + row * 128 + ch * 8);
                *(u32x4*)(Ow + (size_t)(16 * half + row) * DM + ch * 8) = v; }
            LDS_WAIT();
        }
    }
    asm volatile("s_waitcnt lgkmcnt(0)" ::: "memory"); __builtin_amdgcn_s_barrier(); asm volatile("" ::: "memory");
}
__device__ __forceinline__ void diffattn_phase(const Args& args, LAS unsigned char* lds, int vcu, int G, bf16* Oreal, bf16* Odmy, int nrep) {
    unsigned char* ws = args.ws;
    const int lane = threadIdx.x & 63, wid = __builtin_amdgcn_readfirstlane(threadIdx.x >> 6), g = wid & 3, m = wid >> 2;
    const bf16* Q = (const bf16*)(ws + WS_Q); const bf16* Kb = (const bf16*)(ws + WS_K); const bf16* Vb = (const bf16*)(ws + WS_V);
    float lam;
    { const float a = ((const float*)args.in[I_LQ1])[lane] * ((const float*)args.in[I_LK1])[lane], b = ((const float*)args.in[I_LQ2])[lane] * ((const float*)args.in[I_LK2])[lane];
      lam = expf(wave_sum(a)) - expf(wave_sum(b)) + 0.2f; lam = __uint_as_float(__builtin_amdgcn_readfirstlane(__float_as_uint(lam))); }
    for (int pp = vcu; pp < nrep * NB * 8 * 16; pp += G) {
        const int p = pp & 2047; bf16* O = (pp >> 11) ? Odmy : Oreal;
        const int bh = p >> 4, s = p & 15, b = bh >> 3, h = bh & 7;
#pragma unroll 1
        for (int half = 0; half < 2; ++half) {
            const int qb = half ? 31 - s : s;
            const size_t row0 = (size_t)b * SEQ + 128 * qb + 32 * g;
            if ((pp >> 11) == 0)
            attn2_unit<0>(lds, Q + row0 * DM + h * 128 + m * 64, Kb + (size_t)b * SEQ * DM + h * 128, Vb + (size_t)b * SEQ * DM + h * 128,
                       2 * qb + 2, 2 * qb + (g >> 1) + 1, O + row0 * DM + h * 128, lam, (const float*)args.in[I_SUBLN]);
#if PROBE_VAR
            else
            attn2_unit<PROBE_VAR>(lds, Q + row0 * DM + h * 128 + m * 64, Kb + (size_t)b * SEQ * DM + h * 128, Vb + (size_t)b * SEQ * DM + h * 128,
                       2 * qb + 2, 2 * qb + (g >> 1) + 1, O + row0 * DM + h * 128, lam, (const float*)args.in[I_SUBLN]);
#endif
        }
    }
}
__device__ __forceinline__ void crossattn_phase(const Args& args, LAS unsigned char* lds, int vcu, int G) {
    unsigned char* ws = args.ws;
    const int lane = threadIdx.x & 63, wid = __builtin_amdgcn_readfirstlane(threadIdx.x >> 6);
    const bf16* QC = (const bf16*)(ws + WS_QC); const bf16* KV = (const bf16*)(ws + WS_KVC); bf16* OC = (bf16*)(ws + WS_OC);
    const float cref = softmax_cref((const float*)args.in[I_CQ_NORM], (const float*)args.in[I_CK_NORM], 128, 0.08838834764831845f, lane);
#pragma unroll 1
    for (int p = vcu; p < NB * 4 * 16; p += G) {
        const int b = p >> 6, h = (p >> 4) & 3, qb = p & 15;
        const size_t row0 = (size_t)b * SEQ + 256 * qb + 32 * wid;
        attn_unit<1>(lds, QC + row0 * 512 + h * 128, 512, KV + (size_t)b * MEMTOK * DM + h * 128, DM, KV + (size_t)b * MEMTOK * DM + 512 + h * 128, DM,
                     4, 4, OC + row0 * 512 + h * 128, 512, cref, 0.f, nullptr, 1.0f, (const float*)args.in[I_CQ_NORM], 0.08838834764831845f * LOG2E);
    }
}

template <class Sched>
__device__ __forceinline__ void router_select(const Args& args, LAS unsigned char* lds, const Sched& S) {
    unsigned char* ws = args.ws;
    const int tid = threadIdx.x;
    LAS int* cnt_l = (LAS int*)lds; LAS int* base_l = cnt_l + 64;
    const float* logit = (const float*)(ws + WS_LOGIT); const float* rss = (const float*)(ws + WS_RSS2);
    float* rstd2 = (float*)(ws + WS_RSTD2); float* wts = (float*)(ws + WS_WTS); int* idx = (int*)(ws + WS_IDX); int* asg = (int*)(ws + WS_ASG); unsigned* gcnt = (unsigned*)(ws + WS_CTL) + CW_CNT;
    const float* bg = (const float*)args.in[I_B_GROUP]; const float* br = (const float*)args.in[I_B_ROUTER];
    VM_WAIT(); __syncthreads();
    __builtin_amdgcn_fence(__ATOMIC_ACQUIRE, "agent"); VM_WAIT();
    pg8::Unit u;
    for (int i = 0; S.next(i, u); ++i) {
        if (tid < 64) cnt_l[tid] = 0;
        __syncthreads();
        int row = 0, b0 = 0, b1 = 0, rk0 = 0, rk1 = 0; float w0 = 0.f, w1 = 0.f;
        if (tid < 256) {
            row = u.pm * 256 + tid;
            const f32x4* p = (const f32x4*)(rss + (size_t)row * 16); const f32x4 s0 = p[0], s1 = p[1], s2 = p[2], s3 = p[3];
            const float ss = ((s0[0] + s0[1]) + (s0[2] + s0[3])) + ((s1[0] + s1[1]) + (s1[2] + s1[3])) + ((s2[0] + s2[1]) + (s2[2] + s2[3])) + ((s3[0] + s3[1]) + (s3[2] + s3[3]));
            const float rstd = rsqrtf(ss * (1.0f / DM) + EPS); rstd2[row] = rstd;
            { const f32x4* q = (const f32x4*)((const float*)(ws + WS_RSS1) + (size_t)row * 16); const f32x4 m0 = q[0], m1 = q[1], m2 = q[2], m3 = q[3];
              const float mx = fmaxf(fmaxf(fmaxf(fmaxf(m0[0], m0[1]), fmaxf(m0[2], m0[3])), fmaxf(fmaxf(m1[0], m1[1]), fmaxf(m1[2], m1[3]))), fmaxf(fmaxf(fmaxf(m2[0], m2[1]), fmaxf(m2[2], m2[3])), fmaxf(fmaxf(m3[0], m3[1]), fmaxf(m3[2], m3[3]))));
              const float sc = mx > 0.f ? mx * (1.0f / 127.0f) : 1.0f; ((float*)(ws + WS_XS2))[row] = sc; ((LAS float*)(lds + 1024))[tid] = 1.0f / sc; }
            const f32x4* lp = (const f32x4*)(logit + (size_t)row * 64);
            const f32x4 gl4 = lp[0];
            float gl[4]; int gi = 0;
#pragma unroll
            for (int j = 0; j < 4; ++j) gl[j] = gl4[j] * rstd + bg[j];
            float gm = gl[0];
#pragma unroll
            for (int j = 1; j < 4; ++j) if (gl[j] > gm) { gm = gl[j]; gi = j; }
            float den = 0.f;
#pragma unroll
            for (int j = 0; j < 4; ++j) den += expf(gl[j] - gm);
            const float gval = 1.0f / den;
            const f32x4 e0 = lp[1 + 2 * gi], e1 = lp[2 + 2 * gi];
            float el[8];
#pragma unroll
            for (int j = 0; j < 4; ++j) { el[j] = e0[j] * rstd + br[gi * 8 + j]; el[4 + j] = e1[j] * rstd + br[gi * 8 + 4 + j]; }
            int i0 = 0; float v0 = el[0];
#pragma unroll
            for (int j = 1; j < 8; ++j) if (el[j] > v0) { v0 = el[j]; i0 = j; }
            int i1 = -1; float v1 = -INFINITY;
#pragma unroll
            for (int j = 0; j < 8; ++j) if (j != i0 && el[j] > v1) { v1 = el[j]; i1 = j; }
            const float ex = expf(v1 - v0); w0 = gval / (1.0f + ex); w1 = gval * ex / (1.0f + ex);
            b0 = gi * 8 + i0; b1 = 32 + gi * 8 + i1;
            rk0 = atomicAdd((int*)&cnt_l[b0], 1); rk1 = atomicAdd((int*)&cnt_l[b1], 1);
        }
        __syncthreads();
        if (tid < 64) base_l[tid] = (int)__hip_atomic_fetch_add(gcnt + tid, (unsigned)cnt_l[tid], __ATOMIC_RELAXED, __HIP_MEMORY_SCOPE_AGENT);
        __syncthreads();
        {
          const bf16* xb = (const bf16*)(ws + WS_X2B) + (size_t)u.pm * 256 * DM; unsigned char* xq = ws + WS_X2Q + (size_t)u.pm * 256 * DM; const LAS float* invs = (const LAS float*)(lds + 1024);
          for (int p = tid; p < 256 * 64; p += NWAVES * 64) { const int r = p >> 6, c = (p & 63) * 16; const float inv = invs[r];
              const u32x4 a = *(const u32x4*)(xb + (size_t)r * DM + c), b = *(const u32x4*)(xb + (size_t)r * DM + c + 8);
              u32x4 o; o.x = pack_i8x4(bflo(a.x) * inv, bfhi(a.x) * inv, bflo(a.y) * inv, bfhi(a.y) * inv); o.y = pack_i8x4(bflo(a.z) * inv, bfhi(a.z) * inv, bflo(a.w) * inv, bfhi(a.w) * inv);
              o.z = pack_i8x4(bflo(b.x) * inv, bfhi(b.x) * inv, bflo(b.y) * inv, bfhi(b.y) * inv); o.w = pack_i8x4(bflo(b.z) * inv, bfhi(b.z) * inv, bflo(b.w) * inv, bfhi(b.w) * inv);
              *(u32x4*)(xq + (size_t)r * DM + c) = o; } }
        if (tid < 256) { idx[(size_t)b0 * MTOK + base_l[b0] + rk0] = row; idx[(size_t)b1 * MTOK + base_l[b1] + rk1] = row; wts[(size_t)row * 2] = w0; wts[(size_t)row * 2 + 1] = w1;
            asg[(size_t)row * 2] = (b0 << 20) | (base_l[b0] + rk0); asg[(size_t)row * 2 + 1] = (b1 << 20) | (base_l[b1] + rk1); }
        __syncthreads();
    }
}
__device__ __forceinline__ void moe_tables(const Args& args, LAS int* pblk, LAS int* cntl) {
    const unsigned* gcnt = (const unsigned*)(args.ws + WS_CTL) + CW_CNT;
    if (threadIdx.x < 64) cntl[threadIdx.x] = (int)__hip_atomic_load(gcnt + threadIdx.x, __ATOMIC_RELAXED, __HIP_MEMORY_SCOPE_AGENT);
    __syncthreads();
    if (threadIdx.x == 0) { int acc = 0; for (int j = 0; j < 64; ++j) { pblk[j] = acc; acc += (cntl[j] + 255) >> 8; } pblk[64] = acc;
        LAS int* cst = cntl + 64; int a2 = 0; for (int j = 0; j < 64; ++j) { if (j == 32) a2 = 0; cst[j] = a2; a2 += cntl[j]; } }
    __syncthreads();
}

__device__ __forceinline__ void moe_combine_phase(const Args& args, const LAS int* cst, int gw, int NGW, int lane) {
    unsigned char* ws = args.ws;
    const bf16* x2b = (const bf16*)(ws + WS_X2B); const bf16* y0 = (const bf16*)(ws + WS_S0); const bf16* y1 = (const bf16*)(ws + WS_S4);
    const float* wts = (const float*)(ws + WS_WTS); const int* asg = (const int*)(ws + WS_ASG);
    int2 an[2]; float2 wn[2];
#pragma unroll
    for (int t = 0; t < 2; ++t) { const int tk = gw + t * NGW; const bool ok = tk < MTOK; an[t] = ok ? *(const int2*)(asg + (size_t)tk * 2) : make_int2(0, 0); wn[t] = ok ? *(const float2*)(wts + (size_t)tk * 2) : make_float2(0.f, 0.f); }
    for (int tok = gw; tok < MTOK; tok += 2 * NGW) {
        int2 ac[2]; float2 wc2[2];
#pragma unroll
        for (int t = 0; t < 2; ++t) { ac[t] = an[t]; wc2[t] = wn[t]; }
#pragma unroll
        for (int t = 0; t < 2; ++t) { const int tk = tok + (2 + t) * NGW; const bool ok = tk < MTOK; an[t] = ok ? *(const int2*)(asg + (size_t)tk * 2) : make_int2(0, 0); wn[t] = ok ? *(const float2*)(wts + (size_t)tk * 2) : make_float2(0.f, 0.f); }
        u32x2 xv[2][4], p[2][4], q[2][4];
#pragma unroll
        for (int t = 0; t < 2; ++t) { const int tk = tok + t * NGW; if (tk < MTOK) {
            const size_t r0 = (size_t)(cst[ac[t].x >> 20] + (ac[t].x & 0xfffff)), r1 = (size_t)(cst[ac[t].y >> 20] + (ac[t].y & 0xfffff));
#pragma unroll
            for (int k = 0; k < 4; ++k) { const int c = 4 * lane + 256 * k;
                xv[t][k] = *(const u32x2*)(x2b + (size_t)tk * DM + c); p[t][k] = *(const u32x2*)(y0 + r0 * DM + c); q[t][k] = *(const u32x2*)(y1 + r1 * DM + c); } } }
#pragma unroll
        for (int t = 0; t < 2; ++t) { const int tk = tok + t * NGW; if (tk < MTOK) { const float w0 = wc2[t].x, w1 = wc2[t].y;
#pragma unroll
            for (int k = 0; k < 4; ++k) { const int c = 4 * lane + 256 * k; const u32x2 X = xv[t][k], P = p[t][k], Q = q[t][k]; f32x4 o;
                o[0] = bflo(X.x) + w0 * bflo(P.x) + w1 * bflo(Q.x); o[1] = bfhi(X.x) + w0 * bfhi(P.x) + w1 * bfhi(Q.x); o[2] = bflo(X.y) + w0 * bflo(P.y) + w1 * bflo(Q.y); o[3] = bfhi(X.y) + w0 * bfhi(P.y) + w1 * bfhi(Q.y);
                __builtin_nontemporal_store(o, (f32x4*)(args.out + (size_t)tk * DM + c)); } } }
    }
}

constexpr int N_PHASES = 17;
__global__ void __launch_bounds__(NWAVES * 64, 2) fwd_kernel(Args args) {
    extern __shared__ __attribute__((aligned(16))) unsigned char lds_raw[];
    LAS unsigned char* lds = (LAS unsigned char*)lds_raw;
    volatile LAS unsigned* MISC = (volatile LAS unsigned*)(lds + MISC_OFF);
    const int tid = threadIdx.x, lane = tid & 63, wave = __builtin_amdgcn_readfirstlane(tid >> 6);
    const int G = gridDim.x; const int bx = blockIdx.x; const int vcu = (G % 8 == 0) ? (bx % 8) * (G / 8) + bx / 8 : bx;
    const int gw = vcu * NWAVES + wave, NGW = G * NWAVES;
    unsigned char* ws = args.ws;
    for (int u = tid; u < (LDS_BYTES - MISC_OFF) / 4; u += NWAVES * 64) MISC[u] = 0u;
    __syncthreads();
    const int lo = args.ph_lo, hi = args.ph_hi;
    XcdBarrier bar; bar.bar = (unsigned*)(ws + WS_CTL) + CW_BAR + args.li * XCD_BAR_WORDS; bar.x = 0; bar.st = nullptr;
    bar = xcd_barrier_post((unsigned*)(ws + WS_CTL) + CW_BAR + args.li * XCD_BAR_WORDS, MISC);
    LAS int* pblk = (LAS int*)(lds + MISC_OFF + 64); LAS int* cntl = pblk + 72;
#ifndef PH_MASK
#define PH_MASK 0x1ffff
#endif
#define IN(k) (((PH_MASK >> (k)) & 1) && lo <= (k) && (k) < hi)
#define SEAM(k) do { if (IN(k) && IN((k) + 1)) xcd_barrier(bar); } while (0)
    using namespace pg8;

#ifndef PROBE_DUP
#define PROBE_DUP 0
#endif
#define REPS(k) (1 + ((PROBE_DUP >> (k)) & 1))
    unsigned char* const dmyA = ws + WS_QC;
    if (IN(0)) { _Pragma("unroll") for (int rep = 0; rep < REPS(0); ++rep) prologue_phase(args, lds, vcu, G, wave, lane);
        xcd_barrier(bar);
        if (G >= 128 && bx < 64) {
            DenseOrder S; S.init(ws + WS_MEMN, ws + WS_WCKV, MEMROWS, DM, DM, 64, bx);
            EpiAct E{(bf16*)(ws + WS_KVC), 0, 0, DM, nullptr, nullptr};
            gemm_phase<EpiAct, DenseOrder, true, false>(lds, DM, S, E);
        } else {
          const bool split = G >= 128; const int qw = split ? bx - 64 : bx, QW = split ? G - 64 : G;
          LAS float* red = (LAS float*)lds; LAS float* gain_l = (LAS float*)(lds + 4096);
          for (int k = tid; k < DM; k += NWAVES * 64) gain_l[k] = ((const float*)args.in[I_NORM_FFN])[k];
          __syncthreads();
          for (int it = qw; it < NWIN / 32 + NEXP * 32; it += QW) {
              if (it < NWIN / 32) colquant_wg_item((const float*)args.in[I_W_IN], NWIN, 32 * it, win_dest(32 * it), nullptr, ws + WS_WIN, (float*)(ws + WS_WSC), red, tid);
              else { const int r = it - NWIN / 32, e = r >> 5, nb = r & 31;
                  colquant_wg_item((const float*)args.in[I_W_GATE_UP] + (size_t)e * DM * 1024, 1024, 32 * nb, gu_dest(32 * nb), gain_l, ws + WS_WGU + (size_t)e * 1024 * DM, (float*)(ws + WS_WSC2) + e * 1024, red, tid); } }
          if (!split) { DenseOrder S; S.init(ws + WS_MEMN, ws + WS_WCKV, MEMROWS, DM, DM, G, bx);
            EpiAct E{(bf16*)(ws + WS_KVC), 0, 0, DM, nullptr, nullptr};
            gemm_phase<EpiAct, DenseOrder, true, false>(lds, DM, S, E); }
        }
        SEAM(0); }

    if (IN(1)) {
        _Pragma("unroll") for (int rep = 0; rep < REPS(1); ++rep)
        { DenseOrder S; S.init(ws + WS_XN, ws + WS_WIN, MTOK, 2048, DM / 2, G, bx);
          EpiAct E{(bf16*)(ws + WS_LIN), SLOT_ELEMS, 0, DM, (const float*)(ws + WS_XS), (const float*)(ws + WS_WSC)};
          gemm_phase<EpiAct, DenseOrder, true, false, true>(lds, DM / 2, S, E); }
        SEAM(1);
#ifdef PROBE_BARRIERS
        for (int q_ = 0; q_ < 8; ++q_) xcd_barrier(bar);
#endif
    }
    if (IN(2)) {
        headnorm128_phase((const bf16*)(ws + WS_KVC), (bf16*)(ws + WS_KVC), DM, MEMROWS, (const float*)args.in[I_CK_NORM], 1.0f, gw, NGW, lane);
        _Pragma("unroll") for (int rep = 0; rep < REPS(2); ++rep) lru_phase(args, lds, vcu, G);
        SEAM(2);
    }
    if (IN(3)) {
        _Pragma("unroll") for (int rep = 0; rep < REPS(3); ++rep) {
        DenseOrder S; S.init(ws + WS_XN, ws + WS_WIN + (size_t)2048 * DM, MTOK, 5120, DM / 2, G, bx);
        EpiQKV E{(bf16*)(ws + WS_Q), SLOT_ELEMS, (const float*)(ws + WS_XS), (const float*)(ws + WS_WSC) + 2048, (const float*)args.in[I_Q_NORM], (const float*)args.in[I_K_NORM], (const float*)(ws + WS_ROPE), 0.125f * LOG2E, ws + WS_SG8};
        gemm_phase<EpiQKV, DenseOrder, true, false, true>(lds, DM / 2, S, E); }
        if (IN(3) && IN(5)) xcd_barrier(bar);
    }
    if (IN(5)) { diffattn_phase(args, lds, vcu, G, (bf16*)(ws + WS_Q), (bf16*)dmyA, REPS(5)); SEAM(5); }
    if (IN(7)) {
        _Pragma("unroll") for (int rep = 0; rep < REPS(7); ++rep) {
        PairOrder S; S.nM = MTOK / 256; S.nN = DM / 256; S.ntile = S.nM * S.nN; S.G = G; S.c = bx; S.tstep = (size_t)256 * DM * 2;
        S.A0 = (const char*)(ws + WS_U); S.B0 = (const char*)(ws + WS_WLRUO); S.A1 = (const char*)(ws + WS_Q); S.B1 = (const char*)(ws + WS_WATTNO);
        EpiMix E{ws + WS_SG8, ws + WS_SG8 + (size_t)MTOK * DM, (bf16*)(ws + WS_MIX)};
        gemm_phase<EpiMix, PairOrder, true, false, false, true>(lds, DM, S, E); }
        SEAM(7);
    }
    if (IN(8)) {
        _Pragma("unroll") for (int rep = 0; rep < REPS(8); ++rep) {
        DenseOrder S; S.init(ws + WS_MIX, ws + WS_WOUT, MTOK, DM, DM, G, bx);
        EpiResid<true> E{args.in[I_X], (bf16*)(ws + WS_X1B), (float*)(ws + WS_RSS1), nullptr};
        gemm_phase<EpiResid<true>, DenseOrder, true, false>(lds, DM, S, E); }
        SEAM(8);
    }
    if (IN(9)) {
        _Pragma("unroll") for (int rep = 0; rep < REPS(9); ++rep) {
        DenseOrder S; S.init(ws + WS_X1B, ws + WS_WCQ, MTOK, 512, DM, G, bx);
        EpiRowScale E{(bf16*)(ws + WS_QC), 512, (const float*)(ws + WS_RSS1)};
        gemm_phase<EpiRowScale, DenseOrder, true, false>(lds, DM, S, E); }
        if (IN(9) && IN(11)) xcd_barrier(bar);
    }
    if (IN(11)) { _Pragma("unroll") for (int rep = 0; rep < REPS(11); ++rep) crossattn_phase(args, lds, vcu, G); SEAM(11); }
    if (IN(12)) {
        _Pragma("unroll") for (int rep = 0; rep < REPS(12); ++rep) {
        DenseOrder S; S.init(ws + WS_OC, ws + WS_WCO, MTOK, DM, 512, G, bx);
        EpiResid<false> E{ws + WS_X1B, (bf16*)(ws + WS_X2B), (float*)(ws + WS_RSS2), (float*)(ws + WS_RSS1)};
        gemm_phase<EpiResid<false>, DenseOrder, true, false>(lds, 512, S, E); }
        SEAM(12);
    }
    if (IN(13)) {
        DenseOrder S; S.init(ws + WS_X2B, ws + WS_WRT, MTOK, 256, DM, G, bx);
        EpiLogit E{(float*)(ws + WS_LOGIT)};
        gemm_phase<EpiLogit, DenseOrder, true, false>(lds, DM, S, E);
        router_select(args, lds, S);
        SEAM(13);
    }
    if (IN(14)) {
        moe_tables(args, pblk, cntl);
        _Pragma("unroll") for (int rep = 0; rep < REPS(14); ++rep) {
        MoeOrder S{pblk, cntl, 0, 0, G, vcu  , DM / 2, 1, (const char*)(ws + WS_X2Q), (const char*)(ws + WS_WGU), (size_t)1024 * DM, (const int*)(ws + WS_IDX), 0};
        S.rb_hi = pblk[64];
        EpiGateUp E{(bf16*)(ws + WS_H), (const float*)(ws + WS_RSTD2), (const float*)(ws + WS_XS2), (const float*)(ws + WS_WSC2)};
        gemm_phase<EpiGateUp, MoeOrder, true, true, true>(lds, DM / 2, S, E); }
        SEAM(14);
    }
    if (IN(15)) {
        moe_tables(args, pblk, cntl);
        _Pragma("unroll") for (int rep = 0; rep < REPS(15); ++rep) {
        MoeOrder S{pblk, cntl, 0, 0, G, vcu, EFF, 0, (const char*)(ws + WS_H), (const char*)(ws + WS_WDN), (size_t)DM * EFF * 2, (const int*)(ws + WS_IDX), 0};
        S.rb_lo = pblk[0]; S.rb_hi = pblk[64];
        EpiY E{(bf16*)(ws + WS_S0), (bf16*)(ws + WS_S4)};
        gemm_phase<EpiY, MoeOrder, true, false>(lds, EFF, S, E); }
        SEAM(15);
    }
    if (IN(16)) {
        moe_tables(args, pblk, cntl);
        _Pragma("unroll") for (int rep = 0; rep < REPS(16); ++rep) moe_combine_phase(args, cntl + 64, gw, NGW, lane);
    }
#undef REPS
#undef IN
#undef SEAM
}

#ifndef MK_CUTS
#define MK_CUTS 1
#endif
extern "C" void kernel_launch(void* const* d_in, const int* in_sizes, int n_in, void* d_out, int out_size, void* d_ws, size_t ws_size, hipStream_t stream) {
    static int grid = 0;
    if (grid == 0) {
        if (n_in != 36 || out_size != MTOK * DM || ws_size < WS_END) { fprintf(stderr, "kernel_launch: unexpected shapes / workspace (n_in %d out %d ws %zu, need %zu)\n", n_in, out_size, ws_size, (size_t)WS_END); grid = -1; return; }
        int dev = 0, cus = 0, per_cu = 0;
        if (hipGetDevice(&dev) != hipSuccess || hipDeviceGetAttribute(&cus, hipDeviceAttributeMultiprocessorCount, dev) != hipSuccess) { grid = -1; return; }
        if (hipFuncSetAttribute((const void*)fwd_kernel, hipFuncAttributeMaxDynamicSharedMemorySize, LDS_BYTES) != hipSuccess) { fprintf(stderr, "kernel_launch: hipFuncSetAttribute failed\n"); grid = -1; return; }
        if (hipOccupancyMaxActiveBlocksPerMultiprocessor(&per_cu, (const void*)fwd_kernel, NWAVES * 64, LDS_BYTES) != hipSuccess || per_cu < 1) { fprintf(stderr, "kernel_launch: occupancy query says %d blocks per CU\n", per_cu); }
        (void)hipGetLastError();
        grid = cus;
    }
    if (grid < 0) return;
    (void)hipMemsetAsync((char*)d_ws + WS_CTL, 0, CTL_ZERO_BYTES, stream);
    Args a{};
    for (int i = 0; i < 36; ++i) a.in[i] = d_in[i];
    a.out = (float*)d_out; a.ws = (unsigned char*)d_ws;
    constexpr int NL = MK_CUTS;
    for (int li = 0; li < NL; ++li) {
        a.ph_lo = (li * N_PHASES) / NL; a.ph_hi = ((li + 1) * N_PHASES) / NL; a.li = li;
        hipLaunchKernelGGL(fwd_kernel, dim3(grid), dim3(NWAVES * 64), LDS_BYTES, stream, a);
    }
}
```

```cpp
#include <hip/hip_runtime.h>
#include <cstdio>
#include <cstdint>
#include <cmath>

#define GAS __attribute__((address_space(1)))
#define LAS __attribute__((address_space(3)))
typedef unsigned short bf16;
typedef short bf16x8 __attribute__((ext_vector_type(8)));
typedef short s16x4 __attribute__((ext_vector_type(4)));
typedef float f32x2 __attribute__((ext_vector_type(2)));
typedef float f32x4 __attribute__((ext_vector_type(4)));
typedef float f32x16 __attribute__((ext_vector_type(16)));
typedef unsigned u32x2 __attribute__((ext_vector_type(2)));
typedef unsigned u32x4 __attribute__((ext_vector_type(4)));

constexpr int NB = 16, SEQ = 4096, DM = 1024, MTOK = NB * SEQ;
constexpr int NWIN = 7168;
constexpr int MEMTOK = 256, MEMROWS = NB * MEMTOK;
constexpr int NEXP = 32, EFF = 512;
constexpr float EPS = 1e-6f;
constexpr float LOG2E = 1.4426950408889634f;
constexpr int NWAVES = 8;

constexpr size_t MiB = 1u << 20;
constexpr size_t WS_CTL = 0, CTL_ZERO_BYTES = 1 * MiB;
constexpr size_t WS_WIN = 2 * MiB;
constexpr size_t WS_WLRUO = 16 * MiB, WS_WATTNO = 18 * MiB, WS_WOUT = 20 * MiB;
constexpr size_t WS_WCQ = 22 * MiB;
constexpr size_t WS_WCKV = 23 * MiB;
constexpr size_t WS_WCO = 25 * MiB;
constexpr size_t WS_WRT = 26 * MiB;
constexpr size_t WS_WLRU = 26 * MiB + 512 * 1024;
constexpr size_t WS_WGU = 27 * MiB;
constexpr size_t WS_WDN = 91 * MiB;
constexpr size_t WS_S0 = 128 * MiB, WS_S1 = 256 * MiB, WS_S2 = 384 * MiB, WS_S3 = 512 * MiB, WS_S4 = 640 * MiB;
constexpr size_t WS_MEMN = 768 * MiB;
constexpr size_t WS_KVC = 776 * MiB;
constexpr size_t WS_QC = 784 * MiB;
constexpr size_t WS_OC = 848 * MiB;
constexpr size_t WS_IDX = 912 * MiB;
constexpr size_t WS_WTS = 928 * MiB;
constexpr size_t WS_RSS1 = 929 * MiB;
constexpr size_t WS_RSS2 = 933 * MiB;
constexpr size_t WS_RSTD2 = 937 * MiB;
constexpr size_t WS_XS = 937 * MiB + 256 * 1024;
constexpr size_t WS_WSC = 937 * MiB + 512 * 1024;
constexpr size_t WS_LOGIT = 938 * MiB;
constexpr size_t WS_ROPE = 954 * MiB;
constexpr size_t WS_XS2 = 958 * MiB + 512 * 1024;
constexpr size_t WS_WSC2 = 958 * MiB + 768 * 1024;
constexpr size_t WS_ASG = 958 * MiB;
constexpr size_t WS_END = 959 * MiB;
constexpr size_t WS_XN = WS_S0, WS_MIX = WS_S0, WS_LIN = WS_S1, WS_Q = WS_S1, WS_X2B = WS_S1, WS_GG = WS_S2, WS_K = WS_S2, WS_SGL = WS_S2,
                 WS_H = WS_S2, WS_V = WS_S3, WS_SGA = WS_S3, WS_U = WS_S4, WS_X1B = WS_S4;
constexpr size_t WS_X2Q = WS_S0;
constexpr size_t WS_SG8 = WS_QC;
constexpr size_t SLOT_ELEMS = (WS_S2 - WS_S1) / 2;
constexpr int CW_CNT = 1024;
constexpr int CW_WMAX2 = 139264;
constexpr int CW_WMAX = 131072;
constexpr int CW_BAR = 4096;
constexpr int MAX_LAUNCHES = 24;

constexpr int RING_BYTES = 131072;
constexpr int MISC_OFF = RING_BYTES;
constexpr int LDS_BYTES = 147456;

__device__ __forceinline__ unsigned cvt_pk_bf16(float lo, float hi) { unsigned r; asm volatile("v_cvt_pk_bf16_f32 %0, %1, %2" : "=v"(r) : "v"(lo), "v"(hi)); return r; }
__device__ __forceinline__ float bflo(unsigned w) { return __uint_as_float(w << 16); }
__device__ __forceinline__ float bfhi(unsigned w) { return __uint_as_float(w & 0xffff0000u); }
__device__ __forceinline__ float bf2f(bf16 h) { return __uint_as_float((unsigned)h << 16); }
__device__ __forceinline__ float fast_exp2(float x) { return __builtin_amdgcn_exp2f(x); }
__device__ __forceinline__ float fast_rcp(float x) { return __builtin_amdgcn_rcpf(x); }
__device__ __forceinline__ float sigmoid_f(float v) { return fast_rcp(1.0f + fast_exp2(-LOG2E * v)); }
__device__ __forceinline__ float gelu_tanh_f(float v) { const float u = v + 0.044715f * v * v * v; return v * fast_rcp(1.0f + fast_exp2(-2.0f * 0.7978845608028654f * LOG2E * u)); }
__device__ __forceinline__ float wave_sum(float v) {
#pragma unroll
    for (int o = 1; o < 64; o <<= 1) v += __shfl_xor(v, o);
    return v;
}
__device__ __forceinline__ float wave_max(float v) {
#pragma unroll
    for (int o = 1; o < 64; o <<= 1) v = fmaxf(v, __shfl_xor(v, o));
    return v;
}
#define LDS_WAIT() asm volatile("s_waitcnt lgkmcnt(0)" ::: "memory")
#define KEEP_AB(r, a, b) asm volatile("" : "+v"(r) : "v"(a), "v"(b))
#define VM_WAIT() asm volatile("s_waitcnt vmcnt(0)" ::: "memory")

namespace pg8 {
constexpr int BM = 256, BK = 64, HALF = 128, HTB = HALF * BK * 2, STAGE_BYTES = 8 * HTB;
__host__ __device__ __forceinline__ int lds_byte(int r, int c) { const int st = (r >> 4) * 2 + (c >> 5), rr = r & 15, cc = c & 31, ob = rr * 64 + cc * 2; return st * 1024 + (ob ^ (((ob >> 9) & 1) << 5)); }
__host__ __device__ __forceinline__ void stage_rc(int b, int& R, int& C) { const int st = b / 1024, sb = b % 1024, swz = sb ^ (((sb >> 9) & 1) << 5); R = (st >> 1) * 16 + swz / 64; C = (st & 1) * 32 + (swz % 64) / 2; }
__host__ __device__ __forceinline__ int perm32(int rho) { const int n = rho >> 4, i = rho & 15; return 8 * (i >> 2) + 4 * n + (i & 3); }

struct Unit { int pm, pn, aux, nvalid, crow0; const char* a; const char* b; const int* rows; };

typedef int v4i32 __attribute__((ext_vector_type(4)));
template <class Epi, class Sched, bool ALIGN_EPI, bool GATHER, bool I8 = false, bool PAIRACC = false>
__device__ __forceinline__ void gemm_phase(LAS unsigned char* lds, const int K, const Sched& S, const Epi& E) {
    const int tid = threadIdx.x, wid = __builtin_amdgcn_readfirstlane(tid >> 6), lane = tid & 63, wr = wid >> 2, wc = wid & 3, fr = lane & 15, fq = lane >> 4;
    const int nt = K / BK;
    unsigned voffA[2][2], nvoffA[2][2], voffB[2]; int RA[2], CA[2];
#pragma unroll
    for (int i = 0; i < 2; ++i) { int R, C; stage_rc(tid * 16 + i * 8192, R, C); const int Rb = Epi::PERM ? ((R & ~31) + perm32(R & 31)) : R;
        RA[i] = R; CA[i] = C; voffB[i] = (unsigned)(Rb * K + C) * 2u;
#pragma unroll
        for (int h = 0; h < 2; ++h) { voffA[h][i] = (unsigned)((R + HALF * h) * K + C) * 2u; nvoffA[h][i] = voffA[h][i]; } }
    const size_t kstep = (size_t)(BK * 2);
    const size_t hstep = (size_t)HALF * K * 2;
    const unsigned ldsw = (unsigned)wid * 1024u;
    const int aoff = lds_byte(wr * 64 + fr, fq * 8), boff = lds_byte(wc * 32 + fr, fq * 8);
#define PG8_SA(b, h) (((b) * 2 + (h)) * HTB)
#define PG8_SB(b, h) ((4 + (b) * 2 + (h)) * HTB)
#define PG8_STAGE_B(bufoff, gbase) do { _Pragma("unroll") for (int _i = 0; _i < 2; ++_i) \
        __builtin_amdgcn_global_load_lds((const unsigned*)((const char*)(gbase) + voffB[_i]), (LAS unsigned*)(lds + (bufoff) + ldsw + _i * 8192), 16, 0, 0); } while (0)
#define PG8_STAGE_A(bufoff, gbase, h, NX) do { _Pragma("unroll") for (int _i = 0; _i < 2; ++_i) { const unsigned _o = (GATHER && (NX)) ? nvoffA[h][_i] : voffA[h][_i]; \
        __builtin_amdgcn_global_load_lds((const unsigned*)((const char*)(gbase) + _o), (LAS unsigned*)(lds + (bufoff) + ldsw + _i * 8192), 16, 0, 0); } } while (0)
#define PG8_LDA(dst, b, h) do { _Pragma("unroll") for (int m = 0; m < 4; ++m) _Pragma("unroll") for (int k = 0; k < 2; ++k) dst[m][k] = *(const LAS bf16x8*)(lds + PG8_SA(b, h) + aoff + m * 2048 + k * 1024); } while (0)
#define PG8_LDB(dst, b, h) do { _Pragma("unroll") for (int n = 0; n < 2; ++n) _Pragma("unroll") for (int k = 0; k < 2; ++k) dst[n][k] = *(const LAS bf16x8*)(lds + PG8_SB(b, h) + boff + n * 2048 + k * 1024); } while (0)
#define PG8_MMA(ai, bj, At, Bt) do { __builtin_amdgcn_s_setprio(1); _Pragma("unroll") for (int m = 0; m < 4; ++m) _Pragma("unroll") for (int n = 0; n < 2; ++n) _Pragma("unroll") for (int k = 0; k < 2; ++k) \
        { if constexpr (I8) acc[ai][bj][m][n] = __builtin_bit_cast(f32x4, __builtin_amdgcn_mfma_i32_16x16x64_i8(__builtin_bit_cast(v4i32, Bt[n][k]), __builtin_bit_cast(v4i32, At[m][k]), __builtin_bit_cast(v4i32, acc[ai][bj][m][n]), 0, 0, 0)); \
          else acc[ai][bj][m][n] = __builtin_amdgcn_mfma_f32_16x16x32_bf16(Bt[n][k], At[m][k], acc[ai][bj][m][n], 0, 0, 0); } __builtin_amdgcn_s_setprio(0); } while (0)
#define PG8_WAIT_V(n) asm volatile("s_waitcnt vmcnt(" #n ")" ::: "memory")
#define PG8_WAIT_L(n) asm volatile("s_waitcnt lgkmcnt(" #n ")" ::: "memory")
#define PG8_BAR __builtin_amdgcn_s_barrier()
#define PG8_SCHED __builtin_amdgcn_sched_barrier(0)
#define PG8_GATHER_OFFS(dst, u) do { _Pragma("unroll") for (int _i = 0; _i < 2; ++_i) _Pragma("unroll") for (int _h = 0; _h < 2; ++_h) { const int _r = RA[_i] + HALF * _h; \
        const int _tok = (_r < (u).nvalid) ? (u).rows[_r] : 0; dst[_h][_i] = (unsigned)(_tok * K + CA[_i]) * 2u; } } while (0)
    Unit cur, nxt; int ui = 0;
    if (!S.next(0, cur)) return;
    if constexpr (GATHER) { PG8_GATHER_OFFS(voffA, cur); }
    f32x4 acc[2][2][4][2];
#pragma unroll
    for (int a = 0; a < 2; ++a)
#pragma unroll
        for (int b = 0; b < 2; ++b)
#pragma unroll
            for (int m = 0; m < 4; ++m)
#pragma unroll
                for (int n = 0; n < 2; ++n) acc[a][b][m][n] = (f32x4){0.f, 0.f, 0.f, 0.f};
    bf16x8 At[4][2], B0[2][2], B1[2][2];
    const char* cA = cur.a; const char* cB = cur.b;
    PG8_STAGE_B(PG8_SB(0, 0), cB); PG8_STAGE_B(PG8_SB(0, 1), cB + hstep); PG8_STAGE_A(PG8_SA(0, 0), cA, 0, false); PG8_STAGE_A(PG8_SA(0, 1), cA, 1, false);
    if (wr == 1) PG8_BAR;
    PG8_WAIT_V(2); PG8_BAR;
    PG8_STAGE_B(PG8_SB(1, 0), cB + kstep); PG8_STAGE_A(PG8_SA(1, 0), cA + kstep, 0, false); PG8_STAGE_B(PG8_SB(1, 1), cB + hstep + kstep);
    PG8_WAIT_V(6); PG8_BAR;
    for (;;) {
        const bool has_next = S.next(ui + 1, nxt);
        if constexpr (GATHER) { if (has_next) { PG8_GATHER_OFFS(nvoffA, nxt); } else {
#pragma unroll
            for (int h = 0; h < 2; ++h)
#pragma unroll
                for (int i = 0; i < 2; ++i) nvoffA[h][i] = voffA[h][i]; } }
        const char* nA = has_next ? nxt.a : cA; const char* nB = has_next ? nxt.b : cB;
        for (int t = 0; t < nt; t += 2) {
            const bool last = (t == nt - 2);
            const char* a1 = cA + (size_t)(t + 1) * kstep;
            const char* a2 = last ? nA : cA + (size_t)(t + 2) * kstep; const char* b2 = last ? nB : cB + (size_t)(t + 2) * kstep;
            const char* a3 = a2 + kstep; const char* b3 = b2 + kstep;
            PG8_LDB(B0, 0, 0); PG8_LDB(B1, 0, 1); PG8_SCHED; PG8_LDA(At, 0, 0); PG8_STAGE_A(PG8_SA(1, 1), a1, 1, false);
            PG8_WAIT_V(8); PG8_WAIT_L(0); PG8_BAR; PG8_MMA(0, 0, At, B0); PG8_MMA(0, 1, At, B1); PG8_BAR; PG8_SCHED;
            PG8_LDA(At, 0, 1); PG8_STAGE_B(PG8_SB(0, 0), b2); PG8_STAGE_B(PG8_SB(0, 1), b2 + hstep); PG8_STAGE_A(PG8_SA(0, 0), a2, 0, last);
            PG8_WAIT_V(8); PG8_WAIT_L(0); PG8_BAR; PG8_MMA(1, 0, At, B0); PG8_MMA(1, 1, At, B1); PG8_BAR; PG8_SCHED;
            PG8_LDB(B0, 1, 0); PG8_LDB(B1, 1, 1); PG8_SCHED; PG8_LDA(At, 1, 0); PG8_STAGE_A(PG8_SA(0, 1), a2, 1, last);
            PG8_WAIT_V(8); PG8_WAIT_L(0); PG8_BAR; PG8_MMA(0, 0, At, B0); PG8_MMA(0, 1, At, B1); PG8_BAR; PG8_SCHED;
            PG8_LDA(At, 1, 1); PG8_STAGE_B(PG8_SB(1, 0), b3); PG8_STAGE_B(PG8_SB(1, 1), b3 + hstep); PG8_STAGE_A(PG8_SA(1, 0), a3, 0, last);
            PG8_WAIT_V(8); PG8_WAIT_L(0); PG8_BAR; PG8_MMA(1, 0, At, B0); PG8_MMA(1, 1, At, B1); PG8_BAR; PG8_SCHED;
        }
        if constexpr (ALIGN_EPI) { if (wr == 0) PG8_BAR; }
        bool keep = false;
        if constexpr (PAIRACC) { if (cur.aux == 0) { E.mid(acc, cur, wr, wc, fr, fq); keep = true; } }
        if (!keep) E(acc, cur, wr, wc, fr, fq);
        if (!has_next) break;
        if (!keep) {
#pragma unroll
        for (int a = 0; a < 2; ++a)
#pragma unroll
            for (int b = 0; b < 2; ++b)
#pragma unroll
                for (int m = 0; m < 4; ++m)
#pragma unroll
                    for (int n = 0; n < 2; ++n) acc[a][b][m][n] = (f32x4){0.f, 0.f, 0.f, 0.f}; }
        cur = nxt; cA = nA; cB = nB; ++ui;
        if constexpr (GATHER) {
#pragma unroll
            for (int h = 0; h < 2; ++h)
#pragma unroll
                for (int i = 0; i < 2; ++i) voffA[h][i] = nvoffA[h][i]; }
        if constexpr (ALIGN_EPI) { if (wr == 1) PG8_BAR; }
    }
    PG8_WAIT_V(0);
    if constexpr (!ALIGN_EPI) { if (wr == 0) PG8_BAR; }
    PG8_BAR;
#undef PG8_SA
#undef PG8_SB
#undef PG8_STAGE_A
#undef PG8_STAGE_B
#undef PG8_LDA
#undef PG8_LDB
#undef PG8_MMA
#undef PG8_WAIT_V
#undef PG8_WAIT_L
#undef PG8_BAR
#undef PG8_SCHED
#undef PG8_GATHER_OFFS
}

constexpr int NXCD = 8, WGM = 8;
struct DenseOrder {
    int nM, nN, nwg, G, c; const char* A; const char* B; size_t tstep;
    __device__ void init(const void* A_, const void* B_, int M, int N, int K, int G_, int c_) { A = (const char*)A_; B = (const char*)B_; nM = M / BM; nN = N / BM; nwg = nM * nN; G = G_; c = c_; tstep = (size_t)BM * K * 2; }
    __device__ bool next(int i, Unit& u) const {
        const long L = (long)i * G + c; if (L >= nwg) return false;
        int wgid = (int)L; { const int q = nwg / NXCD, r = nwg % NXCD, xcd = wgid % NXCD, off = wgid / NXCD; wgid = (xcd < r ? xcd * (q + 1) : r * (q + 1) + (xcd - r) * q) + off; }
        const int nig = WGM * nN, gid = wgid / nig, fm = gid * WGM, gsz = (nM - fm) < WGM ? (nM - fm) : WGM;
        u.pm = fm + ((wgid % nig) % gsz); u.pn = (wgid % nig) / gsz; u.aux = 0; u.nvalid = BM; u.crow0 = 0; u.rows = nullptr;
        u.a = A + (size_t)u.pm * tstep; u.b = B + (size_t)u.pn * tstep; return true;
    }
};
struct PairOrder {
    int nM, nN, ntile, G, c; const char* A0; const char* B0; const char* A1; const char* B1; size_t tstep;
    __device__ bool next(int i, Unit& u) const {
        const long L = (long)(i >> 1) * G + c; if (L >= ntile) return false;
        int wgid = (int)L; { const int q = ntile / NXCD, r = ntile % NXCD, xcd = wgid % NXCD, off = wgid / NXCD; wgid = (xcd < r ? xcd * (q + 1) : r * (q + 1) + (xcd - r) * q) + off; }
        const int nig = WGM * nN, gid = wgid / nig, fm = gid * WGM, gsz = (nM - fm) < WGM ? (nM - fm) : WGM;
        u.pm = fm + ((wgid % nig) % gsz); u.pn = (wgid % nig) / gsz; u.aux = i & 1; u.nvalid = BM; u.crow0 = 0; u.rows = nullptr;
        u.a = ((i & 1) ? A1 : A0) + (size_t)u.pm * tstep; u.b = ((i & 1) ? B1 : B0) + (size_t)u.pn * tstep; return true;
    }
};
struct MoeOrder {
    const LAS int* pblk; const LAS int* cnt; int rb_lo, rb_hi, G, c, K, gather;
    const char* Abase; const char* Wbase; size_t wstride; const int* idx; int kpass;
    __device__ bool next(int i, Unit& u) const {
        const long L = (long)i * G + c; const int rb = rb_lo + (int)(L >> 2);
        if (rb >= rb_hi) return false;
        int bkt = 0;
#pragma unroll
        for (int st = 32; st > 0; st >>= 1) if (pblk[bkt + st] <= rb) bkt += st;
        const int j = rb - pblk[bkt], e = bkt & 31;
        u.pm = rb; u.pn = (int)(L & 3); u.aux = bkt >> 5; const int left = cnt[bkt] - 256 * j; u.nvalid = left < 256 ? left : 256; u.crow0 = gather ? e : cnt[64 + bkt] + 256 * j;
        u.rows = idx + (size_t)bkt * MTOK + 256 * j;
        u.a = gather ? Abase : Abase + (size_t)rb * 256 * K * 2;
        u.b = Wbase + (size_t)e * wstride + (size_t)u.pn * 256 * K * 2;
        return true;
    }
};

struct EpiAct {
    static constexpr bool PERM = true;
    bf16* o0; size_t gstride; int acts; int ldc;
    const float* sa; const float* sb;
    __device__ __forceinline__ void operator()(const f32x4 (&acc)[2][2][4][2], const Unit& u, int wr, int wc, int fr, int fq) const {
        const int grp = (u.pn * BM) >> 10; const int colt = u.pn * BM - (grp << 10);
        bf16* base = o0 + (size_t)grp * gstride; const int act = (acts >> (4 * grp)) & 15;
        const int row0 = u.pm * BM + wr * 64 + fr, col0 = colt + wc * 32 + 8 * fq;
        float sbv[2][8];
        if (sa) {
#pragma unroll
            for (int bj = 0; bj < 2; ++bj) { const f32x4 b0 = *(const f32x4*)(sb + u.pn * BM + bj * HALF + wc * 32 + 8 * fq), b1 = *(const f32x4*)(sb + u.pn * BM + bj * HALF + wc * 32 + 8 * fq + 4);
                sbv[bj][0] = b0[0]; sbv[bj][1] = b0[1]; sbv[bj][2] = b0[2]; sbv[bj][3] = b0[3]; sbv[bj][4] = b1[0]; sbv[bj][5] = b1[1]; sbv[bj][6] = b1[2]; sbv[bj][7] = b1[3]; } }
        float sarv[8];
#pragma unroll
        for (int g = 0; g < 8; ++g) sarv[g] = sa ? sa[row0 + (g >> 2) * HALF + (g & 3) * 16] : 1.0f;
#pragma unroll
        for (int ai = 0; ai < 2; ++ai)
#pragma unroll
            for (int m = 0; m < 4; ++m) { const int row = row0 + ai * HALF + m * 16; bf16* rowp = base + (size_t)row * ldc + col0; const float sar = sarv[ai * 4 + m];
#pragma unroll
                for (int bj = 0; bj < 2; ++bj) { const f32x4 a0 = acc[ai][bj][m][0], a1 = acc[ai][bj][m][1];
                    float v[8] = {a0[0], a0[1], a0[2], a0[3], a1[0], a1[1], a1[2], a1[3]};
                    if (sa) {
#pragma unroll
                        for (int e = 0; e < 8; ++e) v[e] = (float)__float_as_int(v[e]) * (sar * sbv[bj][e]); }
                    if (act == 1) {
#pragma unroll
                        for (int e = 0; e < 8; ++e) v[e] = gelu_tanh_f(v[e]); }
                    else if (act == 2) {
#pragma unroll
                        for (int e = 0; e < 8; ++e) v[e] = sigmoid_f(v[e]); }
                    u32x4 w; w.x = cvt_pk_bf16(v[0], v[1]); w.y = cvt_pk_bf16(v[2], v[3]); w.z = cvt_pk_bf16(v[4], v[5]); w.w = cvt_pk_bf16(v[6], v[7]);
                    *(u32x4*)(rowp + bj * HALF) = w; } }
    }
};
struct EpiQKV {
    static constexpr bool PERM = true;
    bf16* o0; size_t gstride; const float* sa; const float* sb; const float* qg; const float* kg; const float* rope; float qscale; unsigned char* sg8;
    __device__ __forceinline__ void operator()(const f32x4 (&acc)[2][2][4][2], const Unit& u, int wr, int wc, int fr, int fq) const {
        const int grp = (u.pn * BM) >> 10; const int pnl = u.pn & 3;
        bf16* base = o0 + (size_t)grp * gstride;
        const int row0 = u.pm * BM + wr * 64 + fr;
        float sbv[2][8];
#pragma unroll
        for (int bj = 0; bj < 2; ++bj) { const f32x4 b0 = *(const f32x4*)(sb + u.pn * BM + bj * HALF + wc * 32 + 8 * fq), b1 = *(const f32x4*)(sb + u.pn * BM + bj * HALF + wc * 32 + 8 * fq + 4);
            sbv[bj][0] = b0[0]; sbv[bj][1] = b0[1]; sbv[bj][2] = b0[2]; sbv[bj][3] = b0[3]; sbv[bj][4] = b1[0]; sbv[bj][5] = b1[1]; sbv[bj][6] = b1[2]; sbv[bj][7] = b1[3]; }
#define QKV_SARV float sarv[8]; _Pragma("unroll") for (int g = 0; g < 8; ++g) sarv[g] = sa[row0 + (g >> 2) * HALF + (g & 3) * 16]
        if (grp >= 3) { QKV_SARV;
            unsigned char* b8 = sg8 + (size_t)(grp - 3) * ((size_t)MTOK * DM) + ((size_t)(u.pm * 4 + pnl) << 16) + (wr * 4 + wc) * 8192 + (fq * 16 + fr) * 16;
            f32x2 sbn[2][4];
#pragma unroll
            for (int bj = 0; bj < 2; ++bj)
#pragma unroll
                for (int p = 0; p < 4; ++p) sbn[bj][p] = (f32x2){sbv[bj][2 * p], sbv[bj][2 * p + 1]} * (-LOG2E);
#pragma unroll
            for (int ai = 0; ai < 2; ++ai)
#pragma unroll
                for (int m = 0; m < 4; ++m) { const float sar = sarv[ai * 4 + m]; u32x4 w4;
#pragma unroll
                    for (int bj = 0; bj < 2; ++bj) { const f32x4 a0 = acc[ai][bj][m][0], a1 = acc[ai][bj][m][1];
                        const float v[8] = {a0[0], a0[1], a0[2], a0[3], a1[0], a1[1], a1[2], a1[3]};
                        unsigned pw_[4];
#pragma unroll
                        for (int p = 0; p < 4; ++p) {
                            const f32x2 z = (f32x2){(float)__float_as_int(v[2 * p]), (float)__float_as_int(v[2 * p + 1])} * (sbn[bj][p] * sar);
                            const f32x2 d = (f32x2){fast_exp2(z.x), fast_exp2(z.y)} * (1.0f / 255.0f) + (1.0f / 255.0f);
                            const f32x2 qf = (f32x2){fast_rcp(d.x), fast_rcp(d.y)} + 12582912.0f;
                            pw_[p] = __builtin_amdgcn_perm(__float_as_uint(qf.y), __float_as_uint(qf.x), 0x0c0c0400u); }
                        const unsigned lo = __builtin_amdgcn_perm(pw_[1], pw_[0], 0x05040100u), hi = __builtin_amdgcn_perm(pw_[3], pw_[2], 0x05040100u);
                        if (bj == 0) { w4.x = lo; w4.y = hi; } else { w4.z = lo; w4.w = hi; } }
                    *(u32x4*)(b8 + (ai * 4 + m) * 1024) = w4; }
            return;
        }
        if (grp == 2) { QKV_SARV;
            const int col0 = pnl * BM + wc * 32 + 8 * fq;
#pragma unroll
            for (int ai = 0; ai < 2; ++ai)
#pragma unroll
                for (int m = 0; m < 4; ++m) { const int row = row0 + ai * HALF + m * 16; const float sar = sarv[ai * 4 + m]; bf16* rowp = base + (size_t)row * DM + col0;
#pragma unroll
                    for (int bj = 0; bj < 2; ++bj) { const f32x4 a0 = acc[ai][bj][m][0], a1 = acc[ai][bj][m][1];
                        float v[8] = {a0[0], a0[1], a0[2], a0[3], a1[0], a1[1], a1[2], a1[3]};
#pragma unroll
                        for (int e = 0; e < 8; ++e) v[e] = (float)__float_as_int(v[e]) * (sar * sbv[bj][e]);
                        u32x4 w; w.x = cvt_pk_bf16(v[0], v[1]); w.y = cvt_pk_bf16(v[2], v[3]); w.z = cvt_pk_bf16(v[4], v[5]); w.w = cvt_pk_bf16(v[6], v[7]);
                        *(u32x4*)(rowp + bj * HALF) = w; } }
            return;
        }
        const float* gp = grp == 0 ? qg : kg; const float gs = grp == 0 ? qscale : 1.0f;
        float gv[2][8];
#pragma unroll
        for (int bj = 0; bj < 2; ++bj) { const f32x4 g0 = *(const f32x4*)(gp + 32 * bj + 8 * fq), g1 = *(const f32x4*)(gp + 32 * bj + 8 * fq + 4);
            gv[bj][0] = g0[0] * gs; gv[bj][1] = g0[1] * gs; gv[bj][2] = g0[2] * gs; gv[bj][3] = g0[3] * gs; gv[bj][4] = g1[0] * gs; gv[bj][5] = g1[1] * gs; gv[bj][6] = g1[2] * gs; gv[bj][7] = g1[3] * gs; }
        const int colL = (pnl * 4 + wc) * 64 + 8 * fq;
        f32x4 rp[4];
#pragma unroll
        for (int q = 0; q < 4; ++q) rp[q] = *(const f32x4*)(rope + (size_t)row0 * 16 + 4 * q);
        float sarn = sa[row0];
#pragma unroll
        for (int ai = 0; ai < 2; ++ai)
#pragma unroll
            for (int m = 0; m < 4; ++m) { const int row = row0 + ai * HALF + m * 16; const float sar = sarn;
                const int gi = ai * 4 + m;
                float y[2][8]; float ss = 0.f;
#pragma unroll
                for (int bj = 0; bj < 2; ++bj) { const f32x4 a0 = acc[ai][bj][m][0], a1 = acc[ai][bj][m][1];
                    const float t[8] = {a0[0], a0[1], a0[2], a0[3], a1[0], a1[1], a1[2], a1[3]};
#pragma unroll
                    for (int e = 0; e < 8; ++e) { y[bj][e] = (float)__float_as_int(t[e]) * (sar * sbv[bj][e]); ss += y[bj][e] * y[bj][e]; } }
                ss += __shfl_xor(ss, 16); ss += __shfl_xor(ss, 32);
                const float rstd = rsqrtf(ss * (1.f / 64.f) + EPS);
#pragma unroll
                for (int bj = 0; bj < 2; ++bj)
#pragma unroll
                    for (int e = 0; e < 8; ++e) y[bj][e] *= rstd * gv[bj][e];
                const f32x4 c0 = rp[0], c1 = rp[1], s0 = rp[2], s1 = rp[3];
                const float cs[8] = {c0[0], c0[1], c0[2], c0[3], c1[0], c1[1], c1[2], c1[3]}, sn[8] = {s0[0], s0[1], s0[2], s0[3], s1[0], s1[1], s1[2], s1[3]};
#pragma unroll
                for (int e = 0; e < 8; ++e) { const float px = __shfl_xor(y[0][e], 16);
                    const float r0 = y[0][e] * cs[e] - px * sn[e], r1 = y[0][e] * cs[e] + px * sn[e];
                    y[0][e] = fq == 0 ? r0 : (fq == 1 ? r1 : y[0][e]); }
                if (gi < 7) { const int rown = row0 + ((gi + 1) >> 2) * HALF + ((gi + 1) & 3) * 16;
#pragma unroll
                    for (int q = 0; q < 4; ++q) rp[q] = *(const f32x4*)(rope + (size_t)rown * 16 + 4 * q);
                    sarn = sa[rown]; }
                bf16* rowp = base + (size_t)row * DM + colL;
#pragma unroll
                for (int bj = 0; bj < 2; ++bj) { u32x4 w; w.x = cvt_pk_bf16(y[bj][0], y[bj][1]); w.y = cvt_pk_bf16(y[bj][2], y[bj][3]); w.z = cvt_pk_bf16(y[bj][4], y[bj][5]); w.w = cvt_pk_bf16(y[bj][6], y[bj][7]);
                    *(u32x4*)(rowp + 32 * bj) = w; } }
#undef QKV_SARV
    }
};
struct EpiRowScale {
    static constexpr bool PERM = true;
    bf16* out; int ldc; const float* rss;
    __device__ __forceinline__ void operator()(const f32x4 (&acc)[2][2][4][2], const Unit& u, int wr, int wc, int fr, int fq) const {
        const int row0 = u.pm * BM + wr * 64 + fr, col0 = u.pn * BM + wc * 32 + 8 * fq;
        float rstdv[8];
#pragma unroll
        for (int g = 0; g < 8; ++g) { const f32x4* p = (const f32x4*)(rss + (size_t)(row0 + (g >> 2) * HALF + (g & 3) * 16) * 16);
            const f32x4 s0 = p[0], s1 = p[1], s2 = p[2], s3 = p[3];
            const float ss = ((s0[0] + s0[1]) + (s0[2] + s0[3])) + ((s1[0] + s1[1]) + (s1[2] + s1[3])) + ((s2[0] + s2[1]) + (s2[2] + s2[3])) + ((s3[0] + s3[1]) + (s3[2] + s3[3]));
            rstdv[g] = rsqrtf(ss * (1.0f / DM) + EPS); }
#pragma unroll
        for (int ai = 0; ai < 2; ++ai)
#pragma unroll
            for (int m = 0; m < 4; ++m) { const int row = row0 + ai * HALF + m * 16; const float rstd = rstdv[ai * 4 + m];
                bf16* rowp = out + (size_t)row * ldc + col0;
#pragma unroll
                for (int bj = 0; bj < 2; ++bj) { const f32x4 v0 = acc[ai][bj][m][0] * rstd, v1 = acc[ai][bj][m][1] * rstd;
                    u32x4 w; w.x = cvt_pk_bf16(v0[0], v0[1]); w.y = cvt_pk_bf16(v0[2], v0[3]); w.z = cvt_pk_bf16(v1[0], v1[1]); w.w = cvt_pk_bf16(v1[2], v1[3]);
                    *(u32x4*)(rowp + bj * HALF) = w; } }
    }
};
struct EpiMix {
    static constexpr bool PERM = true;
    const unsigned char* g0; const unsigned char* g1; bf16* mix;
    __device__ __forceinline__ void mid(f32x4 (&acc)[2][2][4][2], const Unit& u, int wr, int wc, int fr, int fq) const {
        const size_t goff = ((size_t)(u.pm * 4 + u.pn) << 16) + (wr * 4 + wc) * 8192 + (fq * 16 + fr) * 16;
#pragma unroll
        for (int ai = 0; ai < 2; ++ai)
#pragma unroll
            for (int m = 0; m < 4; ++m) { const u32x4 a4 = *(const u32x4*)(g0 + goff + (ai * 4 + m) * 1024), b4 = *(const u32x4*)(g1 + goff + (ai * 4 + m) * 1024);
#pragma unroll
                for (int bj = 0; bj < 2; ++bj) {
#pragma unroll
                    for (int e = 0; e < 8; ++e) { const unsigned aw = bj == 0 ? (e < 4 ? a4.x : a4.y) : (e < 4 ? a4.z : a4.w), bw = bj == 0 ? (e < 4 ? b4.x : b4.y) : (e < 4 ? b4.z : b4.w); const int sh = 8 * (e & 3);
                        const float ga = (float)((aw >> sh) & 0xffu), gb = fmaxf((float)((bw >> sh) & 0xffu), 1.0f);
                        acc[ai][bj][m][e >> 2][e & 3] *= ga * fast_rcp(gb); } } }
    }
    __device__ __forceinline__ void operator()(const f32x4 (&acc)[2][2][4][2], const Unit& u, int wr, int wc, int fr, int fq) const {
        const int row0 = u.pm * BM + wr * 64 + fr, col0 = u.pn * BM + wc * 32 + 8 * fq;
        const size_t goff = ((size_t)(u.pm * 4 + u.pn) << 16) + (wr * 4 + wc) * 8192 + (fq * 16 + fr) * 16;
        u32x4 gb8[8];
#pragma unroll
        for (int g = 0; g < 8; ++g) gb8[g] = *(const u32x4*)(g1 + goff + g * 1024);
#pragma unroll
        for (int ai = 0; ai < 2; ++ai)
#pragma unroll
            for (int m = 0; m < 4; ++m) { const size_t off = (size_t)(row0 + ai * HALF + m * 16) * DM + col0; const u32x4 b4 = gb8[ai * 4 + m];
#pragma unroll
                for (int bj = 0; bj < 2; ++bj) { float v[8];
#pragma unroll
                    for (int e = 0; e < 8; ++e) { const unsigned bw = bj == 0 ? (e < 4 ? b4.x : b4.y) : (e < 4 ? b4.z : b4.w); const float gb = fmaxf((float)((bw >> (8 * (e & 3))) & 0xffu), 1.0f) * (1.0f / 255.0f);
                        v[e] = acc[ai][bj][m][e >> 2][e & 3] * gb; }
                    u32x4 w; w.x = cvt_pk_bf16(v[0], v[1]); w.y = cvt_pk_bf16(v[2], v[3]); w.z = cvt_pk_bf16(v[4], v[5]); w.w = cvt_pk_bf16(v[6], v[7]);
                    *(u32x4*)(mix + off + bj * HALF) = w; } }
    }
};
template <bool XF32> struct EpiResid {
    static constexpr bool PERM = true;
    const void* xin; bf16* xb; float* rss; float* amx;
    __device__ __forceinline__ void operator()(const f32x4 (&acc)[2][2][4][2], const Unit& u, int wr, int wc, int fr, int fq) const {
        const int row0 = u.pm * BM + wr * 64 + fr, col0 = u.pn * BM + wc * 32 + 8 * fq;
        constexpr int D = XF32 ? 3 : 4;
        f32x4 xv[D][XF32 ? 4 : 1]; u32x4 xw[D][XF32 ? 1 : 2];
#define ER_LOAD(g) do { const size_t o_ = (size_t)(row0 + ((g) >> 2) * HALF + ((g) & 3) * 16) * DM + col0; _Pragma("unroll") for (int q_ = 0; q_ < 2; ++q_) { const size_t oo_ = o_ + q_ * HALF; \
            if (XF32) { xv[(g) % D][XF32 ? 2 * q_ : 0] = __builtin_nontemporal_load((const f32x4*)((const float*)xin + oo_)); xv[(g) % D][XF32 ? 2 * q_ + 1 : 0] = __builtin_nontemporal_load((const f32x4*)((const float*)xin + oo_ + 4)); } \
            else xw[(g) % D][XF32 ? 0 : q_] = *(const u32x4*)((const bf16*)xin + oo_); } } while (0)
#pragma unroll
        for (int g = 0; g < D - 1; ++g) ER_LOAD(g);
#pragma unroll
        for (int ai = 0; ai < 2; ++ai)
#pragma unroll
            for (int m = 0; m < 4; ++m) { const int row = row0 + ai * HALF + m * 16; const size_t off = (size_t)row * DM + col0; float ss = 0.f, am = 0.f;
                const int gi = ai * 4 + m;
                if (gi + D - 1 < 8) ER_LOAD(gi + D - 1);
#pragma unroll
                for (int bj = 0; bj < 2; ++bj) { f32x4 v0, v1;
                    if (XF32) { v0 = xv[gi % D][XF32 ? 2 * bj : 0]; v1 = xv[gi % D][XF32 ? 2 * bj + 1 : 0]; }
                    else { const u32x4 w = xw[gi % D][XF32 ? 0 : bj]; v0 = (f32x4){bflo(w.x), bfhi(w.x), bflo(w.y), bfhi(w.y)}; v1 = (f32x4){bflo(w.z), bfhi(w.z), bflo(w.w), bfhi(w.w)}; }
                    v0 = v0 + acc[ai][bj][m][0]; v1 = v1 + acc[ai][bj][m][1];
                    u32x4 w; w.x = cvt_pk_bf16(v0[0], v0[1]); w.y = cvt_pk_bf16(v0[2], v0[3]); w.z = cvt_pk_bf16(v1[0], v1[1]); w.w = cvt_pk_bf16(v1[2], v1[3]); *(u32x4*)(xb + off + bj * HALF) = w;
                    ss += ((v0[0] * v0[0] + v0[1] * v0[1]) + (v0[2] * v0[2] + v0[3] * v0[3])) + ((v1[0] * v1[0] + v1[1] * v1[1]) + (v1[2] * v1[2] + v1[3] * v1[3]));
                    am = fmaxf(am, fmaxf(fmaxf(fmaxf(fabsf(v0[0]), fabsf(v0[1])), fmaxf(fabsf(v0[2]), fabsf(v0[3]))), fmaxf(fmaxf(fabsf(v1[0]), fabsf(v1[1])), fmaxf(fabsf(v1[2]), fabsf(v1[3]))))); }
                ss += __shfl_xor(ss, 16); ss += __shfl_xor(ss, 32);
                if (fq == 0) rss[(size_t)row * 16 + u.pn * 4 + wc] = ss;
                if (amx) { am = fmaxf(am, __shfl_xor(am, 16)); am = fmaxf(am, __shfl_xor(am, 32)); if (fq == 0) amx[(size_t)row * 16 + u.pn * 4 + wc] = am; } }
#undef ER_LOAD
    }
};
struct EpiLogit {
    static constexpr bool PERM = false;
    float* logit;
    __device__ __forceinline__ void operator()(const f32x4 (&acc)[2][2][4][2], const Unit& u, int wr, int wc, int fr, int fq) const {
        if (wc >= 2) return;
        const int row0 = u.pm * BM + wr * 64 + fr, col0 = wc * 32 + 4 * fq;
#pragma unroll
        for (int ai = 0; ai < 2; ++ai)
#pragma unroll
            for (int m = 0; m < 4; ++m) { float* rowp = logit + (size_t)(row0 + ai * HALF + m * 16) * 64 + col0;
#pragma unroll
                for (int n = 0; n < 2; ++n) *(f32x4*)(rowp + n * 16) = acc[ai][0][m][n]; }
    }
};
struct EpiGateUp {
    static constexpr bool PERM = true;
    bf16* H; const float* rstd; const float* xs; const float* wsc;
    __device__ __forceinline__ void operator()(const f32x4 (&acc)[2][2][4][2], const Unit& u, int wr, int wc, int fr, int fq) const {
        const int col0 = u.pn * 128 + wc * 32 + 8 * fq;
        int tok[8]; float rs[8];
#pragma unroll
        for (int i = 0; i < 8; ++i) { const int rt = (i >> 2) * HALF + wr * 64 + (i & 3) * 16 + fr; tok[i] = u.rows[rt < u.nvalid ? rt : 0]; }
#pragma unroll
        for (int i = 0; i < 8; ++i) rs[i] = rstd[tok[i]] * xs[tok[i]];
        const float* wcol = wsc + (size_t)u.crow0 * 1024 + u.pn * BM + wc * 32 + 8 * fq;
        float sg[8], su[8];
        { const f32x4 g0 = *(const f32x4*)wcol, g1 = *(const f32x4*)(wcol + 4), u0 = *(const f32x4*)(wcol + HALF), u1 = *(const f32x4*)(wcol + HALF + 4);
          sg[0] = g0[0]; sg[1] = g0[1]; sg[2] = g0[2]; sg[3] = g0[3]; sg[4] = g1[0]; sg[5] = g1[1]; sg[6] = g1[2]; sg[7] = g1[3];
          su[0] = u0[0]; su[1] = u0[1]; su[2] = u0[2]; su[3] = u0[3]; su[4] = u1[0]; su[5] = u1[1]; su[6] = u1[2]; su[7] = u1[3]; }
#pragma unroll
        for (int ai = 0; ai < 2; ++ai)
#pragma unroll
            for (int m = 0; m < 4; ++m) { const int rt = ai * HALF + wr * 64 + m * 16 + fr; const float r_ = rt < u.nvalid ? rs[ai * 4 + m] : 0.f;
                float h[8];
#pragma unroll
                for (int n = 0; n < 2; ++n)
#pragma unroll
                    for (int e = 0; e < 4; ++e) { const float g = (float)__float_as_int(acc[ai][0][m][n][e]) * (r_ * sg[n * 4 + e]), up = (float)__float_as_int(acc[ai][1][m][n][e]) * (r_ * su[n * 4 + e]); h[n * 4 + e] = g * sigmoid_f(g) * up; }
                u32x4 w; w.x = cvt_pk_bf16(h[0], h[1]); w.y = cvt_pk_bf16(h[2], h[3]); w.z = cvt_pk_bf16(h[4], h[5]); w.w = cvt_pk_bf16(h[6], h[7]);
                *(u32x4*)(H + (size_t)(u.pm * BM + rt) * EFF + col0) = w; }
    }
};
struct EpiY {
    static constexpr bool PERM = true;
    bf16* y0; bf16* y1;
    __device__ __forceinline__ void operator()(const f32x4 (&acc)[2][2][4][2], const Unit& u, int wr, int wc, int fr, int fq) const {
        bf16* base = (u.aux ? y1 : y0) + (size_t)u.crow0 * DM + u.pn * BM;
        const unsigned loff = (unsigned)((wr * 64 + fr) * DM + wc * 32 + 8 * fq); const int rt0 = wr * 64 + fr;
#pragma unroll
        for (int ai = 0; ai < 2; ++ai)
#pragma unroll
            for (int m = 0; m < 4; ++m) {
                if (rt0 + ai * HALF + m * 16 < u.nvalid) {
#pragma unroll
                    for (int bj = 0; bj < 2; ++bj) { const f32x4 v0 = acc[ai][bj][m][0], v1 = acc[ai][bj][m][1];
                        u32x4 w; w.x = cvt_pk_bf16(v0[0], v0[1]); w.y = cvt_pk_bf16(v0[2], v0[3]); w.z = cvt_pk_bf16(v1[0], v1[1]); w.w = cvt_pk_bf16(v1[2], v1[3]);
                        *(u32x4*)(base + loff + (unsigned)((ai * HALF + m * 16) * DM + bj * HALF)) = w; } } }
    }
};
}

#define XB_TMO      128
#define XB_XCNT(j)  (256  + 64 * (j))
#define XB_XSUB(j)  (1280 + 64 * (j))
#define XB_XGEN(j)  (2304 + 64 * (j))
#define XB_TOP      3328
#define XB_TOPGEN   3392
#define XCD_BAR_WORDS 3456
#define XB_SPIN_CAP (1u << 18)
__device__ __forceinline__ unsigned xb_ld(unsigned* p)              { return __hip_atomic_load(p, __ATOMIC_RELAXED, __HIP_MEMORY_SCOPE_AGENT); }
__device__ __forceinline__ unsigned xb_add(unsigned* p, unsigned v) { return __hip_atomic_fetch_add(p, v, __ATOMIC_RELAXED, __HIP_MEMORY_SCOPE_AGENT); }
__device__ __forceinline__ unsigned xb_xcc_id() { return (unsigned)__builtin_amdgcn_s_getreg((3 << 11) | 20) & 0xFu; }
#define XB_SPIN(cond, bar) do { unsigned _sp = 0; while (cond) { __builtin_amdgcn_s_sleep(1); \
    if ((++_sp & 255u) == 0u) { if (xb_ld(&(bar)[XB_TMO])) break; if (_sp > XB_SPIN_CAP) { atomicAdd(&(bar)[XB_TMO], 1u); break; } } } } while (0)
struct XcdBarrier { unsigned* bar; unsigned x; volatile LAS unsigned* st; };
__device__ __forceinline__ XcdBarrier xcd_barrier_post(unsigned* bar, volatile LAS unsigned* st) {
    XcdBarrier b; b.bar = bar; b.x = xb_xcc_id(); b.st = st;
    if (threadIdx.x == 0) (void)xb_add(&bar[XB_XCNT(b.x)], 1u);
    return b;
}
__device__ __forceinline__ void xcd_barrier_complete(unsigned* bar, unsigned x, unsigned& nloc, unsigned& nx) {
    const unsigned G = gridDim.x * gridDim.y * gridDim.z;
    unsigned sum, cnt, mine, sp = 0u;
    for (;;) {
        sum = 0u; cnt = 0u; mine = 0u;
#pragma unroll
        for (unsigned j = 0; j < 16; ++j) { const unsigned c = xb_ld(&bar[XB_XCNT(j)]); sum += c; cnt += (c > 0u) ? 1u : 0u; mine = (j == x) ? c : mine; }
        if (sum == G) break;
        __builtin_amdgcn_s_sleep(1);
        if ((++sp & 255u) == 0u) { if (xb_ld(&bar[XB_TMO])) break; if (sp > XB_SPIN_CAP) { atomicAdd(&bar[XB_TMO], 1u); break; } }
    }
    nloc = mine > 0u ? mine : 1u; nx = cnt > 0u ? cnt : 1u;
}
__device__ __forceinline__ void xcd_barrier(const XcdBarrier& b) {
    asm volatile("s_waitcnt vmcnt(0)" ::: "memory");
    __syncthreads();
    if (threadIdx.x == 0) {
        unsigned* bar = b.bar;
        __builtin_amdgcn_s_waitcnt(0);
        unsigned nloc = b.st[0], nx = b.st[1];
        if (nloc == 0u) { xcd_barrier_complete(bar, b.x, nloc, nx); b.st[0] = nloc; b.st[1] = nx; }
        const unsigned old = xb_add(&bar[XB_XSUB(b.x)], 1u);
        const unsigned gen = old / nloc;
        if (old + 1u == (gen + 1u) * nloc) {
            __builtin_amdgcn_fence(__ATOMIC_RELEASE, "agent");
            asm volatile("s_waitcnt vmcnt(0)" ::: "memory");
            const unsigned og = xb_add(&bar[XB_TOP], 1u);
            const unsigned tg = og / nx;
            if (og + 1u == (tg + 1u) * nx) xb_add(&bar[XB_TOPGEN], 1u);
            else XB_SPIN(xb_ld(&bar[XB_TOPGEN]) == tg, bar);
            __builtin_amdgcn_fence(__ATOMIC_ACQUIRE, "agent");
            xb_add(&bar[XB_XGEN(b.x)], 1u);
            asm volatile("s_waitcnt vmcnt(0)" ::: "memory");
        } else {
            XB_SPIN(xb_ld(&bar[XB_XGEN(b.x)]) == gen, bar);
            __builtin_amdgcn_fence(__ATOMIC_ACQUIRE, "agent");
            asm volatile("s_waitcnt vmcnt(0)" ::: "memory");
        }
    }
    __syncthreads();
}

struct Args { const void* in[36]; float* out; unsigned char* ws; int ph_lo, ph_hi, li, pad; };
enum { I_X = 0, I_MEM, I_POS, I_NORM_MIX, I_W_IN, I_CONV_W, I_CONV_B, I_LRU_WA, I_LRU_BA, I_LRU_WX, I_LRU_BX, I_LRU_LAMBDA, I_W_LRU_O, I_Q_NORM, I_K_NORM,
       I_LQ1, I_LK1, I_LQ2, I_LK2, I_SUBLN, I_W_ATTN_O, I_W_OUT, I_NORM_CX, I_NORM_MEM, I_W_CQ, I_W_CKV, I_CQ_NORM, I_CK_NORM, I_W_CO, I_NORM_FFN,
       I_W_GROUP, I_B_GROUP, I_W_ROUTER, I_B_ROUTER, I_W_GATE_UP, I_W_DOWN };

template <int MODE>
__device__ __forceinline__ void transpose_item(const float* W, int K, int N, bf16* WT, int row_off, const float* gain, LAS float* scr, int item, int lane) {
    const int nblk = N / 32, kb = item / nblk, nb = item % nblk, k0 = 64 * kb, n0 = 32 * nb;
    float tv[32];
#pragma unroll
    for (int i = 0; i < 32; ++i) { const int kk = 2 * i + (lane >> 5); tv[i] = W[(size_t)(k0 + kk) * N + n0 + (lane & 31)]; }
#pragma unroll
    for (int i = 0; i < 32; ++i) { const int kk = 2 * i + (lane >> 5); float v = tv[i]; if (gain) v *= gain[k0 + kk]; scr[kk * 33 + (lane & 31)] = v; }
    LDS_WAIT(); asm volatile("" ::: "memory");
    const int c = lane & 7;
#pragma unroll
    for (int j = 0; j < 4; ++j) { const int n = (lane >> 3) + 8 * j; const LAS float* s = scr + (8 * c) * 33 + n;
        u32x4 o; o.x = cvt_pk_bf16(s[0 * 33], s[1 * 33]); o.y = cvt_pk_bf16(s[2 * 33], s[3 * 33]); o.z = cvt_pk_bf16(s[4 * 33], s[5 * 33]); o.w = cvt_pk_bf16(s[6 * 33], s[7 * 33]);
        const int ng = n0 + n; int dr;
        if (MODE == 0) dr = row_off + ng; else { const int jj = ng & 511, up = ng >> 9; dr = row_off + (jj >> 7) * 256 + up * 128 + (jj & 127); }
        *(u32x4*)(WT + (size_t)dr * K + k0 + 8 * c) = o; }
    LDS_WAIT(); asm volatile("" ::: "memory");
}
__device__ __forceinline__ unsigned pack_i8x4(float a, float b, float c, float d) {
    const int ia = max(-127, min(127, __float2int_rn(a))), ib = max(-127, min(127, __float2int_rn(b))), ic = max(-127, min(127, __float2int_rn(c))), id = max(-127, min(127, __float2int_rn(d)));
    return (unsigned)(ia & 0xff) | ((unsigned)(ib & 0xff) << 8) | ((unsigned)(ic & 0xff) << 16) | ((unsigned)(id & 0xff) << 24);
}
__device__ __forceinline__ void rms_row_to_i8(const float* xrow, const float* g, unsigned char* orow, float* xs, int lane) {
    const f32x4* xr = (const f32x4*)xrow + lane; const f32x4* gr = (const f32x4*)g + lane;
    f32x4 v[4]; float s = 0.f;
#pragma unroll
    for (int j = 0; j < 4; ++j) { v[j] = __builtin_nontemporal_load(xr + 64 * j); s += (v[j].x * v[j].x + v[j].y * v[j].y) + (v[j].z * v[j].z + v[j].w * v[j].w); }
    const float rstd = rsqrtf(wave_sum(s) * (1.f / DM) + EPS); float mx = 0.f;
#pragma unroll
    for (int j = 0; j < 4; ++j) { const f32x4 gg = gr[64 * j]; v[j] = v[j] * gg * rstd; mx = fmaxf(mx, fmaxf(fmaxf(fabsf(v[j].x), fabsf(v[j].y)), fmaxf(fabsf(v[j].z), fabsf(v[j].w)))); }
    mx = wave_max(mx); const float sc = mx > 0.f ? mx * (1.0f / 127.0f) : 1.0f, inv = 1.0f / sc;
    if (lane == 0) *xs = sc;
    unsigned* o4 = (unsigned*)orow + lane;
#pragma unroll
    for (int j = 0; j < 4; ++j) o4[64 * j] = pack_i8x4(v[j].x * inv, v[j].y * inv, v[j].z * inv, v[j].w * inv);
}
__device__ __forceinline__ int win_dest(int n0) { if (n0 >= 2048 && n0 < 4096) { const int l0 = n0 & 255; return (n0 & ~255) + 128 * ((l0 >> 5) & 1) + 32 * (l0 >> 6); } return n0; }
__device__ __forceinline__ void win_absmax_item(const float* W, unsigned* wmax, int item, int lane) {
    constexpr int nblk = NWIN / 32; const int kb = item / nblk, nb = item % nblk, k0 = 64 * kb, n0 = 32 * nb;
    float tv[32], mx = 0.f;
#pragma unroll
    for (int i = 0; i < 32; ++i) { const int kk = 2 * i + (lane >> 5); tv[i] = W[(size_t)(k0 + kk) * NWIN + n0 + (lane & 31)]; }
#pragma unroll
    for (int i = 0; i < 32; ++i) mx = fmaxf(mx, fabsf(tv[i]));
    mx = fmaxf(mx, __shfl_xor(mx, 32));
    if (lane < 32) atomicMax(wmax + win_dest(n0) + lane, __float_as_uint(mx));
}
__device__ __forceinline__ void win_quant_item(const float* W, unsigned char* WT, const unsigned* wmax, float* wsc, LAS float* scr, int item, int lane) {
    constexpr int nblk = NWIN / 32; const int kb = item / nblk, nb = item % nblk, k0 = 64 * kb, n0 = 32 * nb, d0 = win_dest(n0);
    float tv[32];
#pragma unroll
    for (int i = 0; i < 32; ++i) { const int kk = 2 * i + (lane >> 5); tv[i] = W[(size_t)(k0 + kk) * NWIN + n0 + (lane & 31)]; }
    if (lane < 32) { const float mx = __uint_as_float(__hip_atomic_load(wmax + d0 + lane, __ATOMIC_RELAXED, __HIP_MEMORY_SCOPE_AGENT)); const float sc = mx > 0.f ? mx * (1.0f / 127.0f) : 1.0f;
        scr[64 * 33 + lane] = 1.0f / sc; if (kb == 0) wsc[d0 + lane] = sc; }
#pragma unroll
    for (int i = 0; i < 32; ++i) { const int kk = 2 * i + (lane >> 5); scr[kk * 33 + (lane & 31)] = tv[i]; }
    LDS_WAIT(); asm volatile("" ::: "memory");
    const int c = lane & 7;
#pragma unroll
    for (int j = 0; j < 4; ++j) { const int n = (lane >> 3) + 8 * j; const LAS float* sp = scr + (8 * c) * 33 + n; const float inv = scr[64 * 33 + n];
        u32x2 o; o.x = pack_i8x4(sp[0 * 33] * inv, sp[1 * 33] * inv, sp[2 * 33] * inv, sp[3 * 33] * inv); o.y = pack_i8x4(sp[4 * 33] * inv, sp[5 * 33] * inv, sp[6 * 33] * inv, sp[7 * 33] * inv);
        *(u32x2*)(WT + (size_t)(d0 + n) * DM + k0 + 8 * c) = o; }
    LDS_WAIT(); asm volatile("" ::: "memory");
}
__device__ __forceinline__ int gu_dest(int n) { const int jj = n & 511, up = n >> 9; return (jj >> 7) * 256 + up * 128 + (jj & 127); }
__device__ __forceinline__ void gu_absmax_item(const float* W, const float* gain, unsigned* wmax  , int item, int lane) {
    const int kb = item >> 5, nb = item & 31, k0 = 64 * kb, n0 = 32 * nb;
    float tv[32], mx = 0.f;
#pragma unroll
    for (int i = 0; i < 32; ++i) { const int kk = 2 * i + (lane >> 5); tv[i] = W[(size_t)(k0 + kk) * 1024 + n0 + (lane & 31)]; }
#pragma unroll
    for (int i = 0; i < 32; ++i) { const int kk = 2 * i + (lane >> 5); mx = fmaxf(mx, fabsf(tv[i] * gain[k0 + kk])); }
    mx = fmaxf(mx, __shfl_xor(mx, 32));
    if (lane < 32) atomicMax(wmax + gu_dest(n0) + lane, __float_as_uint(mx));
}
__device__ __forceinline__ void gu_quant_item(const float* W, const float* gain, unsigned char* WT  , const unsigned* wmax, float* wsc, LAS float* scr, int item, int lane) {
    const int kb = item >> 5, nb = item & 31, k0 = 64 * kb, n0 = 32 * nb, d0 = gu_dest(n0);
    float tv[32];
#pragma unroll
    for (int i = 0; i < 32; ++i) { const int kk = 2 * i + (lane >> 5); tv[i] = W[(size_t)(k0 + kk) * 1024 + n0 + (lane & 31)]; }
    if (lane < 32) { const float mx = __uint_as_float(__hip_atomic_load(wmax + d0 + lane, __ATOMIC_RELAXED, __HIP_MEMORY_SCOPE_AGENT)); const float sc = mx > 0.f ? mx * (1.0f / 127.0f) : 1.0f;
        scr[64 * 33 + lane] = 1.0f / sc; if (kb == 0) wsc[d0 + lane] = sc; }
#pragma unroll
    for (int i = 0; i < 32; ++i) { const int kk = 2 * i + (lane >> 5); scr[kk * 33 + (lane & 31)] = tv[i] * gain[k0 + kk]; }
    LDS_WAIT(); asm volatile("" ::: "memory");
    const int c = lane & 7;
#pragma unroll
    for (int j = 0; j < 4; ++j) { const int n = (lane >> 3) + 8 * j; const LAS float* sp = scr + (8 * c) * 33 + n; const float inv = scr[64 * 33 + n];
        u32x2 o; o.x = pack_i8x4(sp[0 * 33] * inv, sp[1 * 33] * inv, sp[2 * 33] * inv, sp[3 * 33] * inv); o.y = pack_i8x4(sp[4 * 33] * inv, sp[5 * 33] * inv, sp[6 * 33] * inv, sp[7 * 33] * inv);
        *(u32x2*)(WT + (size_t)(d0 + n) * DM + k0 + 8 * c) = o; }
    LDS_WAIT(); asm volatile("" ::: "memory");
}
__device__ __forceinline__ void rms_row_to_bf16(const float* xrow, const float* g, bf16* orow, int lane) {
    const f32x4* xr = (const f32x4*)xrow + lane; const f32x4* gr = (const f32x4*)g + lane;
    f32x4 v[4]; float s = 0.f;
#pragma unroll
    for (int j = 0; j < 4; ++j) { v[j] = xr[64 * j]; s += (v[j].x * v[j].x + v[j].y * v[j].y) + (v[j].z * v[j].z + v[j].w * v[j].w); }
    const float rstd = rsqrtf(wave_sum(s) * (1.f / DM) + EPS);
    u32x2* o8 = (u32x2*)orow + lane;
#pragma unroll
    for (int j = 0; j < 4; ++j) { const f32x4 gg = gr[64 * j]; u32x2 w; w.x = cvt_pk_bf16(v[j].x * rstd * gg.x, v[j].y * rstd * gg.y); w.y = cvt_pk_bf16(v[j].z * rstd * gg.z, v[j].w * rstd * gg.w); o8[64 * j] = w; }
}
__device__ __forceinline__ void colquant_wg_item(const float* W, int N, int n0, int d0, const LAS float* gain_l  , unsigned char* WT, float* wsc, LAS float* red, int tid) {
    const int ks = tid >> 5, nl = tid & 31;
    float v[64];
    const float* src = W + (size_t)(64 * ks) * N + n0 + nl;
#pragma unroll
    for (int i = 0; i < 64; ++i) v[i] = src[(size_t)i * N];
    if (gain_l) {
#pragma unroll
        for (int i = 0; i < 16; ++i) { const f32x4 g4 = *(const LAS f32x4*)(gain_l + 64 * ks + 4 * i); v[4 * i] *= g4[0]; v[4 * i + 1] *= g4[1]; v[4 * i + 2] *= g4[2]; v[4 * i + 3] *= g4[3]; } }
    float mx = 0.f;
#pragma unroll
    for (int i = 0; i < 64; ++i) mx = fmaxf(mx, fabsf(v[i]));
    red[ks * 32 + nl] = mx;
    __syncthreads();
    float cm = 0.f;
#pragma unroll
    for (int j = 0; j < 16; ++j) cm = fmaxf(cm, red[j * 32 + nl]);
    const float sc = cm > 0.f ? cm * (1.0f / 127.0f) : 1.0f, inv = 1.0f / sc;
    if (ks == 0) wsc[d0 + nl] = sc;
    unsigned char* dst = WT + (size_t)(d0 + nl) * DM + 64 * ks;
#pragma unroll
    for (int q = 0; q < 4; ++q) { u32x4 o;
        o.x = pack_i8x4(v[16 * q] * inv, v[16 * q + 1] * inv, v[16 * q + 2] * inv, v[16 * q + 3] * inv); o.y = pack_i8x4(v[16 * q + 4] * inv, v[16 * q + 5] * inv, v[16 * q + 6] * inv, v[16 * q + 7] * inv);
        o.z = pack_i8x4(v[16 * q + 8] * inv, v[16 * q + 9] * inv, v[16 * q + 10] * inv, v[16 * q + 11] * inv); o.w = pack_i8x4(v[16 * q + 12] * inv, v[16 * q + 13] * inv, v[16 * q + 14] * inv, v[16 * q + 15] * inv);
        *(u32x4*)(dst + 16 * q) = o; }
    __syncthreads();
}
__device__ __forceinline__ void prologue_phase(const Args& args, LAS unsigned char* lds, int vcu, int G, int wave, int lane) {
    unsigned char* ws = args.ws;
    LAS float* scr = (LAS float*)(lds + wave * 16384);
    const int gw = vcu * NWAVES + wave, NGW = G * NWAVES;
    constexpr int I0 = 0  , I1 = 512, I4 = 256, I5 = 512, I6 = 256, I7 = 0, I8 = 256  , I9 = 8  ;
    constexpr int E0 = I0, E1 = E0 + 3 * I1, E4 = E1 + I4, E5 = E4 + I5, E6 = E5 + I6, E7 = E6 + NEXP * I7, E8 = E7 + NEXP * I8, E9 = E8 + 16 * I9;
    for (int it = gw; it < E9; it += NGW) {
        if (it < E0) { win_absmax_item((const float*)args.in[I_W_IN], (unsigned*)(ws + WS_CTL) + CW_WMAX, it, lane); continue; }
        if (it < E1) { const int r = it - E0, w = r / I1; const float* src = (const float*)args.in[w == 0 ? I_W_LRU_O : (w == 1 ? I_W_ATTN_O : I_W_OUT)];
            bf16* dst = (bf16*)(ws + (w == 0 ? WS_WLRUO : (w == 1 ? WS_WATTNO : WS_WOUT))); transpose_item<0>(src, DM, DM, dst, 0, nullptr, scr, r % I1, lane); continue; }
        if (it < E4) { transpose_item<0>((const float*)args.in[I_W_CQ], DM, 512, (bf16*)(ws + WS_WCQ), 0, (const float*)args.in[I_NORM_CX], scr, it - E1, lane); continue; }
        if (it < E5) { transpose_item<0>((const float*)args.in[I_W_CKV], DM, DM, (bf16*)(ws + WS_WCKV), 0, nullptr, scr, it - E4, lane); continue; }
        if (it < E6) { transpose_item<0>((const float*)args.in[I_W_CO], 512, DM, (bf16*)(ws + WS_WCO), 0, nullptr, scr, it - E5, lane); continue; }
        if (it < E7) { const int r = it - E6, e = r / I7; gu_absmax_item((const float*)args.in[I_W_GATE_UP] + (size_t)e * DM * 1024, (const float*)args.in[I_NORM_FFN], (unsigned*)(ws + WS_CTL) + CW_WMAX2 + e * 1024, r % I7, lane); continue; }
        if (it < E8) { const int r = it - E7, e = r / I8; transpose_item<0>((const float*)args.in[I_W_DOWN] + (size_t)e * EFF * DM, EFF, DM, (bf16*)(ws + WS_WDN) + (size_t)e * DM * EFF, 0, nullptr, scr, r % I8, lane); continue; }
        { const int r = it - E8, blk = r / (2 * I9), which = (r / I9) & 1; const float* src = (const float*)args.in[which ? I_LRU_WX : I_LRU_WA] + (size_t)blk * 128 * 128;
          transpose_item<0>(src, 128, 128, (bf16*)(ws + WS_WLRU) + (size_t)blk * 256 * 128, which * 128, nullptr, scr, r % I9, lane); }
    }
    { const float* wg = (const float*)args.in[I_W_GROUP]; const float* wr_ = (const float*)args.in[I_W_ROUTER]; const float* gf = (const float*)args.in[I_NORM_FFN]; bf16* dst = (bf16*)(ws + WS_WRT);
      for (int idx = gw * 64 + lane; idx < 256 * DM; idx += NGW * 64) { const int n = idx >> 10, k = idx & 1023; float v = 0.f;
          if (n < 4) v = wg[k * 4 + n] * gf[k]; else if (n < 36) v = wr_[k * 32 + (n - 4)] * gf[k];
          dst[idx] = (bf16)(cvt_pk_bf16(v, 0.f) & 0xffffu); } }
    { const int* pos = (const int*)args.in[I_POS]; float* rope = (float*)(ws + WS_ROPE);
      for (int idx = gw * 64 + lane; idx < MTOK * 8; idx += NGW * 64) { const int row = idx >> 3, i = idx & 7;
          const float invf = expf(-13.122363377404328f * (float)i * 0.125f); float sn, cs; sincosf((float)pos[row] * invf, &sn, &cs);
          rope[(size_t)row * 16 + i] = cs; rope[(size_t)row * 16 + 8 + i] = sn; } }
    for (int m = gw; m < MTOK; m += 2 * NGW) {
        rms_row_to_i8((const float*)args.in[I_X] + (size_t)m * DM, (const float*)args.in[I_NORM_MIX], ws + WS_XN + (size_t)m * DM, (float*)(ws + WS_XS) + m, lane);
        if (m + NGW < MTOK) rms_row_to_i8((const float*)args.in[I_X] + (size_t)(m + NGW) * DM, (const float*)args.in[I_NORM_MIX], ws + WS_XN + (size_t)(m + NGW) * DM, (float*)(ws + WS_XS) + m + NGW, lane); }
    for (int m = gw; m < MEMROWS; m += NGW) rms_row_to_bf16((const float*)args.in[I_MEM] + (size_t)m * DM, (const float*)args.in[I_NORM_MEM], (bf16*)(ws + WS_MEMN) + (size_t)m * DM, lane);
}

__device__ __forceinline__ void qk16_process(const bf16* p, bf16* po, const float (&g)[16], const float (&cs)[8], const float (&sn)[8], int lane) {
    const u32x4 w0 = *(const u32x4*)p, w1 = *(const u32x4*)(p + 8);
    float v[16] = { bflo(w0.x), bfhi(w0.x), bflo(w0.y), bfhi(w0.y), bflo(w0.z), bfhi(w0.z), bflo(w0.w), bfhi(w0.w), bflo(w1.x), bfhi(w1.x), bflo(w1.y), bfhi(w1.y), bflo(w1.z), bfhi(w1.z), bflo(w1.w), bfhi(w1.w) };
    float ss = 0.f;
#pragma unroll
    for (int d = 0; d < 16; ++d) ss += v[d] * v[d];
    ss += __shfl_xor(ss, 1); ss += __shfl_xor(ss, 2);
    const float rstd = rsqrtf(ss * (1.f / 64.f) + EPS);
#pragma unroll
    for (int d = 0; d < 16; ++d) v[d] = v[d] * rstd * g[d];
    if ((lane & 3) == 0) {
#pragma unroll
        for (int i = 0; i < 8; ++i) { const float x1 = v[i], x2 = v[8 + i]; v[i] = x1 * cs[i] - x2 * sn[i]; v[8 + i] = x2 * cs[i] + x1 * sn[i]; } }
    u32x4 o0, o1; o0.x = cvt_pk_bf16(v[0], v[1]); o0.y = cvt_pk_bf16(v[2], v[3]); o0.z = cvt_pk_bf16(v[4], v[5]); o0.w = cvt_pk_bf16(v[6], v[7]);
    o1.x = cvt_pk_bf16(v[8], v[9]); o1.y = cvt_pk_bf16(v[10], v[11]); o1.z = cvt_pk_bf16(v[12], v[13]); o1.w = cvt_pk_bf16(v[14], v[15]);
    *(u32x4*)po = o0; *(u32x4*)(po + 8) = o1;
}
__device__ __forceinline__ void qknorm_phase(const bf16* Q, const bf16* Kb, bf16* Qo, bf16* Ko, const int* pos, const float* qg, const float* kg, int gw, int NGW, int lane) {
    float gq[16], gk[16];
#pragma unroll
    for (int d = 0; d < 16; ++d) { gq[d] = qg[16 * (lane & 3) + d] * (0.125f * LOG2E); gk[d] = kg[16 * (lane & 3) + d]; }
    const float invf = expf(-13.122363377404328f * (float)(lane & 7) * 0.125f);
    for (int row = gw; row < MTOK; row += NGW) {
        const float ang = (float)pos[row] * invf; float s_, c_; sincosf(ang, &s_, &c_);
        float cs[8], sn[8];
#pragma unroll
        for (int i = 0; i < 8; ++i) { cs[i] = __uint_as_float(__builtin_amdgcn_readlane(__float_as_uint(c_), i)); sn[i] = __uint_as_float(__builtin_amdgcn_readlane(__float_as_uint(s_), i)); }
        qk16_process(Q + (size_t)row * DM + 16 * lane, Qo + (size_t)row * DM + 16 * lane, gq, cs, sn, lane);
        qk16_process(Kb + (size_t)row * DM + 16 * lane, Ko + (size_t)row * DM + 16 * lane, gk, cs, sn, lane);
    }
}
__device__ __forceinline__ void headnorm128_phase(const bf16* X, bf16* Xo, int pitch, int nrows, const float* g, float scale, int gw, int NGW, int lane) {
    float gg[8];
#pragma unroll
    for (int e = 0; e < 8; ++e) gg[e] = g[8 * (lane & 15) + e] * scale;
    for (int row = gw; row < nrows; row += NGW) {
        const bf16* p = X + (size_t)row * pitch + 8 * lane; const u32x4 w = *(const u32x4*)p;
        float v[8] = { bflo(w.x), bfhi(w.x), bflo(w.y), bfhi(w.y), bflo(w.z), bfhi(w.z), bflo(w.w), bfhi(w.w) };
        float ss = 0.f;
#pragma unroll
        for (int e = 0; e < 8; ++e) ss += v[e] * v[e];
        ss += __shfl_xor(ss, 1); ss += __shfl_xor(ss, 2); ss += __shfl_xor(ss, 4); ss += __shfl_xor(ss, 8);
        const float rstd = rsqrtf(ss * (1.f / 128.f) + EPS);
        u32x4 o; o.x = cvt_pk_bf16(v[0] * rstd * gg[0], v[1] * rstd * gg[1]); o.y = cvt_pk_bf16(v[2] * rstd * gg[2], v[3] * rstd * gg[3]);
        o.z = cvt_pk_bf16(v[4] * rstd * gg[4], v[5] * rstd * gg[5]); o.w = cvt_pk_bf16(v[6] * rstd * gg[6], v[7] * rstd * gg[7]);
        *(u32x4*)(Xo + (size_t)row * pitch + 8 * lane) = o;
    }
}

constexpr int LRU_RAW = 0, LRU_RAWP = 528  , LRU_XC = 128 * LRU_RAWP, LRU_XCP = 272, LRU_GG = LRU_XC + 64 * 272, LRU_GGP = 144, LRU_UT = LRU_GG + 2 * 64 * 144;
static_assert(LRU_UT + 64 * 144 <= RING_BYTES, "LRU LDS map");
__device__ __forceinline__ float dpp_shr(float v, float old, int n) {
    const int o = __float_as_int(old), s = __float_as_int(v); int r;
    switch (n) { case 1: r = __builtin_amdgcn_update_dpp(o, s, 0x111, 0xf, 0xf, false); break; case 2: r = __builtin_amdgcn_update_dpp(o, s, 0x112, 0xf, 0xf, false); break;
                 case 4: r = __builtin_amdgcn_update_dpp(o, s, 0x114, 0xf, 0xf, false); break; default: r = __builtin_amdgcn_update_dpp(o, s, 0x118, 0xf, 0xf, false); break; }
    return __int_as_float(r);
}
__device__ __forceinline__ void lru_phase(const Args& args, LAS unsigned char* lds, int vcu, int G) {
    unsigned char* ws = args.ws;
    const int tid = threadIdx.x, lane = tid & 63, wid = __builtin_amdgcn_readfirstlane(tid >> 6), j16 = lane & 15, g4 = lane >> 4;
    const bf16* LIN = (const bf16*)(ws + WS_LIN); const bf16* GGb = (const bf16*)(ws + WS_GG); bf16* U = (bf16*)(ws + WS_U);
    const float* convw = (const float*)args.in[I_CONV_W]; const float* convb = (const float*)args.in[I_CONV_B];
    for (int unit = vcu; unit < NB * 16; unit += G) {
        const int b = unit >> 4, n = (unit >> 1) & 7, hh = unit & 1;
        const int cg = tid & 15;
        float cw[4][8], cb[8];
#pragma unroll
        for (int e = 0; e < 8; ++e) { cb[e] = convb[128 * n + 8 * cg + e];
#pragma unroll
            for (int k = 0; k < 4; ++k) cw[k][e] = convw[k * DM + 128 * n + 8 * cg + e]; }
        bf16x8 wf[4];
        { const int i = j16, grp = i >> 2, chl = (grp >> 1) * 4 + (i & 3), iswx = grp & 1, col = iswx * 128 + 64 * hh + 8 * wid + chl;
          const bf16* wp = (const bf16*)(ws + WS_WLRU) + ((size_t)n * 256 + col) * 128 + 8 * g4;
#pragma unroll
          for (int ks = 0; ks < 4; ++ks) wf[ks] = *(const bf16x8*)(wp + 32 * ks); }
        const int chl0 = 8 * wid + 4 * (g4 >> 1) + 2 * (g4 & 1);
        const int chg0 = 128 * n + 64 * hh + chl0;
        float ba[2], bx[2], sp8[2];
#pragma unroll
        for (int q = 0; q < 2; ++q) { ba[q] = ((const float*)args.in[I_LRU_BA])[chg0 + q]; bx[q] = ((const float*)args.in[I_LRU_BX])[chg0 + q];
            const float lam = ((const float*)args.in[I_LRU_LAMBDA])[chg0 + q]; sp8[q] = 8.0f * log1pf(expf(-lam)); }
        float hprev[2] = {0.f, 0.f};
        const size_t rowbase = (size_t)b * SEQ;
        const int lrow[2] = { tid >> 4, (tid + 512) >> 4 }, lpc = tid & 15;
        const int grow = tid >> 3, gpc = tid & 7, grho = (grow & 3) * 16 + (grow >> 2);
        u32x4 rl[2], rg;
#define LRU_FILL(row_, pc_, w_) do { LAS unsigned char* d_ = lds + LRU_RAW + (row_) * LRU_RAWP + (pc_) * 16; \
            *(LAS f32x4*)d_ = (f32x4){bflo((w_).x), bfhi((w_).x), bflo((w_).y), bfhi((w_).y)}; *(LAS f32x4*)(d_ + 256) = (f32x4){bflo((w_).z), bfhi((w_).z), bflo((w_).w), bfhi((w_).w)}; } while (0)
        if (tid < 3 * 32) *(LAS u32x4*)(lds + LRU_RAW + (125 + tid / 32) * LRU_RAWP + (tid & 31) * 16) = (u32x4){0u, 0u, 0u, 0u};
#pragma unroll
        for (int i = 0; i < 2; ++i) rl[i] = *(const u32x4*)(LIN + (rowbase + lrow[i]) * DM + 128 * n + 8 * lpc);
        rg = *(const u32x4*)(GGb + (rowbase + grow) * DM + 128 * n + 64 * hh + 8 * gpc);
#pragma unroll
        for (int i = 0; i < 2; ++i) LRU_FILL(lrow[i], lpc, rl[i]);
        *(LAS u32x4*)(lds + LRU_GG + grho * LRU_GGP + gpc * 16) = rg;
#pragma unroll
        for (int i = 0; i < 2; ++i) rl[i] = *(const u32x4*)(LIN + (rowbase + 64 + lrow[i]) * DM + 128 * n + 8 * lpc);
        rg = *(const u32x4*)(GGb + (rowbase + 64 + grow) * DM + 128 * n + 64 * hh + 8 * gpc);
        __syncthreads();
        for (int it = 0; it < SEQ / 64; ++it) {
            const int t0 = 64 * it;
#pragma unroll
            for (int i = 0; i < 2; ++i) { const int t = (tid >> 4) + 32 * i; f32x2 a2[4];
#pragma unroll
                for (int e = 0; e < 4; ++e) a2[e] = (f32x2){cb[2 * e], cb[2 * e + 1]};
#pragma unroll
                for (int k = 0; k < 4; ++k) { const int rr = (t0 + t - 3 + k) & 127; const LAS unsigned char* rp_ = lds + LRU_RAW + rr * LRU_RAWP + cg * 16;
                    const f32x4 xa = *(const LAS f32x4*)rp_, xb4 = *(const LAS f32x4*)(rp_ + 256);
                    a2[0] = __builtin_elementwise_fma((f32x2){cw[k][0], cw[k][1]}, (f32x2){xa.x, xa.y}, a2[0]); a2[1] = __builtin_elementwise_fma((f32x2){cw[k][2], cw[k][3]}, (f32x2){xa.z, xa.w}, a2[1]);
                    a2[2] = __builtin_elementwise_fma((f32x2){cw[k][4], cw[k][5]}, (f32x2){xb4.x, xb4.y}, a2[2]); a2[3] = __builtin_elementwise_fma((f32x2){cw[k][6], cw[k][7]}, (f32x2){xb4.z, xb4.w}, a2[3]); }
                u32x4 o; o.x = cvt_pk_bf16(a2[0].x, a2[0].y); o.y = cvt_pk_bf16(a2[1].x, a2[1].y); o.z = cvt_pk_bf16(a2[2].x, a2[2].y); o.w = cvt_pk_bf16(a2[3].x, a2[3].y);
                const int rho = (t & 3) * 16 + (t >> 2);
                *(LAS u32x4*)(lds + LRU_XC + rho * LRU_XCP + cg * 16) = o; }
            __syncthreads();
            if (it + 1 < SEQ / 64) {
#pragma unroll
                for (int i = 0; i < 2; ++i) LRU_FILL((t0 + 64 + lrow[i]) & 127, lpc, rl[i]);
                *(LAS u32x4*)(lds + LRU_GG + ((it + 1) & 1) * 64 * LRU_GGP + grho * LRU_GGP + gpc * 16) = rg;
                if (it + 2 < SEQ / 64) {
#pragma unroll
                    for (int i = 0; i < 2; ++i) rl[i] = *(const u32x4*)(LIN + (rowbase + t0 + 128 + lrow[i]) * DM + 128 * n + 8 * lpc);
                    rg = *(const u32x4*)(GGb + (rowbase + t0 + 128 + grow) * DM + 128 * n + 64 * hh + 8 * gpc); } }
            f32x4 acc[4];
#pragma unroll
            for (int tb = 0; tb < 4; ++tb) { acc[tb] = (f32x4){0.f, 0.f, 0.f, 0.f};
#pragma unroll
                for (int ks = 0; ks < 4; ++ks) { const bf16x8 xf = *(const LAS bf16x8*)(lds + LRU_XC + (tb * 16 + j16) * LRU_XCP + (32 * ks + 8 * g4) * 2);
                    acc[tb] = __builtin_amdgcn_mfma_f32_16x16x32_bf16(wf[ks], xf, acc[tb], 0, 0, 0); } }
            float pr[4][2], pi[4][2];
#pragma unroll
            for (int tb = 0; tb < 4; ++tb)
#pragma unroll
                for (int q = 0; q < 2; ++q) {
                    const auto sw_ = __builtin_amdgcn_permlane16_swap(__float_as_uint(acc[tb][q]), __float_as_uint(acc[tb][2 + q]), false, false);
                    pr[tb][q] = __uint_as_float(sw_[0]); pi[tb][q] = __uint_as_float(sw_[1]); }
            const LAS unsigned char* ggp = lds + LRU_GG + (it & 1) * 64 * LRU_GGP;
            unsigned uo[4];
            f32x2 hq2[4];
            { const f32x2 ba2 = (f32x2){ba[0], ba[1]}, bx2 = (f32x2){bx[0], bx[1]}, nsp2 = (f32x2){-sp8[0], -sp8[1]};
              f32x2 a2v[4], bb2[4];
#pragma unroll
              for (int tb = 0; tb < 4; ++tb) {
                  const f32x2 zr = ((f32x2){pr[tb][0], pr[tb][1]} + ba2) * (-LOG2E), zi = ((f32x2){pi[tb][0], pi[tb][1]} + bx2) * (-LOG2E);
                  const f32x2 er = (f32x2){fast_exp2(zr.x), fast_exp2(zr.y)} + 1.0f, ei = (f32x2){fast_exp2(zi.x), fast_exp2(zi.y)} + 1.0f;
                  const f32x2 r = (f32x2){fast_rcp(er.x), fast_rcp(er.y)}, ig = (f32x2){fast_rcp(ei.x), fast_rcp(ei.y)};
                  const f32x2 la = nsp2 * r, lal = la * LOG2E, x2v = la + la;
                  const f32x2 av = (f32x2){fast_exp2(lal.x), fast_exp2(lal.y)}; a2v[tb] = av;
                  f32x2 pe = x2v * 0.0013888889f + 0.0083333338f; pe = pe * x2v + 0.041666668f; pe = pe * x2v + 0.16666667f; pe = pe * x2v + 0.5f; pe = pe * x2v + 1.0f;
                  f32x2 emv = -x2v * pe;
                  if (__builtin_amdgcn_ballot_w64(fminf(x2v.x, x2v.y) <= -0.25f) != 0ull) { const f32x2 dv = 1.0f - av * av;
                      emv.x = x2v.x > -0.25f ? emv.x : dv.x; emv.y = x2v.y > -0.25f ? emv.y : dv.y; }
                  const f32x2 coef = (f32x2){__builtin_amdgcn_sqrtf(emv.x), __builtin_amdgcn_sqrtf(emv.y)};
                  const unsigned xw = *(const LAS unsigned*)(lds + LRU_XC + (tb * 16 + j16) * LRU_XCP + (64 * hh + chl0) * 2);
                  bb2[tb] = coef * ig * (f32x2){bflo(xw), bfhi(xw)}; }
              f32x2 A = a2v[0], H = bb2[0];
#pragma unroll
              for (int tb = 1; tb < 4; ++tb) { H = __builtin_elementwise_fma(a2v[tb], H, bb2[tb]); A = A * a2v[tb]; }
#pragma unroll
              for (int sft = 1; sft < 16; sft <<= 1) { const f32x2 As = (f32x2){dpp_shr(A.x, 1.0f, sft), dpp_shr(A.y, 1.0f, sft)}, Hs = (f32x2){dpp_shr(H.x, 0.0f, sft), dpp_shr(H.y, 0.0f, sft)};
                  H = __builtin_elementwise_fma(A, Hs, H); A = A * As; }
              const f32x2 Aex = (f32x2){dpp_shr(A.x, 1.0f, 1), dpp_shr(A.y, 1.0f, 1)}, Hex = (f32x2){dpp_shr(H.x, 0.0f, 1), dpp_shr(H.y, 0.0f, 1)};
              f32x2 h = __builtin_elementwise_fma(Aex, (f32x2){hprev[0], hprev[1]}, Hex);
#pragma unroll
              for (int tb = 0; tb < 4; ++tb) { h = __builtin_elementwise_fma(a2v[tb], h, bb2[tb]); hq2[tb] = h; }
              hprev[0] = __shfl(h.x, (lane & 48) | 15); hprev[1] = __shfl(h.y, (lane & 48) | 15);
            }
#pragma unroll
            for (int tb = 0; tb < 4; ++tb) { const unsigned gw2 = *(const LAS unsigned*)(ggp + (tb * 16 + j16) * LRU_GGP + chl0 * 2);
                const f32x2 gv = (f32x2){bflo(gw2), bfhi(gw2)};
                const f32x2 uu = (gv + (gv * gv * gv) * 0.044715f) * (-2.0f * 0.7978845608028654f * LOG2E);
                const f32x2 den = (f32x2){fast_exp2(uu.x), fast_exp2(uu.y)} + 1.0f;
                const f32x2 outv = hq2[tb] * gv * (f32x2){fast_rcp(den.x), fast_rcp(den.y)};
                uo[tb] = cvt_pk_bf16(outv.x, outv.y);
                *(LAS unsigned*)(lds + LRU_UT + (tb * 16 + j16) * LRU_GGP + chl0 * 2) = uo[tb]; }
            __syncthreads();
            { const u32x4 v = *(const LAS u32x4*)(lds + LRU_UT + grho * LRU_GGP + gpc * 16);
              *(u32x4*)(U + (rowbase + t0 + grow) * DM + 128 * n + 64 * hh + 8 * gpc) = v; }
        }
        __syncthreads();
    }
}

constexpr int AT_SLOT = 32768, AT_V = 16384, AT_STG = 3 * AT_SLOT;
static_assert(AT_STG + 8 * 4096 <= RING_BYTES, "attention LDS map");
__device__ __forceinline__ void glds16(const void* gsrc, unsigned lds_dst) { unsigned keep;
    asm volatile("s_mov_b32 %0, m0\n\ts_mov_b32 m0, %2\n\ts_nop 0\n\tglobal_load_lds_dwordx4 %1, off\n\ts_mov_b32 m0, %0" : "=&s"(keep) : "v"(gsrc), "s"(lds_dst) : "memory"); }
__device__ __forceinline__ int crow(int r, int hi) { return (r & 3) + 8 * (r >> 2) + 4 * hi; }
typedef short v4i16_t __attribute__((ext_vector_type(4)));
__device__ __forceinline__ s16x4 vtr(const LAS unsigned char* p) { return __builtin_bit_cast(s16x4, __builtin_amdgcn_ds_read_tr16_b64_v4i16((LAS v4i16_t*)p)); }

template <int K> __device__ __forceinline__ float swz_xor(float v) { return __int_as_float(__builtin_amdgcn_ds_swizzle(__float_as_int(v), (K << 10) | 0x1f)); }
__device__ __forceinline__ float xor32_sum(float v) { auto rr = __builtin_amdgcn_permlane32_swap(__float_as_uint(v), __float_as_uint(v), false, false); return __uint_as_float(rr[0]) + __uint_as_float(rr[1]); }
template <int NMAP>
__device__ __forceinline__ void attn_unit(LAS unsigned char* ldsb, const bf16* Qw  , int pitchQ,
                                          const bf16* Kp, int pitchK, const bf16* Vp, int pitchV, int NT, int ntv,
                                          bf16* Ow, int pitchO, float cref, float lam, const float* subln, float oscale, const float* qgain = nullptr, float qscale = 1.0f) {
    int tid = threadIdx.x; asm volatile("" : "+v"(tid));
    const int lane = tid & 63, r32 = lane & 31, hi = lane >> 5; const int wid = __builtin_amdgcn_readfirstlane(tid >> 6);
    const unsigned lds0 = (unsigned)(size_t)ldsb;
    constexpr int NQR = (NMAP == 2) ? 4 : 8;
    bf16x8 qr[NQR];
#pragma unroll
    for (int j = 0; j < NQR; ++j) qr[j] = *(const bf16x8*)(Qw + (size_t)r32 * pitchQ + 16 * j + 8 * hi);
    if (NMAP == 1 && qgain) {
        float ss = 0.f;
#pragma unroll
        for (int j = 0; j < 8; ++j) { const u32x4 w = __builtin_bit_cast(u32x4, qr[j]);
            ss += bflo(w.x) * bflo(w.x) + bfhi(w.x) * bfhi(w.x) + bflo(w.y) * bflo(w.y) + bfhi(w.y) * bfhi(w.y) + bflo(w.z) * bflo(w.z) + bfhi(w.z) * bfhi(w.z) + bflo(w.w) * bflo(w.w) + bfhi(w.w) * bfhi(w.w); }
        ss = xor32_sum(ss);
        const float rs = rsqrtf(ss * (1.f / 128.f) + EPS) * qscale;
#pragma unroll
        for (int j = 0; j < 8; ++j) { const u32x4 w = __builtin_bit_cast(u32x4, qr[j]); const f32x4 g0 = *(const f32x4*)(qgain + 16 * j + 8 * hi), g1 = *(const f32x4*)(qgain + 16 * j + 8 * hi + 4);
            u32x4 o; o.x = cvt_pk_bf16(bflo(w.x) * rs * g0[0], bfhi(w.x) * rs * g0[1]); o.y = cvt_pk_bf16(bflo(w.y) * rs * g0[2], bfhi(w.y) * rs * g0[3]);
            o.z = cvt_pk_bf16(bflo(w.z) * rs * g1[0], bfhi(w.z) * rs * g1[1]); o.w = cvt_pk_bf16(bflo(w.w) * rs * g1[2], bfhi(w.w) * rs * g1[3]);
            qr[j] = __builtin_bit_cast(bf16x8, o); }
    }
    const LAS unsigned char* qpark = ldsb + AT_STG + wid * 4096 + lane * 16;
    if (NMAP == 2) {
#pragma unroll
        for (int j = 4; j < 8; ++j) { const bf16x8 t_ = *(const bf16x8*)(Qw + (size_t)r32 * pitchQ + 16 * j + 8 * hi); *(LAS bf16x8*)(ldsb + AT_STG + wid * 4096 + lane * 16 + (j - 4) * 1024) = t_; } }
    const bf16* ksrc = Kp + (size_t)lane * pitchK + wid * 8;
    const bf16* vsrc = Vp + (size_t)(16 * (wid & 3) + (lane >> 2)) * pitchV + (wid >> 2) * 32 + (lane & 3) * 8;
#define AT_DMA(t, slot) do { const unsigned _sb = lds0 + (unsigned)(slot) * AT_SLOT; \
        glds16(ksrc + (size_t)(t) * 64 * pitchK, (unsigned)__builtin_amdgcn_readfirstlane(_sb + wid * 1024)); \
        glds16(ksrc + (size_t)(t) * 64 * pitchK + 64, (unsigned)__builtin_amdgcn_readfirstlane(_sb + (wid + 8) * 1024)); \
        glds16(vsrc + (size_t)(t) * 64 * pitchV, (unsigned)__builtin_amdgcn_readfirstlane(_sb + AT_V + wid * 1024)); \
        glds16(vsrc + (size_t)(t) * 64 * pitchV + 64, (unsigned)__builtin_amdgcn_readfirstlane(_sb + AT_V + (wid + 8) * 1024)); } while (0)
    const LAS unsigned char* kp0 = ldsb + hi * 1024 + r32 * 16;
    const LAS unsigned char* vp0 = ldsb + AT_V + ((lane >> 4) & 1) * 32 + (lane & 3) * 8 + (4 * hi + ((lane & 15) >> 2)) * 64;
    f32x16 o[NMAP][4];
#pragma unroll
    for (int m = 0; m < NMAP; ++m)
#pragma unroll
        for (int d = 0; d < 4; ++d) o[m][d] = (f32x16){};
    float lsum[NMAP];
#pragma unroll
    for (int m = 0; m < NMAP; ++m) lsum[m] = 0.f;
    AT_DMA(0, 0);
    if (NT > 1) AT_DMA(1, 1);
    int slot = 0;
#pragma unroll 1
    for (int t = 0; t < NT; ++t) {
        if (t + 1 < NT) asm volatile("s_waitcnt vmcnt(4)" ::: "memory"); else asm volatile("s_waitcnt vmcnt(0)" ::: "memory");
        __builtin_amdgcn_s_barrier(); asm volatile("" ::: "memory");
        if (t + 2 < NT) { const int s2 = slot == 0 ? 2 : slot - 1; AT_DMA(t + 2, s2); }
        if (t < ntv) {
            const LAS unsigned char* kp = kp0 + slot * AT_SLOT; const LAS unsigned char* vp = vp0 + slot * AT_SLOT;
#define AT_SB() __builtin_amdgcn_sched_barrier(0)
#pragma unroll
            for (int m = 0; m < NMAP; ++m) {
                constexpr int JN = 8 / NMAP;
#pragma unroll
                for (int hk = 0; hk < 2; ++hk) {
                    f32x16 p = (f32x16){};
                    bf16x8 kb = *(const LAS bf16x8*)(kp + (m * JN) * 2048 + hk * 512);
                    AT_SB();
#pragma unroll
                    for (int jj = 0; jj < JN; ++jj) { const int j = m * JN + jj; bf16x8 nb = kb;
                        if (jj + 1 < JN) nb = *(const LAS bf16x8*)(kp + (j + 1) * 2048 + hk * 512);
                        const bf16x8 qf = (NMAP == 2 && m == 1) ? *(const LAS bf16x8*)(qpark + jj * 1024) : qr[(NMAP == 2 && m == 1) ? 0 : j];
                        p = __builtin_amdgcn_mfma_f32_32x32x16_bf16(kb, qf, p, 0, 0, 0);
                        AT_SB(); kb = nb; }
                    s16x4 lo = vtr(vp + (2 * hk) * 1024), hh = vtr(vp + (2 * hk) * 1024 + 512);
                    float s = 0.f;
#pragma unroll
                    for (int r = 0; r < 16; ++r) { p[r] = fast_exp2(p[r]); s += p[r]; }
                    lsum[m] += s;
                    u32x4 pw[2];
                    pw[0] = (u32x4){cvt_pk_bf16(p[0], p[1]), cvt_pk_bf16(p[2], p[3]), cvt_pk_bf16(p[4], p[5]), cvt_pk_bf16(p[6], p[7])};
                    pw[1] = (u32x4){cvt_pk_bf16(p[8], p[9]), cvt_pk_bf16(p[10], p[11]), cvt_pk_bf16(p[12], p[13]), cvt_pk_bf16(p[14], p[15])};
                    AT_SB();
#pragma unroll
                    for (int idx = 0; idx < 8; ++idx) { const int d0 = idx >> 1, ksl = idx & 1;
                        const bf16x8 vf = (bf16x8){lo[0], lo[1], lo[2], lo[3], hh[0], hh[1], hh[2], hh[3]};
                        if (idx + 1 < 8) { const int nd0 = (idx + 1) >> 1, nks = 2 * hk + ((idx + 1) & 1); lo = vtr(vp + (nd0 * 4 + nks) * 1024); hh = vtr(vp + (nd0 * 4 + nks) * 1024 + 512); }
                        o[m][d0] = __builtin_amdgcn_mfma_f32_32x32x16_bf16(__builtin_bit_cast(bf16x8, pw[ksl]), vf, o[m][d0], 0, 0, 0);
                        AT_SB(); }
                }
            }
#undef AT_SB
        }
        slot = slot == 2 ? 0 : slot + 1;
    }
#undef AT_DMA
    int hie = hi, r32e = r32, lanee = lane;
    asm volatile("" : "+v"(hie), "+v"(r32e), "+v"(lanee));
    float inv[NMAP];
#pragma unroll
    for (int m = 0; m < NMAP; ++m) { const float l = xor32_sum(lsum[m]); inv[m] = 1.0f / l; }
    float gsub[4];
#pragma unroll
    for (int d0 = 0; d0 < 4; ++d0) gsub[d0] = (NMAP == 2) ? subln[32 * d0 + r32e] * oscale : oscale;
    LAS bf16* stg = (LAS bf16*)(ldsb + AT_STG + wid * 4096);
#pragma unroll
    for (int half = 0; half < 2; ++half) {
#pragma unroll
        for (int rr = 0; rr < 8; ++rr) { const int r = half * 8 + rr; const int orow = crow(r, hie);
            const float i0 = __shfl(inv[0], orow); float val[4];
            if (NMAP == 2) { const float i1 = __shfl(inv[NMAP - 1], orow) * lam; float ss = 0.f;
#pragma unroll
                for (int d0 = 0; d0 < 4; ++d0) { val[d0] = o[0][d0][r] * i0 - o[NMAP - 1][d0][r] * i1; ss += val[d0] * val[d0]; }
                ss += swz_xor<1>(ss); ss += swz_xor<2>(ss); ss += swz_xor<4>(ss); ss += swz_xor<8>(ss); ss += swz_xor<16>(ss);
                const float rstd = rsqrtf(ss * (1.f / 128.f) + EPS);
#pragma unroll
                for (int d0 = 0; d0 < 4; ++d0) val[d0] *= rstd;
            } else {
#pragma unroll
                for (int d0 = 0; d0 < 4; ++d0) val[d0] = o[0][d0][r] * i0; }
#pragma unroll
            for (int d0 = 0; d0 < 4; ++d0) stg[(orow & 15) * 128 + d0 * 32 + r32e] = (bf16)(cvt_pk_bf16(val[d0] * gsub[d0], 0.f) & 0xffffu);
            __builtin_amdgcn_sched_barrier(0); }
        LDS_WAIT();
#pragma unroll
        for (int i = 0; i < 4; ++i) { const int id = i * 64 + lanee, row = id >> 4, ch = id & 15; const u32x4 v = *(const LAS u32x4*)(stg + row * 128 + ch * 8);
            *(u32x4*)(Ow + (size_t)(16 * half + row) * pitchO + ch * 8) = v; }
        LDS_WAIT();
    }
    asm volatile("s_waitcnt lgkmcnt(0)" ::: "memory"); __builtin_amdgcn_s_barrier(); asm volatile("" ::: "memory");
}

__device__ __forceinline__ float softmax_cref(const float* gq, const float* gk, int n, float dotscale, int lane) {
    float a = 0.f, b = 0.f;
    for (int d = lane; d < n; d += 64) { a = fmaxf(a, fabsf(gq[d])); b = fmaxf(b, fabsf(gk[d])); }
    a = wave_max(a); b = wave_max(b);
    return fmaxf(0.f, (float)n * dotscale * a * b * LOG2E - 100.f);
}

#ifndef PROBE_VAR
#define PROBE_VAR 0
#endif
constexpr int A2_KS = 16384, A2_V = 3 * 16384, A2_NV = 5;
static_assert(A2_V + A2_NV * 16384 <= RING_BYTES, "attention LDS map");
#define A2_SB() __builtin_amdgcn_sched_barrier(0)
#define A2_PV(S_, PWA) do { const int s_ = (S_); \
              const bf16x8 vf_ = (bf16x8){vl_[s_ & 1][0], vl_[s_ & 1][1], vl_[s_ & 1][2], vl_[s_ & 1][3], vh_[s_ & 1][0], vh_[s_ & 1][1], vh_[s_ & 1][2], vh_[s_ & 1][3]}; \
              if (s_ + 2 < 16) { const int pc_ = ((s_ + 2) & 3) * 4 + ((s_ + 2) >> 2); vl_[s_ & 1] = vtr(vp_ + pc_ * 1024); vh_[s_ & 1] = vtr(vp_ + pc_ * 1024 + 512); } \
              o[s_ & 3] = __builtin_amdgcn_mfma_f32_32x32x16_bf16(__builtin_bit_cast(bf16x8, PWA[s_ >> 2]), vf_, o[s_ & 3], 0, 0, 0); } while (0)
#define A2_ITER(t, PC0, PC1, PN0, PN1, PW, PWN) do { \
        if ((t) < NT) { \
            if ((t) + 1 < NT) asm volatile("s_waitcnt vmcnt(4)" ::: "memory"); else asm volatile("s_waitcnt vmcnt(0)" ::: "memory"); \
            __builtin_amdgcn_s_barrier(); asm volatile("" ::: "memory"); \
            if ((t) + 2 < NT) { A2_DMA((t) + 2, ((t) + 2) % 3, ((t) + 2) % A2_NV); } \
        } \
        const bool vis_ = (t) < ntv; \
        const LAS unsigned char* kp_ = ldsb + ((t) % 3) * A2_KS; \
        const LAS unsigned char* vp_ = vp0 + (((t) >= 2 ? (t) - 2 : 0) % A2_NV) * 16384; \
        PN0 = (f32x16){}; PN1 = (f32x16){}; \
        bf16x8 kq_[2]; s16x4 vl_[2], vh_[2]; \
        kq_[0] = *(const LAS bf16x8*)(kp_ + kad[0]); kq_[1] = *(const LAS bf16x8*)(kp_ + kad[0] + 8192); \
        _Pragma("unroll") for (int i_ = 0; i_ < 2; ++i_) { vl_[i_] = vtr(vp_ + (i_ * 4) * 1024); vh_[i_] = vtr(vp_ + (i_ * 4) * 1024 + 512); } \
        A2_SB(); \
        _Pragma("unroll") for (int i_ = 0; i_ < 8; ++i_) { \
            { const bf16x8 kf_ = kq_[i_ & 1]; \
              if (i_ + 2 < 8) kq_[i_ & 1] = *(const LAS bf16x8*)(kp_ + kad[(i_ + 2) >> 1] + ((i_ + 2) & 1) * 8192); \
              if (vis_) { if (i_ & 1) PN1 = __builtin_amdgcn_mfma_f32_32x32x16_bf16(kf_, qr[i_ >> 1], PN1, 0, 0, 0); else PN0 = __builtin_amdgcn_mfma_f32_32x32x16_bf16(kf_, qr[i_ >> 1], PN0, 0, 0, 0); } \
              if (i_ == 0) KEEP_AB(PN0, kf_, qr[0]); if (i_ == 1) KEEP_AB(PN1, kf_, qr[0]); } \
            A2_SB(); \
              \
            float e0_ = fast_exp2(PC0[2 * i_]), e1_ = fast_exp2(PC0[2 * i_ + 1]); \
            asm volatile("" : "+v"(e0_), "+v"(e1_)); \
            A2_SB(); \
            A2_PV(2 * i_, PW); \
            A2_SB(); \
            float e2_ = fast_exp2(PC1[2 * i_]), e3_ = fast_exp2(PC1[2 * i_ + 1]); \
            asm volatile("" : "+v"(e2_), "+v"(e3_)); \
            A2_SB(); \
            A2_PV(2 * i_ + 1, PW); \
            A2_SB(); \
            s0 += e0_ + e1_; s1 += e2_ + e3_; \
            PWN[i_ >> 2][i_ & 3] = cvt_pk_bf16(e0_, e1_); PWN[2 + (i_ >> 2)][i_ & 3] = cvt_pk_bf16(e2_, e3_); \
            A2_SB(); \
        } \
        if (!vis_) { _Pragma("unroll") for (int r_ = 0; r_ < 16; ++r_) { PN0[r_] = -INFINITY; PN1[r_] = -INFINITY; } } \
    } while (0)
template <int VAR>
__device__ __forceinline__ void attn2_unit(LAS unsigned char* ldsb, const bf16* Qw  , const bf16* Kp, const bf16* Vp,
                                           int NT, int ntv, bf16* Ow  , float lam, const float* subln) {
    int tid = threadIdx.x; asm volatile("" : "+v"(tid));
    const int lane = tid & 63, r32 = lane & 31, hi = lane >> 5; const int wid = __builtin_amdgcn_readfirstlane(tid >> 6); const int g = wid & 3, m = wid >> 2;
    const unsigned lds0 = (unsigned)(size_t)ldsb;
    bf16x8 qr[4];
#pragma unroll
    for (int j = 0; j < 4; ++j) qr[j] = *(const bf16x8*)(Qw + (size_t)r32 * DM + 16 * j + 8 * hi);
    asm volatile("s_waitcnt vmcnt(0)" : "+v"(qr[0]), "+v"(qr[1]), "+v"(qr[2]), "+v"(qr[3]) :: "memory");
    const int kkey = 4 * wid + (lane >> 4);
    const bf16* ksrc = Kp + (size_t)kkey * DM + (((lane & 15) ^ (kkey & 15)) << 3);
    const bf16* vsrc = Vp + (size_t)(16 * (wid & 3) + (lane >> 2)) * DM + (wid >> 2) * 32 + (lane & 3) * 8;
#define A2_DMA(t, ks, vs) do { const unsigned _kb = lds0 + (unsigned)(ks) * A2_KS, _vb = lds0 + A2_V + (unsigned)(vs) * 16384; \
        glds16(ksrc + (size_t)(t) * 64 * DM, (unsigned)__builtin_amdgcn_readfirstlane(_kb + wid * 1024)); \
        glds16(ksrc + (size_t)((t) * 64 + 32) * DM, (unsigned)__builtin_amdgcn_readfirstlane(_kb + (wid + 8) * 1024)); \
        glds16(vsrc + (size_t)(t) * 64 * DM, (unsigned)__builtin_amdgcn_readfirstlane(_vb + wid * 1024)); \
        glds16(vsrc + (size_t)(t) * 64 * DM + 64, (unsigned)__builtin_amdgcn_readfirstlane(_vb + (wid + 8) * 1024)); } while (0)
    unsigned kad[4];
#pragma unroll
    for (int jj = 0; jj < 4; ++jj) kad[jj] = (unsigned)(r32 * 256 + ((((8 * m + 2 * jj + hi) ^ (r32 & 15))) << 4));
    const LAS unsigned char* vp0 = ldsb + A2_V + ((lane >> 4) & 1) * 32 + (lane & 3) * 8 + (4 * hi + ((lane & 15) >> 2)) * 64;
    f32x16 o[4];
#pragma unroll
    for (int d = 0; d < 4; ++d) o[d] = (f32x16){};
    float s0 = 0.f, s1 = 0.f;
    u32x4 pwA[4], pwB[4];
#pragma unroll
    for (int i = 0; i < 4; ++i) { pwA[i] = (u32x4){0u, 0u, 0u, 0u}; pwB[i] = (u32x4){0u, 0u, 0u, 0u}; }
    f32x16 pA0, pA1, pB0, pB1;
#pragma unroll
    for (int r = 0; r < 16; ++r) { pA0[r] = -INFINITY; pA1[r] = -INFINITY; pB0[r] = -INFINITY; pB1[r] = -INFINITY; }
    A2_DMA(0, 0, 0);
    if (NT > 1) A2_DMA(1, 1, 1);
#pragma unroll 1
    for (int t = 0; t < NT + 2; t += 2) {
        A2_ITER(t,     pA0, pA1, pB0, pB1, pwA, pwB);
        A2_ITER(t + 1, pB0, pB1, pA0, pA1, pwB, pwA);
    }
#undef A2_DMA
    asm volatile("s_waitcnt lgkmcnt(0)" ::: "memory"); __builtin_amdgcn_s_barrier(); asm volatile("" ::: "memory");
    int tid2 = threadIdx.x; asm volatile("" : "+v"(tid2));
    const int lanee = tid2 & 63, r32e = lanee & 31, hie = lanee >> 5;
    const float inv = 1.0f / xor32_sum(s0 + s1);
    LAS float* exch = (LAS float*)(ldsb + g * 16384) + lanee;
    if (m == 1) {
#pragma unroll
        for (int r = 0; r < 16; ++r) { const float ir = __shfl(inv, crow(r, hie)) * lam;
#pragma unroll
            for (int d0 = 0; d0 < 4; ++d0) exch[(d0 * 16 + r) * 64] = o[d0][r] * ir; }
    }
    asm volatile("s_waitcnt lgkmcnt(0)" ::: "memory"); __builtin_amdgcn_s_barrier(); asm volatile("" ::: "memory");
    if (m == 0) {
        float gsub[4];
#pragma unroll
        for (int d0 = 0; d0 < 4; ++d0) gsub[d0] = subln[32 * d0 + r32e] * 0.8f;
        LAS bf16* stg = (LAS bf16*)(ldsb + 65536 + g * 4096);
#pragma unroll
        for (int half = 0; half < 2; ++half) {
#pragma unroll
            for (int rr = 0; rr < 8; ++rr) { const int r = half * 8 + rr; const int orow = crow(r, hie);
                const float i0 = __shfl(inv, orow); float val[4]; float ss = 0.f;
#pragma unroll
                for (int d0 = 0; d0 < 4; ++d0) { val[d0] = o[d0][r] * i0 - exch[(d0 * 16 + r) * 64]; ss += val[d0] * val[d0]; }
                ss += swz_xor<1>(ss); ss += swz_xor<2>(ss); ss += swz_xor<4>(ss); ss += swz_xor<8>(ss); ss += swz_xor<16>(ss);
                const float rstd = rsqrtf(ss * (1.f / 128.f) + EPS);
#pragma unroll
                for (int d0 = 0; d0 < 4; ++d0) stg[(orow & 15) * 128 + d0 * 32 + r32e] = (bf16)(cvt_pk_bf16(val[d0] * rstd * gsub[d0], 0.f) & 0xffffu);
                __builtin_amdgcn_sched_barrier(0); }
            LDS_WAIT();
#pragma unroll
            for (int i = 0; i < 4; ++i) { const int id = i * 64 + lanee, row = id >> 4, ch = id & 15; const u32x4 v = *(const LAS u32x4*)(stg + row * 128 + ch * 8);
                *(u32x4*)(Ow + (size_t)(16 * half + row) * DM + ch * 8) = v; }
            LDS_WAIT();
        }
    }
    asm volatile("s_waitcnt lgkmcnt(0)" ::: "memory"); __builtin_amdgcn_s_barrier(); asm volatile("" ::: "memory");
}
__device__ __forceinline__ void diffattn_phase(const Args& args, LAS unsigned char* lds, int vcu, int G, bf16* Oreal, bf16* Odmy, int nrep) {
    unsigned char* ws = args.ws;
    const int lane = threadIdx.x & 63, wid = __builtin_amdgcn_readfirstlane(threadIdx.x >> 6), g = wid & 3, m = wid >> 2;
    const bf16* Q = (const bf16*)(ws + WS_Q); const bf16* Kb = (const bf16*)(ws + WS_K); const bf16* Vb = (const bf16*)(ws + WS_V);
    float lam;
    { const float a = ((const float*)args.in[I_LQ1])[lane] * ((const float*)args.in[I_LK1])[lane], b = ((const float*)args.in[I_LQ2])[lane] * ((const float*)args.in[I_LK2])[lane];
      lam = expf(wave_sum(a)) - expf(wave_sum(b)) + 0.2f; lam = __uint_as_float(__builtin_amdgcn_readfirstlane(__float_as_uint(lam))); }
    for (int pp = vcu; pp < nrep * NB * 8 * 16; pp += G) {
        const int p = pp & 2047; bf16* O = (pp >> 11) ? Odmy : Oreal;
        const int bh = p >> 4, s = p & 15, b = bh >> 3, h = bh & 7;
#pragma unroll 1
        for (int half = 0; half < 2; ++half) {
            const int qb = half ? 31 - s : s;
            const size_t row0 = (size_t)b * SEQ + 128 * qb + 32 * g;
            if ((pp >> 11) == 0)
            attn2_unit<0>(lds, Q + row0 * DM + h * 128 + m * 64, Kb + (size_t)b * SEQ * DM + h * 128, Vb + (size_t)b * SEQ * DM + h * 128,
                       2 * qb + 2, 2 * qb + (g >> 1) + 1, O + row0 * DM + h * 128, lam, (const float*)args.in[I_SUBLN]);
#if PROBE_VAR
            else
            attn2_unit<PROBE_VAR>(lds, Q + row0 * DM + h * 128 + m * 64, Kb + (size_t)b * SEQ * DM + h * 128, Vb + (size_t)b * SEQ * DM + h * 128,
                       2 * qb + 2, 2 * qb + (g >> 1) + 1, O + row0 * DM + h * 128, lam, (const float*)args.in[I_SUBLN]);
#endif
        }
    }
}
__device__ __forceinline__ void crossattn_phase(const Args& args, LAS unsigned char* lds, int vcu, int G) {
    unsigned char* ws = args.ws;
    const int lane = threadIdx.x & 63, wid = __builtin_amdgcn_readfirstlane(threadIdx.x >> 6);
    const bf16* QC = (const bf16*)(ws + WS_QC); const bf16* KV = (const bf16*)(ws + WS_KVC); bf16* OC = (bf16*)(ws + WS_OC);
    const float cref = softmax_cref((const float*)args.in[I_CQ_NORM], (const float*)args.in[I_CK_NORM], 128, 0.08838834764831845f, lane);
#pragma unroll 1
    for (int p = vcu; p < NB * 4 * 16; p += G) {
        const int b = p >> 6, h = (p >> 4) & 3, qb = p & 15;
        const size_t row0 = (size_t)b * SEQ + 256 * qb + 32 * wid;
        attn_unit<1>(lds, QC + row0 * 512 + h * 128, 512, KV + (size_t)b * MEMTOK * DM + h * 128, DM, KV + (size_t)b * MEMTOK * DM + 512 + h * 128, DM,
                     4, 4, OC + row0 * 512 + h * 128, 512, cref, 0.f, nullptr, 1.0f, (const float*)args.in[I_CQ_NORM], 0.08838834764831845f * LOG2E);
    }
}

template <class Sched>
__device__ __forceinline__ void router_select(const Args& args, LAS unsigned char* lds, const Sched& S) {
    unsigned char* ws = args.ws;
    const int tid = threadIdx.x;
    LAS int* cnt_l = (LAS int*)lds; LAS int* base_l = cnt_l + 64;
    const float* logit = (const float*)(ws + WS_LOGIT); const float* rss = (const float*)(ws + WS_RSS2);
    float* rstd2 = (float*)(ws + WS_RSTD2); float* wts = (float*)(ws + WS_WTS); int* idx = (int*)(ws + WS_IDX); int* asg = (int*)(ws + WS_ASG); unsigned* gcnt = (unsigned*)(ws + WS_CTL) + CW_CNT;
    const float* bg = (const float*)args.in[I_B_GROUP]; const float* br = (const float*)args.in[I_B_ROUTER];
    VM_WAIT(); __syncthreads();
    __builtin_amdgcn_fence(__ATOMIC_ACQUIRE, "agent"); VM_WAIT();
    pg8::Unit u;
    for (int i = 0; S.next(i, u); ++i) {
        if (tid < 64) cnt_l[tid] = 0;
        __syncthreads();
        int row = 0, b0 = 0, b1 = 0, rk0 = 0, rk1 = 0; float w0 = 0.f, w1 = 0.f;
        if (tid < 256) {
            row = u.pm * 256 + tid;
            const f32x4* p = (const f32x4*)(rss + (size_t)row * 16); const f32x4 s0 = p[0], s1 = p[1], s2 = p[2], s3 = p[3];
            const float ss = ((s0[0] + s0[1]) + (s0[2] + s0[3])) + ((s1[0] + s1[1]) + (s1[2] + s1[3])) + ((s2[0] + s2[1]) + (s2[2] + s2[3])) + ((s3[0] + s3[1]) + (s3[2] + s3[3]));
            const float rstd = rsqrtf(ss * (1.0f / DM) + EPS); rstd2[row] = rstd;
            { const f32x4* q = (const f32x4*)((const float*)(ws + WS_RSS1) + (size_t)row * 16); const f32x4 m0 = q[0], m1 = q[1], m2 = q[2], m3 = q[3];
              const float mx = fmaxf(fmaxf(fmaxf(fmaxf(m0[0], m0[1]), fmaxf(m0[2], m0[3])), fmaxf(fmaxf(m1[0], m1[1]), fmaxf(m1[2], m1[3]))), fmaxf(fmaxf(fmaxf(m2[0], m2[1]), fmaxf(m2[2], m2[3])), fmaxf(fmaxf(m3[0], m3[1]), fmaxf(m3[2], m3[3]))));
              const float sc = mx > 0.f ? mx * (1.0f / 127.0f) : 1.0f; ((float*)(ws + WS_XS2))[row] = sc; ((LAS float*)(lds + 1024))[tid] = 1.0f / sc; }
            const f32x4* lp = (const f32x4*)(logit + (size_t)row * 64);
            const f32x4 gl4 = lp[0];
            float gl[4]; int gi = 0;
#pragma unroll
            for (int j = 0; j < 4; ++j) gl[j] = gl4[j] * rstd + bg[j];
            float gm = gl[0];
#pragma unroll
            for (int j = 1; j < 4; ++j) if (gl[j] > gm) { gm = gl[j]; gi = j; }
            float den = 0.f;
#pragma unroll
            for (int j = 0; j < 4; ++j) den += expf(gl[j] - gm);
            const float gval = 1.0f / den;
            const f32x4 e0 = lp[1 + 2 * gi], e1 = lp[2 + 2 * gi];
            float el[8];
#pragma unroll
            for (int j = 0; j < 4; ++j) { el[j] = e0[j] * rstd + br[gi * 8 + j]; el[4 + j] = e1[j] * rstd + br[gi * 8 + 4 + j]; }
            int i0 = 0; float v0 = el[0];
#pragma unroll
            for (int j = 1; j < 8; ++j) if (el[j] > v0) { v0 = el[j]; i0 = j; }
            int i1 = -1; float v1 = -INFINITY;
#pragma unroll
            for (int j = 0; j < 8; ++j) if (j != i0 && el[j] > v1) { v1 = el[j]; i1 = j; }
            const float ex = expf(v1 - v0); w0 = gval / (1.0f + ex); w1 = gval * ex / (1.0f + ex);
            b0 = gi * 8 + i0; b1 = 32 + gi * 8 + i1;
            rk0 = atomicAdd((int*)&cnt_l[b0], 1); rk1 = atomicAdd((int*)&cnt_l[b1], 1);
        }
        __syncthreads();
        if (tid < 64) base_l[tid] = (int)__hip_atomic_fetch_add(gcnt + tid, (unsigned)cnt_l[tid], __ATOMIC_RELAXED, __HIP_MEMORY_SCOPE_AGENT);
        __syncthreads();
        {
          const bf16* xb = (const bf16*)(ws + WS_X2B) + (size_t)u.pm * 256 * DM; unsigned char* xq = ws + WS_X2Q + (size_t)u.pm * 256 * DM; const LAS float* invs = (const LAS float*)(lds + 1024);
          for (int p = tid; p < 256 * 64; p += NWAVES * 64) { const int r = p >> 6, c = (p & 63) * 16; const float inv = invs[r];
              const u32x4 a = *(const u32x4*)(xb + (size_t)r * DM + c), b = *(const u32x4*)(xb + (size_t)r * DM + c + 8);
              u32x4 o; o.x = pack_i8x4(bflo(a.x) * inv, bfhi(a.x) * inv, bflo(a.y) * inv, bfhi(a.y) * inv); o.y = pack_i8x4(bflo(a.z) * inv, bfhi(a.z) * inv, bflo(a.w) * inv, bfhi(a.w) * inv);
              o.z = pack_i8x4(bflo(b.x) * inv, bfhi(b.x) * inv, bflo(b.y) * inv, bfhi(b.y) * inv); o.w = pack_i8x4(bflo(b.z) * inv, bfhi(b.z) * inv, bflo(b.w) * inv, bfhi(b.w) * inv);
              *(u32x4*)(xq + (size_t)r * DM + c) = o; } }
        if (tid < 256) { idx[(size_t)b0 * MTOK + base_l[b0] + rk0] = row; idx[(size_t)b1 * MTOK + base_l[b1] + rk1] = row; wts[(size_t)row * 2] = w0; wts[(size_t)row * 2 + 1] = w1;
            asg[(size_t)row * 2] = (b0 << 20) | (base_l[b0] + rk0); asg[(size_t)row * 2 + 1] = (b1 << 20) | (base_l[b1] + rk1); }
        __syncthreads();
    }
}
__device__ __forceinline__ void moe_tables(const Args& args, LAS int* pblk, LAS int* cntl) {
    const unsigned* gcnt = (const unsigned*)(args.ws + WS_CTL) + CW_CNT;
    if (threadIdx.x < 64) cntl[threadIdx.x] = (int)__hip_atomic_load(gcnt + threadIdx.x, __ATOMIC_RELAXED, __HIP_MEMORY_SCOPE_AGENT);
    __syncthreads();
    if (threadIdx.x == 0) { int acc = 0; for (int j = 0; j < 64; ++j) { pblk[j] = acc; acc += (cntl[j] + 255) >> 8; } pblk[64] = acc;
        LAS int* cst = cntl + 64; int a2 = 0; for (int j = 0; j < 64; ++j) { if (j == 32) a2 = 0; cst[j] = a2; a2 += cntl[j]; } }
    __syncthreads();
}

__device__ __forceinline__ void moe_combine_phase(const Args& args, const LAS int* cst, int gw, int NGW, int lane) {
    unsigned char* ws = args.ws;
    const bf16* x2b = (const bf16*)(ws + WS_X2B); const bf16* y0 = (const bf16*)(ws + WS_S0); const bf16* y1 = (const bf16*)(ws + WS_S4);
    const float* wts = (const float*)(ws + WS_WTS); const int* asg = (const int*)(ws + WS_ASG);
    int2 an[2]; float2 wn[2];
#pragma unroll
    for (int t = 0; t < 2; ++t) { const int tk = gw + t * NGW; const bool ok = tk < MTOK; an[t] = ok ? *(const int2*)(asg + (size_t)tk * 2) : make_int2(0, 0); wn[t] = ok ? *(const float2*)(wts + (size_t)tk * 2) : make_float2(0.f, 0.f); }
    for (int tok = gw; tok < MTOK; tok += 2 * NGW) {
        int2 ac[2]; float2 wc2[2];
#pragma unroll
        for (int t = 0; t < 2; ++t) { ac[t] = an[t]; wc2[t] = wn[t]; }
#pragma unroll
        for (int t = 0; t < 2; ++t) { const int tk = tok + (2 + t) * NGW; const bool ok = tk < MTOK; an[t] = ok ? *(const int2*)(asg + (size_t)tk * 2) : make_int2(0, 0); wn[t] = ok ? *(const float2*)(wts + (size_t)tk * 2) : make_float2(0.f, 0.f); }
        u32x2 xv[2][4], p[2][4], q[2][4];
#pragma unroll
        for (int t = 0; t < 2; ++t) { const int tk = tok + t * NGW; if (tk < MTOK) {
            const size_t r0 = (size_t)(cst[ac[t].x >> 20] + (ac[t].x & 0xfffff)), r1 = (size_t)(cst[ac[t].y >> 20] + (ac[t].y & 0xfffff));
#pragma unroll
            for (int k = 0; k < 4; ++k) { const int c = 4 * lane + 256 * k;
                xv[t][k] = *(const u32x2*)(x2b + (size_t)tk * DM + c); p[t][k] = *(const u32x2*)(y0 + r0 * DM + c); q[t][k] = *(const u32x2*)(y1 + r1 * DM + c); } } }
#pragma unroll
        for (int t = 0; t < 2; ++t) { const int tk = tok + t * NGW; if (tk < MTOK) { const float w0 = wc2[t].x, w1 = wc2[t].y;
#pragma unroll
            for (int k = 0; k < 4; ++k) { const int c = 4 * lane + 256 * k; const u32x2 X = xv[t][k], P = p[t][k], Q = q[t][k]; f32x4 o;
                o[0] = bflo(X.x) + w0 * bflo(P.x) + w1 * bflo(Q.x); o[1] = bfhi(X.x) + w0 * bfhi(P.x) + w1 * bfhi(Q.x); o[2] = bflo(X.y) + w0 * bflo(P.y) + w1 * bflo(Q.y); o[3] = bfhi(X.y) + w0 * bfhi(P.y) + w1 * bfhi(Q.y);
                __builtin_nontemporal_store(o, (f32x4*)(args.out + (size_t)tk * DM + c)); } } }
    }
}

constexpr int N_PHASES = 17;
__global__ void __launch_bounds__(NWAVES * 64, 2) fwd_kernel(Args args) {
    extern __shared__ __attribute__((aligned(16))) unsigned char lds_raw[];
    LAS unsigned char* lds = (LAS unsigned char*)lds_raw;
    volatile LAS unsigned* MISC = (volatile LAS unsigned*)(lds + MISC_OFF);
    const int tid = threadIdx.x, lane = tid & 63, wave = __builtin_amdgcn_readfirstlane(tid >> 6);
    const int G = gridDim.x; const int bx = blockIdx.x; const int vcu = (G % 8 == 0) ? (bx % 8) * (G / 8) + bx / 8 : bx;
    const int gw = vcu * NWAVES + wave, NGW = G * NWAVES;
    unsigned char* ws = args.ws;
    for (int u = tid; u < (LDS_BYTES - MISC_OFF) / 4; u += NWAVES * 64) MISC[u] = 0u;
    __syncthreads();
    const int lo = args.ph_lo, hi = args.ph_hi;
    XcdBarrier bar; bar.bar = (unsigned*)(ws + WS_CTL) + CW_BAR + args.li * XCD_BAR_WORDS; bar.x = 0; bar.st = nullptr;
    bar = xcd_barrier_post((unsigned*)(ws + WS_CTL) + CW_BAR + args.li * XCD_BAR_WORDS, MISC);
    LAS int* pblk = (LAS int*)(lds + MISC_OFF + 64); LAS int* cntl = pblk + 72;
#ifndef PH_MASK
#define PH_MASK 0x1ffff
#endif
#define IN(k) (((PH_MASK >> (k)) & 1) && lo <= (k) && (k) < hi)
#define SEAM(k) do { if (IN(k) && IN((k) + 1)) xcd_barrier(bar); } while (0)
    using namespace pg8;

#ifndef PROBE_DUP
#define PROBE_DUP 0
#endif
#define REPS(k) (1 + ((PROBE_DUP >> (k)) & 1))
    unsigned char* const dmyA = ws + WS_QC;
    if (IN(0)) { _Pragma("unroll") for (int rep = 0; rep < REPS(0); ++rep) prologue_phase(args, lds, vcu, G, wave, lane);
        xcd_barrier(bar);
        if (G >= 128 && bx < 64) {
            DenseOrder S; S.init(ws + WS_MEMN, ws + WS_WCKV, MEMROWS, DM, DM, 64, bx);
            EpiAct E{(bf16*)(ws + WS_KVC), 0, 0, DM, nullptr, nullptr};
            gemm_phase<EpiAct, DenseOrder, true, false>(lds, DM, S, E);
        } else {
          const bool split = G >= 128; const int qw = split ? bx - 64 : bx, QW = split ? G - 64 : G;
          LAS float* red = (LAS float*)lds; LAS float* gain_l = (LAS float*)(lds + 4096);
          for (int k = tid; k < DM; k += NWAVES * 64) gain_l[k] = ((const float*)args.in[I_NORM_FFN])[k];
          __syncthreads();
          for (int it = qw; it < NWIN / 32 + NEXP * 32; it += QW) {
              if (it < NWIN / 32) colquant_wg_item((const float*)args.in[I_W_IN], NWIN, 32 * it, win_dest(32 * it), nullptr, ws + WS_WIN, (float*)(ws + WS_WSC), red, tid);
              else { const int r = it - NWIN / 32, e = r >> 5, nb = r & 31;
                  colquant_wg_item((const float*)args.in[I_W_GATE_UP] + (size_t)e * DM * 1024, 1024, 32 * nb, gu_dest(32 * nb), gain_l, ws + WS_WGU + (size_t)e * 1024 * DM, (float*)(ws + WS_WSC2) + e * 1024, red, tid); } }
          if (!split) { DenseOrder S; S.init(ws + WS_MEMN, ws + WS_WCKV, MEMROWS, DM, DM, G, bx);
            EpiAct E{(bf16*)(ws + WS_KVC), 0, 0, DM, nullptr, nullptr};
            gemm_phase<EpiAct, DenseOrder, true, false>(lds, DM, S, E); }
        }
        SEAM(0); }

    if (IN(1)) {
        _Pragma("unroll") for (int rep = 0; rep < REPS(1); ++rep)
        { DenseOrder S; S.init(ws + WS_XN, ws + WS_WIN, MTOK, 2048, DM / 2, G, bx);
          EpiAct E{(bf16*)(ws + WS_LIN), SLOT_ELEMS, 0, DM, (const float*)(ws + WS_XS), (const float*)(ws + WS_WSC)};
          gemm_phase<EpiAct, DenseOrder, true, false, true>(lds, DM / 2, S, E); }
        SEAM(1);
#ifdef PROBE_BARRIERS
        for (int q_ = 0; q_ < 8; ++q_) xcd_barrier(bar);
#endif
    }
    if (IN(2)) {
        headnorm128_phase((const bf16*)(ws + WS_KVC), (bf16*)(ws + WS_KVC), DM, MEMROWS, (const float*)args.in[I_CK_NORM], 1.0f, gw, NGW, lane);
        _Pragma("unroll") for (int rep = 0; rep < REPS(2); ++rep) lru_phase(args, lds, vcu, G);
        SEAM(2);
    }
    if (IN(3)) {
        _Pragma("unroll") for (int rep = 0; rep < REPS(3); ++rep) {
        DenseOrder S; S.init(ws + WS_XN, ws + WS_WIN + (size_t)2048 * DM, MTOK, 5120, DM / 2, G, bx);
        EpiQKV E{(bf16*)(ws + WS_Q), SLOT_ELEMS, (const float*)(ws + WS_XS), (const float*)(ws + WS_WSC) + 2048, (const float*)args.in[I_Q_NORM], (const float*)args.in[I_K_NORM], (const float*)(ws + WS_ROPE), 0.125f * LOG2E, ws + WS_SG8};
        gemm_phase<EpiQKV, DenseOrder, true, false, true>(lds, DM / 2, S, E); }
        if (IN(3) && IN(5)) xcd_barrier(bar);
    }
    if (IN(5)) { diffattn_phase(args, lds, vcu, G, (bf16*)(ws + WS_Q), (bf16*)dmyA, REPS(5)); SEAM(5); }
    if (IN(7)) {
        _Pragma("unroll") for (int rep = 0; rep < REPS(7); ++rep) {
        PairOrder S; S.nM = MTOK / 256; S.nN = DM / 256; S.ntile = S.nM * S.nN; S.G = G; S.c = bx; S.tstep = (size_t)256 * DM * 2;
        S.A0 = (const char*)(ws + WS_U); S.B0 = (const char*)(ws + WS_WLRUO); S.A1 = (const char*)(ws + WS_Q); S.B1 = (const char*)(ws + WS_WATTNO);
        EpiMix E{ws + WS_SG8, ws + WS_SG8 + (size_t)MTOK * DM, (bf16*)(ws + WS_MIX)};
        gemm_phase<EpiMix, PairOrder, true, false, false, true>(lds, DM, S, E); }
        SEAM(7);
    }
    if (IN(8)) {
        _Pragma("unroll") for (int rep = 0; rep < REPS(8); ++rep) {
        DenseOrder S; S.init(ws + WS_MIX, ws + WS_WOUT, MTOK, DM, DM, G, bx);
        EpiResid<true> E{args.in[I_X], (bf16*)(ws + WS_X1B), (float*)(ws + WS_RSS1), nullptr};
        gemm_phase<EpiResid<true>, DenseOrder, true, false>(lds, DM, S, E); }
        SEAM(8);
    }
    if (IN(9)) {
        _Pragma("unroll") for (int rep = 0; rep < REPS(9); ++rep) {
        DenseOrder S; S.init(ws + WS_X1B, ws + WS_WCQ, MTOK, 512, DM, G, bx);
        EpiRowScale E{(bf16*)(ws + WS_QC), 512, (const float*)(ws + WS_RSS1)};
        gemm_phase<EpiRowScale, DenseOrder, true, false>(lds, DM, S, E); }
        if (IN(9) && IN(11)) xcd_barrier(bar);
    }
    if (IN(11)) { _Pragma("unroll") for (int rep = 0; rep < REPS(11); ++rep) crossattn_phase(args, lds, vcu, G); SEAM(11); }
    if (IN(12)) {
        _Pragma("unroll") for (int rep = 0; rep < REPS(12); ++rep) {
        DenseOrder S; S.init(ws + WS_OC, ws + WS_WCO, MTOK, DM, 512, G, bx);
        EpiResid<false> E{ws + WS_X1B, (bf16*)(ws + WS_X2B), (float*)(ws + WS_RSS2), (float*)(ws + WS_RSS1)};
        gemm_phase<EpiResid<false>, DenseOrder, true, false>(lds, 512, S, E); }
        SEAM(12);
    }
    if (IN(13)) {
        DenseOrder S; S.init(ws + WS_X2B, ws + WS_WRT, MTOK, 256, DM, G, bx);
        EpiLogit E{(float*)(ws + WS_LOGIT)};
        gemm_phase<EpiLogit, DenseOrder, true, false>(lds, DM, S, E);
        router_select(args, lds, S);
        SEAM(13);
    }
    if (IN(14)) {
        moe_tables(args, pblk, cntl);
        _Pragma("unroll") for (int rep = 0; rep < REPS(14); ++rep) {
        MoeOrder S{pblk, cntl, 0, 0, G, bx, DM / 2, 1, (const char*)(ws + WS_X2Q), (const char*)(ws + WS_WGU), (size_t)1024 * DM, (const int*)(ws + WS_IDX), 0};
        S.rb_hi = pblk[64];
        EpiGateUp E{(bf16*)(ws + WS_H), (const float*)(ws + WS_RSTD2), (const float*)(ws + WS_XS2), (const float*)(ws + WS_WSC2)};
        gemm_phase<EpiGateUp, MoeOrder, true, true, true>(lds, DM / 2, S, E); }
        SEAM(14);
    }
    if (IN(15)) {
        moe_tables(args, pblk, cntl);
        _Pragma("unroll") for (int rep = 0; rep < REPS(15); ++rep) {
        MoeOrder S{pblk, cntl, 0, 0, G, bx, EFF, 0, (const char*)(ws + WS_H), (const char*)(ws + WS_WDN), (size_t)DM * EFF * 2, (const int*)(ws + WS_IDX), 0};
        S.rb_lo = pblk[0]; S.rb_hi = pblk[64];
        EpiY E{(bf16*)(ws + WS_S0), (bf16*)(ws + WS_S4)};
        gemm_phase<EpiY, MoeOrder, true, false>(lds, EFF, S, E); }
        SEAM(15);
    }
    if (IN(16)) {
        moe_tables(args, pblk, cntl);
        _Pragma("unroll") for (int rep = 0; rep < REPS(16); ++rep) moe_combine_phase(args, cntl + 64, gw, NGW, lane);
    }
#undef REPS
#undef IN
#undef SEAM
}

#ifndef MK_CUTS
#define MK_CUTS 1
#endif
extern "C" void kernel_launch(void* const* d_in, const int* in_sizes, int n_in, void* d_out, int out_size, void* d_ws, size_t ws_size, hipStream_t stream) {
    static int grid = 0;
    if (grid == 0) {
        if (n_in != 36 || out_size != MTOK * DM || ws_size < WS_END) { fprintf(stderr, "kernel_launch: unexpected shapes / workspace (n_in %d out %d ws %zu, need %zu)\n", n_in, out_size, ws_size, (size_t)WS_END); grid = -1; return; }
        int dev = 0, cus = 0, per_cu = 0;
        if (hipGetDevice(&dev) != hipSuccess || hipDeviceGetAttribute(&cus, hipDeviceAttributeMultiprocessorCount, dev) != hipSuccess) { grid = -1; return; }
        if (hipFuncSetAttribute((const void*)fwd_kernel, hipFuncAttributeMaxDynamicSharedMemorySize, LDS_BYTES) != hipSuccess) { fprintf(stderr, "kernel_launch: hipFuncSetAttribute failed\n"); grid = -1; return; }
        if (hipOccupancyMaxActiveBlocksPerMultiprocessor(&per_cu, (const void*)fwd_kernel, NWAVES * 64, LDS_BYTES) != hipSuccess || per_cu < 1) { fprintf(stderr, "kernel_launch: occupancy query says %d blocks per CU\n", per_cu); }
        (void)hipGetLastError();
        grid = cus;
    }
    if (grid < 0) return;
    (void)hipMemsetAsync((char*)d_ws + WS_CTL, 0, CTL_ZERO_BYTES, stream);
    Args a{};
    for (int i = 0; i < 36; ++i) a.in[i] = d_in[i];
    a.out = (float*)d_out; a.ws = (unsigned char*)d_ws;
    constexpr int NL = MK_CUTS;
    for (int li = 0; li < NL; ++li) {
        a.ph_lo = (li * N_PHASES) / NL; a.ph_hi = ((li + 1) * N_PHASES) / NL; a.li = li;
        hipLaunchKernelGGL(fwd_kernel, dim3(grid), dim3(NWAVES * 64), LDS_BYTES, stream, a);
    }
}
```

```cpp
#include <hip/hip_runtime.h>
#include <cstdio>
#include <cstdint>
#include <cmath>

#define GAS __attribute__((address_space(1)))
#define LAS __attribute__((address_space(3)))
typedef unsigned short bf16;
typedef short bf16x8 __attribute__((ext_vector_type(8)));
typedef short s16x4 __attribute__((ext_vector_type(4)));
typedef float f32x2 __attribute__((ext_vector_type(2)));
typedef float f32x4 __attribute__((ext_vector_type(4)));
typedef float f32x16 __attribute__((ext_vector_type(16)));
typedef unsigned u32x2 __attribute__((ext_vector_type(2)));
typedef unsigned u32x4 __attribute__((ext_vector_type(4)));

constexpr int NB = 16, SEQ = 4096, DM = 1024, MTOK = NB * SEQ;
constexpr int NWIN = 7168;
constexpr int MEMTOK = 256, MEMROWS = NB * MEMTOK;
constexpr int NEXP = 32, EFF = 512;
constexpr float EPS = 1e-6f;
constexpr float LOG2E = 1.4426950408889634f;
constexpr int NWAVES = 8;

constexpr size_t MiB = 1u << 20;
constexpr size_t WS_CTL = 0, CTL_ZERO_BYTES = 1 * MiB;
constexpr size_t WS_WIN = 2 * MiB;
constexpr size_t WS_WLRUO = 16 * MiB, WS_WATTNO = 18 * MiB, WS_WOUT = 20 * MiB;
constexpr size_t WS_WCQ = 22 * MiB;
constexpr size_t WS_WCKV = 23 * MiB;
constexpr size_t WS_WCO = 25 * MiB;
constexpr size_t WS_WRT = 26 * MiB;
constexpr size_t WS_WLRU = 26 * MiB + 512 * 1024;
constexpr size_t WS_WGU = 27 * MiB;
constexpr size_t WS_WDN = 91 * MiB;
constexpr size_t WS_S0 = 128 * MiB, WS_S1 = 256 * MiB, WS_S2 = 384 * MiB, WS_S3 = 512 * MiB, WS_S4 = 640 * MiB;
constexpr size_t WS_MEMN = 768 * MiB;
constexpr size_t WS_KVC = 776 * MiB;
constexpr size_t WS_QC = 784 * MiB;
constexpr size_t WS_OC = 848 * MiB;
constexpr size_t WS_IDX = 912 * MiB;
constexpr size_t WS_WTS = 928 * MiB;
constexpr size_t WS_RSS1 = 929 * MiB;
constexpr size_t WS_RSS2 = 933 * MiB;
constexpr size_t WS_RSTD2 = 937 * MiB;
constexpr size_t WS_XS = 937 * MiB + 256 * 1024;
constexpr size_t WS_WSC = 937 * MiB + 512 * 1024;
constexpr size_t WS_LOGIT = 938 * MiB;
constexpr size_t WS_ROPE = 954 * MiB;
constexpr size_t WS_XS2 = 958 * MiB + 512 * 1024;
constexpr size_t WS_WSC2 = 958 * MiB + 768 * 1024;
constexpr size_t WS_ASG = 958 * MiB;
constexpr size_t WS_END = 959 * MiB;
constexpr size_t WS_XN = WS_S0, WS_MIX = WS_S0, WS_LIN = WS_S1, WS_Q = WS_S1, WS_X2B = WS_S1, WS_GG = WS_S2, WS_K = WS_S2, WS_SGL = WS_S2,
                 WS_H = WS_S2, WS_V = WS_S3, WS_SGA = WS_S3, WS_U = WS_S4, WS_X1B = WS_S4;
constexpr size_t WS_X2Q = WS_S0;
constexpr size_t WS_SG8 = WS_QC;
constexpr size_t SLOT_ELEMS = (WS_S2 - WS_S1) / 2;
constexpr int CW_CNT = 1024;
constexpr int CW_WMAX2 = 139264;
constexpr int CW_WMAX = 131072;
constexpr int CW_BAR = 4096;
constexpr int MAX_LAUNCHES = 24;

constexpr int RING_BYTES = 131072;
constexpr int MISC_OFF = RING_BYTES;
constexpr int LDS_BYTES = 147456;

__device__ __forceinline__ unsigned cvt_pk_bf16(float lo, float hi) { unsigned r; asm volatile("v_cvt_pk_bf16_f32 %0, %1, %2" : "=v"(r) : "v"(lo), "v"(hi)); return r; }
__device__ __forceinline__ float bflo(unsigned w) { return __uint_as_float(w << 16); }
__device__ __forceinline__ float bfhi(unsigned w) { return __uint_as_float(w & 0xffff0000u); }
__device__ __forceinline__ float bf2f(bf16 h) { return __uint_as_float((unsigned)h << 16); }
__device__ __forceinline__ float fast_exp2(float x) { return __builtin_amdgcn_exp2f(x); }
__device__ __forceinline__ float fast_rcp(float x) { return __builtin_amdgcn_rcpf(x); }
__device__ __forceinline__ float sigmoid_f(float v) { return fast_rcp(1.0f + fast_exp2(-LOG2E * v)); }
__device__ __forceinline__ float gelu_tanh_f(float v) { const float u = v + 0.044715f * v * v * v; return v * fast_rcp(1.0f + fast_exp2(-2.0f * 0.7978845608028654f * LOG2E * u)); }
__device__ __forceinline__ float wave_sum(float v) {
#pragma unroll
    for (int o = 1; o < 64; o <<= 1) v += __shfl_xor(v, o);
    return v;
}
__device__ __forceinline__ float wave_max(float v) {
#pragma unroll
    for (int o = 1; o < 64; o <<= 1) v = fmaxf(v, __shfl_xor(v, o));
    return v;
}
#define LDS_WAIT() asm volatile("s_waitcnt lgkmcnt(0)" ::: "memory")
#define KEEP_AB(r, a, b) asm volatile("" : "+v"(r) : "v"(a), "v"(b))
#define VM_WAIT() asm volatile("s_waitcnt vmcnt(0)" ::: "memory")

namespace pg8 {
constexpr int BM = 256, BK = 64, HALF = 128, HTB = HALF * BK * 2, STAGE_BYTES = 8 * HTB;
__host__ __device__ __forceinline__ int lds_byte(int r, int c) { const int st = (r >> 4) * 2 + (c >> 5), rr = r & 15, cc = c & 31, ob = rr * 64 + cc * 2; return st * 1024 + (ob ^ (((ob >> 9) & 1) << 5)); }
__host__ __device__ __forceinline__ void stage_rc(int b, int& R, int& C) { const int st = b / 1024, sb = b % 1024, swz = sb ^ (((sb >> 9) & 1) << 5); R = (st >> 1) * 16 + swz / 64; C = (st & 1) * 32 + (swz % 64) / 2; }
__host__ __device__ __forceinline__ int perm32(int rho) { const int n = rho >> 4, i = rho & 15; return 8 * (i >> 2) + 4 * n + (i & 3); }

struct Unit { int pm, pn, aux, nvalid, crow0; const char* a; const char* b; const int* rows; };

typedef int v4i32 __attribute__((ext_vector_type(4)));
template <class Epi, class Sched, bool ALIGN_EPI, bool GATHER, bool I8 = false, bool PAIRACC = false>
__device__ __forceinline__ void gemm_phase(LAS unsigned char* lds, const int K, const Sched& S, const Epi& E) {
    const int tid = threadIdx.x, wid = __builtin_amdgcn_readfirstlane(tid >> 6), lane = tid & 63, wr = wid >> 2, wc = wid & 3, fr = lane & 15, fq = lane >> 4;
    const int nt = K / BK;
    unsigned voffA[2][2], nvoffA[2][2], voffB[2]; int RA[2], CA[2];
#pragma unroll
    for (int i = 0; i < 2; ++i) { int R, C; stage_rc(tid * 16 + i * 8192, R, C); const int Rb = Epi::PERM ? ((R & ~31) + perm32(R & 31)) : R;
        RA[i] = R; CA[i] = C; voffB[i] = (unsigned)(Rb * K + C) * 2u;
#pragma unroll
        for (int h = 0; h < 2; ++h) { voffA[h][i] = (unsigned)((R + HALF * h) * K + C) * 2u; nvoffA[h][i] = voffA[h][i]; } }
    const size_t kstep = (size_t)(BK * 2);
    const size_t hstep = (size_t)HALF * K * 2;
    const unsigned ldsw = (unsigned)wid * 1024u;
    const int aoff = lds_byte(wr * 64 + fr, fq * 8), boff = lds_byte(wc * 32 + fr, fq * 8);
#define PG8_SA(b, h) (((b) * 2 + (h)) * HTB)
#define PG8_SB(b, h) ((4 + (b) * 2 + (h)) * HTB)
#define PG8_STAGE_B(bufoff, gbase) do { _Pragma("unroll") for (int _i = 0; _i < 2; ++_i) \
        __builtin_amdgcn_global_load_lds((const unsigned*)((const char*)(gbase) + voffB[_i]), (LAS unsigned*)(lds + (bufoff) + ldsw + _i * 8192), 16, 0, 0); } while (0)
#define PG8_STAGE_A(bufoff, gbase, h, NX) do { _Pragma("unroll") for (int _i = 0; _i < 2; ++_i) { const unsigned _o = (GATHER && (NX)) ? nvoffA[h][_i] : voffA[h][_i]; \
        __builtin_amdgcn_global_load_lds((const unsigned*)((const char*)(gbase) + _o), (LAS unsigned*)(lds + (bufoff) + ldsw + _i * 8192), 16, 0, 0); } } while (0)
#define PG8_LDA(dst, b, h) do { _Pragma("unroll") for (int m = 0; m < 4; ++m) _Pragma("unroll") for (int k = 0; k < 2; ++k) dst[m][k] = *(const LAS bf16x8*)(lds + PG8_SA(b, h) + aoff + m * 2048 + k * 1024); } while (0)
#define PG8_LDB(dst, b, h) do { _Pragma("unroll") for (int n = 0; n < 2; ++n) _Pragma("unroll") for (int k = 0; k < 2; ++k) dst[n][k] = *(const LAS bf16x8*)(lds + PG8_SB(b, h) + boff + n * 2048 + k * 1024); } while (0)
#define PG8_MMA(ai, bj, At, Bt) do { __builtin_amdgcn_s_setprio(1); _Pragma("unroll") for (int m = 0; m < 4; ++m) _Pragma("unroll") for (int n = 0; n < 2; ++n) _Pragma("unroll") for (int k = 0; k < 2; ++k) \
        { if constexpr (I8) acc[ai][bj][m][n] = __builtin_bit_cast(f32x4, __builtin_amdgcn_mfma_i32_16x16x64_i8(__builtin_bit_cast(v4i32, Bt[n][k]), __builtin_bit_cast(v4i32, At[m][k]), __builtin_bit_cast(v4i32, acc[ai][bj][m][n]), 0, 0, 0)); \
          else acc[ai][bj][m][n] = __builtin_amdgcn_mfma_f32_16x16x32_bf16(Bt[n][k], At[m][k], acc[ai][bj][m][n], 0, 0, 0); } __builtin_amdgcn_s_setprio(0); } while (0)
#define PG8_WAIT_V(n) asm volatile("s_waitcnt vmcnt(" #n ")" ::: "memory")
#define PG8_WAIT_L(n) asm volatile("s_waitcnt lgkmcnt(" #n ")" ::: "memory")
#define PG8_BAR __builtin_amdgcn_s_barrier()
#define PG8_SCHED __builtin_amdgcn_sched_barrier(0)
#define PG8_GATHER_OFFS(dst, u) do { _Pragma("unroll") for (int _i = 0; _i < 2; ++_i) _Pragma("unroll") for (int _h = 0; _h < 2; ++_h) { const int _r = RA[_i] + HALF * _h; \
        const int _tok = (_r < (u).nvalid) ? (u).rows[_r] : 0; dst[_h][_i] = (unsigned)(_tok * K + CA[_i]) * 2u; } } while (0)
    Unit cur, nxt; int ui = 0;
    if (!S.next(0, cur)) return;
    if constexpr (GATHER) { PG8_GATHER_OFFS(voffA, cur); }
    f32x4 acc[2][2][4][2];
#pragma unroll
    for (int a = 0; a < 2; ++a)
#pragma unroll
        for (int b = 0; b < 2; ++b)
#pragma unroll
            for (int m = 0; m < 4; ++m)
#pragma unroll
                for (int n = 0; n < 2; ++n) acc[a][b][m][n] = (f32x4){0.f, 0.f, 0.f, 0.f};
    bf16x8 At[4][2], B0[2][2], B1[2][2];
    const char* cA = cur.a; const char* cB = cur.b;
    PG8_STAGE_B(PG8_SB(0, 0), cB); PG8_STAGE_B(PG8_SB(0, 1), cB + hstep); PG8_STAGE_A(PG8_SA(0, 0), cA, 0, false); PG8_STAGE_A(PG8_SA(0, 1), cA, 1, false);
    if (wr == 1) PG8_BAR;
    PG8_WAIT_V(2); PG8_BAR;
    PG8_STAGE_B(PG8_SB(1, 0), cB + kstep); PG8_STAGE_A(PG8_SA(1, 0), cA + kstep, 0, false); PG8_STAGE_B(PG8_SB(1, 1), cB + hstep + kstep);
    PG8_WAIT_V(6); PG8_BAR;
    for (;;) {
        const bool has_next = S.next(ui + 1, nxt);
        if constexpr (GATHER) { if (has_next) { PG8_GATHER_OFFS(nvoffA, nxt); } else {
#pragma unroll
            for (int h = 0; h < 2; ++h)
#pragma unroll
                for (int i = 0; i < 2; ++i) nvoffA[h][i] = voffA[h][i]; } }
        const char* nA = has_next ? nxt.a : cA; const char* nB = has_next ? nxt.b : cB;
        for (int t = 0; t < nt; t += 2) {
            const bool last = (t == nt - 2);
            const char* a1 = cA + (size_t)(t + 1) * kstep;
            const char* a2 = last ? nA : cA + (size_t)(t + 2) * kstep; const char* b2 = last ? nB : cB + (size_t)(t + 2) * kstep;
            const char* a3 = a2 + kstep; const char* b3 = b2 + kstep;
            PG8_LDB(B0, 0, 0); PG8_LDB(B1, 0, 1); PG8_SCHED; PG8_LDA(At, 0, 0); PG8_STAGE_A(PG8_SA(1, 1), a1, 1, false);
            PG8_WAIT_V(8); PG8_WAIT_L(0); PG8_BAR; PG8_MMA(0, 0, At, B0); PG8_MMA(0, 1, At, B1); PG8_BAR; PG8_SCHED;
            PG8_LDA(At, 0, 1); PG8_STAGE_B(PG8_SB(0, 0), b2); PG8_STAGE_B(PG8_SB(0, 1), b2 + hstep); PG8_STAGE_A(PG8_SA(0, 0), a2, 0, last);
            PG8_WAIT_V(8); PG8_WAIT_L(0); PG8_BAR; PG8_MMA(1, 0, At, B0); PG8_MMA(1, 1, At, B1); PG8_BAR; PG8_SCHED;
            PG8_LDB(B0, 1, 0); PG8_LDB(B1, 1, 1); PG8_SCHED; PG8_LDA(At, 1, 0); PG8_STAGE_A(PG8_SA(0, 1), a2, 1, last);
            PG8_WAIT_V(8); PG8_WAIT_L(0); PG8_BAR; PG8_MMA(0, 0, At, B0); PG8_MMA(0, 1, At, B1); PG8_BAR; PG8_SCHED;
            PG8_LDA(At, 1, 1); PG8_STAGE_B(PG8_SB(1, 0), b3); PG8_STAGE_B(PG8_SB(1, 1), b3 + hstep); PG8_STAGE_A(PG8_SA(1, 0), a3, 0, last);
            PG8_WAIT_V(8); PG8_WAIT_L(0); PG8_BAR; PG8_MMA(1, 0, At, B0); PG8_MMA(1, 1, At, B1); PG8_BAR; PG8_SCHED;
        }
        if constexpr (ALIGN_EPI) { if (wr == 0) PG8_BAR; }
        bool keep = false;
        if constexpr (PAIRACC) { if (cur.aux == 0) { E.mid(acc, cur, wr, wc, fr, fq); keep = true; } }
        if (!keep) E(acc, cur, wr, wc, fr, fq);
        if (!has_next) break;
        if (!keep) {
#pragma unroll
        for (int a = 0; a < 2; ++a)
#pragma unroll
            for (int b = 0; b < 2; ++b)
#pragma unroll
                for (int m = 0; m < 4; ++m)
#pragma unroll
                    for (int n = 0; n < 2; ++n) acc[a][b][m][n] = (f32x4){0.f, 0.f, 0.f, 0.f}; }
        cur = nxt; cA = nA; cB = nB; ++ui;
        if constexpr (GATHER) {
#pragma unroll
            for (int h = 0; h < 2; ++h)
#pragma unroll
                for (int i = 0; i < 2; ++i) voffA[h][i] = nvoffA[h][i]; }
        if constexpr (ALIGN_EPI) { if (wr == 1) PG8_BAR; }
    }
    PG8_WAIT_V(0);
    if constexpr (!ALIGN_EPI) { if (wr == 0) PG8_BAR; }
    PG8_BAR;
#undef PG8_SA
#undef PG8_SB
#undef PG8_STAGE_A
#undef PG8_STAGE_B
#undef PG8_LDA
#undef PG8_LDB
#undef PG8_MMA
#undef PG8_WAIT_V
#undef PG8_WAIT_L
#undef PG8_BAR
#undef PG8_SCHED
#undef PG8_GATHER_OFFS
}

constexpr int NXCD = 8, WGM = 8;
struct DenseOrder {
    int nM, nN, nwg, G, c; const char* A; const char* B; size_t tstep;
    __device__ void init(const void* A_, const void* B_, int M, int N, int K, int G_, int c_) { A = (const char*)A_; B = (const char*)B_; nM = M / BM; nN = N / BM; nwg = nM * nN; G = G_; c = c_; tstep = (size_t)BM * K * 2; }
    __device__ bool next(int i, Unit& u) const {
        const long L = (long)i * G + c; if (L >= nwg) return false;
        int wgid = (int)L; { const int q = nwg / NXCD, r = nwg % NXCD, xcd = wgid % NXCD, off = wgid / NXCD; wgid = (xcd < r ? xcd * (q + 1) : r * (q + 1) + (xcd - r) * q) + off; }
        const int nig = WGM * nN, gid = wgid / nig, fm = gid * WGM, gsz = (nM - fm) < WGM ? (nM - fm) : WGM;
        u.pm = fm + ((wgid % nig) % gsz); u.pn = (wgid % nig) / gsz; u.aux = 0; u.nvalid = BM; u.crow0 = 0; u.rows = nullptr;
        u.a = A + (size_t)u.pm * tstep; u.b = B + (size_t)u.pn * tstep; return true;
    }
};
struct PairOrder {
    int nM, nN, ntile, G, c; const char* A0; const char* B0; const char* A1; const char* B1; size_t tstep;
    __device__ bool next(int i, Unit& u) const {
        const long L = (long)(i >> 1) * G + c; if (L >= ntile) return false;
        int wgid = (int)L; { const int q = ntile / NXCD, r = ntile % NXCD, xcd = wgid % NXCD, off = wgid / NXCD; wgid = (xcd < r ? xcd * (q + 1) : r * (q + 1) + (xcd - r) * q) + off; }
        const int nig = WGM * nN, gid = wgid / nig, fm = gid * WGM, gsz = (nM - fm) < WGM ? (nM - fm) : WGM;
        u.pm = fm + ((wgid % nig) % gsz); u.pn = (wgid % nig) / gsz; u.aux = i & 1; u.nvalid = BM; u.crow0 = 0; u.rows = nullptr;
        u.a = ((i & 1) ? A1 : A0) + (size_t)u.pm * tstep; u.b = ((i & 1) ? B1 : B0) + (size_t)u.pn * tstep; return true;
    }
};
struct MoeOrder {
    const LAS int* pblk; const LAS int* cnt; int rb_lo, rb_hi, G, c, K, gather;
    const char* Abase; const char* Wbase; size_t wstride; const int* idx; int kpass;
    __device__ bool next(int i, Unit& u) const {
        const long L = (long)i * G + c; const int rb = rb_lo + (int)(L >> 2);
        if (rb >= rb_hi) return false;
        int bkt = 0;
#pragma unroll
        for (int st = 32; st > 0; st >>= 1) if (pblk[bkt + st] <= rb) bkt += st;
        const int j = rb - pblk[bkt], e = bkt & 31;
        u.pm = rb; u.pn = (int)(L & 3); u.aux = bkt >> 5; const int left = cnt[bkt] - 256 * j; u.nvalid = left < 256 ? left : 256; u.crow0 = gather ? e : cnt[64 + bkt] + 256 * j;
        u.rows = idx + (size_t)bkt * MTOK + 256 * j;
        u.a = gather ? Abase : Abase + (size_t)rb * 256 * K * 2;
        u.b = Wbase + (size_t)e * wstride + (size_t)u.pn * 256 * K * 2;
        return true;
    }
};

struct EpiAct {
    static constexpr bool PERM = true;
    bf16* o0; size_t gstride; int acts; int ldc;
    const float* sa; const float* sb;
    __device__ __forceinline__ void operator()(const f32x4 (&acc)[2][2][4][2], const Unit& u, int wr, int wc, int fr, int fq) const {
        const int grp = (u.pn * BM) >> 10; const int colt = u.pn * BM - (grp << 10);
        bf16* base = o0 + (size_t)grp * gstride; const int act = (acts >> (4 * grp)) & 15;
        const int row0 = u.pm * BM + wr * 64 + fr, col0 = colt + wc * 32 + 8 * fq;
        float sbv[2][8];
        if (sa) {
#pragma unroll
            for (int bj = 0; bj < 2; ++bj) { const f32x4 b0 = *(const f32x4*)(sb + u.pn * BM + bj * HALF + wc * 32 + 8 * fq), b1 = *(const f32x4*)(sb + u.pn * BM + bj * HALF + wc * 32 + 8 * fq + 4);
                sbv[bj][0] = b0[0]; sbv[bj][1] = b0[1]; sbv[bj][2] = b0[2]; sbv[bj][3] = b0[3]; sbv[bj][4] = b1[0]; sbv[bj][5] = b1[1]; sbv[bj][6] = b1[2]; sbv[bj][7] = b1[3]; } }
        float sarv[8];
#pragma unroll
        for (int g = 0; g < 8; ++g) sarv[g] = sa ? sa[row0 + (g >> 2) * HALF + (g & 3) * 16] : 1.0f;
#pragma unroll
        for (int ai = 0; ai < 2; ++ai)
#pragma unroll
            for (int m = 0; m < 4; ++m) { const int row = row0 + ai * HALF + m * 16; bf16* rowp = base + (size_t)row * ldc + col0; const float sar = sarv[ai * 4 + m];
#pragma unroll
                for (int bj = 0; bj < 2; ++bj) { const f32x4 a0 = acc[ai][bj][m][0], a1 = acc[ai][bj][m][1];
                    float v[8] = {a0[0], a0[1], a0[2], a0[3], a1[0], a1[1], a1[2], a1[3]};
                    if (sa) {
#pragma unroll
                        for (int e = 0; e < 8; ++e) v[e] = (float)__float_as_int(v[e]) * (sar * sbv[bj][e]); }
                    if (act == 1) {
#pragma unroll
                        for (int e = 0; e < 8; ++e) v[e] = gelu_tanh_f(v[e]); }
                    else if (act == 2) {
#pragma unroll
                        for (int e = 0; e < 8; ++e) v[e] = sigmoid_f(v[e]); }
                    u32x4 w; w.x = cvt_pk_bf16(v[0], v[1]); w.y = cvt_pk_bf16(v[2], v[3]); w.z = cvt_pk_bf16(v[4], v[5]); w.w = cvt_pk_bf16(v[6], v[7]);
                    *(u32x4*)(rowp + bj * HALF) = w; } }
    }
};
struct EpiQKV {
    static constexpr bool PERM = true;
    bf16* o0; size_t gstride; const float* sa; const float* sb; const float* qg; const float* kg; const float* rope; float qscale; unsigned char* sg8;
    __device__ __forceinline__ void operator()(const f32x4 (&acc)[2][2][4][2], const Unit& u, int wr, int wc, int fr, int fq) const {
        const int grp = (u.pn * BM) >> 10; const int pnl = u.pn & 3;
        bf16* base = o0 + (size_t)grp * gstride;
        const int row0 = u.pm * BM + wr * 64 + fr;
        float sbv[2][8];
#pragma unroll
        for (int bj = 0; bj < 2; ++bj) { const f32x4 b0 = *(const f32x4*)(sb + u.pn * BM + bj * HALF + wc * 32 + 8 * fq), b1 = *(const f32x4*)(sb + u.pn * BM + bj * HALF + wc * 32 + 8 * fq + 4);
            sbv[bj][0] = b0[0]; sbv[bj][1] = b0[1]; sbv[bj][2] = b0[2]; sbv[bj][3] = b0[3]; sbv[bj][4] = b1[0]; sbv[bj][5] = b1[1]; sbv[bj][6] = b1[2]; sbv[bj][7] = b1[3]; }
#define QKV_SARV float sarv[8]; _Pragma("unroll") for (int g = 0; g < 8; ++g) sarv[g] = sa[row0 + (g >> 2) * HALF + (g & 3) * 16]
        if (grp >= 3) { QKV_SARV;
            unsigned char* b8 = sg8 + (size_t)(grp - 3) * ((size_t)MTOK * DM) + ((size_t)(u.pm * 4 + pnl) << 16) + (wr * 4 + wc) * 8192 + (fq * 16 + fr) * 16;
            f32x2 sbn[2][4];
#pragma unroll
            for (int bj = 0; bj < 2; ++bj)
#pragma unroll
                for (int p = 0; p < 4; ++p) sbn[bj][p] = (f32x2){sbv[bj][2 * p], sbv[bj][2 * p + 1]} * (-LOG2E);
#pragma unroll
            for (int ai = 0; ai < 2; ++ai)
#pragma unroll
                for (int m = 0; m < 4; ++m) { const float sar = sarv[ai * 4 + m]; u32x4 w4;
#pragma unroll
                    for (int bj = 0; bj < 2; ++bj) { const f32x4 a0 = acc[ai][bj][m][0], a1 = acc[ai][bj][m][1];
                        const float v[8] = {a0[0], a0[1], a0[2], a0[3], a1[0], a1[1], a1[2], a1[3]};
                        unsigned pw_[4];
#pragma unroll
                        for (int p = 0; p < 4; ++p) {
                            const f32x2 z = (f32x2){(float)__float_as_int(v[2 * p]), (float)__float_as_int(v[2 * p + 1])} * (sbn[bj][p] * sar);
                            const f32x2 d = (f32x2){fast_exp2(z.x), fast_exp2(z.y)} * (1.0f / 255.0f) + (1.0f / 255.0f);
                            const f32x2 qf = (f32x2){fast_rcp(d.x), fast_rcp(d.y)} + 12582912.0f;
                            pw_[p] = __builtin_amdgcn_perm(__float_as_uint(qf.y), __float_as_uint(qf.x), 0x0c0c0400u); }
                        const unsigned lo = __builtin_amdgcn_perm(pw_[1], pw_[0], 0x05040100u), hi = __builtin_amdgcn_perm(pw_[3], pw_[2], 0x05040100u);
                        if (bj == 0) { w4.x = lo; w4.y = hi; } else { w4.z = lo; w4.w = hi; } }
                    *(u32x4*)(b8 + (ai * 4 + m) * 1024) = w4; }
            return;
        }
        if (grp == 2) { QKV_SARV;
            const int col0 = pnl * BM + wc * 32 + 8 * fq;
#pragma unroll
            for (int ai = 0; ai < 2; ++ai)
#pragma unroll
                for (int m = 0; m < 4; ++m) { const int row = row0 + ai * HALF + m * 16; const float sar = sarv[ai * 4 + m]; bf16* rowp = base + (size_t)row * DM + col0;
#pragma unroll
                    for (int bj = 0; bj < 2; ++bj) { const f32x4 a0 = acc[ai][bj][m][0], a1 = acc[ai][bj][m][1];
                        float v[8] = {a0[0], a0[1], a0[2], a0[3], a1[0], a1[1], a1[2], a1[3]};
#pragma unroll
                        for (int e = 0; e < 8; ++e) v[e] = (float)__float_as_int(v[e]) * (sar * sbv[bj][e]);
                        u32x4 w; w.x = cvt_pk_bf16(v[0], v[1]); w.y = cvt_pk_bf16(v[2], v[3]); w.z = cvt_pk_bf16(v[4], v[5]); w.w = cvt_pk_bf16(v[6], v[7]);
                        *(u32x4*)(rowp + bj * HALF) = w; } }
            return;
        }
        const float* gp = grp == 0 ? qg : kg; const float gs = grp == 0 ? qscale : 1.0f;
        float gv[2][8];
#pragma unroll
        for (int bj = 0; bj < 2; ++bj) { const f32x4 g0 = *(const f32x4*)(gp + 32 * bj + 8 * fq), g1 = *(const f32x4*)(gp + 32 * bj + 8 * fq + 4);
            gv[bj][0] = g0[0] * gs; gv[bj][1] = g0[1] * gs; gv[bj][2] = g0[2] * gs; gv[bj][3] = g0[3] * gs; gv[bj][4] = g1[0] * gs; gv[bj][5] = g1[1] * gs; gv[bj][6] = g1[2] * gs; gv[bj][7] = g1[3] * gs; }
        const int colL = (pnl * 4 + wc) * 64 + 8 * fq;
        f32x4 rp[4];
#pragma unroll
        for (int q = 0; q < 4; ++q) rp[q] = *(const f32x4*)(rope + (size_t)row0 * 16 + 4 * q);
        float sarn = sa[row0];
#pragma unroll
        for (int ai = 0; ai < 2; ++ai)
#pragma unroll
            for (int m = 0; m < 4; ++m) { const int row = row0 + ai * HALF + m * 16; const float sar = sarn;
                const int gi = ai * 4 + m;
                float y[2][8]; float ss = 0.f;
#pragma unroll
                for (int bj = 0; bj < 2; ++bj) { const f32x4 a0 = acc[ai][bj][m][0], a1 = acc[ai][bj][m][1];
                    const float t[8] = {a0[0], a0[1], a0[2], a0[3], a1[0], a1[1], a1[2], a1[3]};
#pragma unroll
                    for (int e = 0; e < 8; ++e) { y[bj][e] = (float)__float_as_int(t[e]) * (sar * sbv[bj][e]); ss += y[bj][e] * y[bj][e]; } }
                ss += __shfl_xor(ss, 16); ss += __shfl_xor(ss, 32);
                const float rstd = rsqrtf(ss * (1.f / 64.f) + EPS);
#pragma unroll
                for (int bj = 0; bj < 2; ++bj)
#pragma unroll
                    for (int e = 0; e < 8; ++e) y[bj][e] *= rstd * gv[bj][e];
                const f32x4 c0 = rp[0], c1 = rp[1], s0 = rp[2], s1 = rp[3];
                const float cs[8] = {c0[0], c0[1], c0[2], c0[3], c1[0], c1[1], c1[2], c1[3]}, sn[8] = {s0[0], s0[1], s0[2], s0[3], s1[0], s1[1], s1[2], s1[3]};
#pragma unroll
                for (int e = 0; e < 8; ++e) { const float px = __shfl_xor(y[0][e], 16);
                    const float r0 = y[0][e] * cs[e] - px * sn[e], r1 = y[0][e] * cs[e] + px * sn[e];
                    y[0][e] = fq == 0 ? r0 : (fq == 1 ? r1 : y[0][e]); }
                if (gi < 7) { const int rown = row0 + ((gi + 1) >> 2) * HALF + ((gi + 1) & 3) * 16;
#pragma unroll
                    for (int q = 0; q < 4; ++q) rp[q] = *(const f32x4*)(rope + (size_t)rown * 16 + 4 * q);
                    sarn = sa[rown]; }
                bf16* rowp = base + (size_t)row * DM + colL;
#pragma unroll
                for (int bj = 0; bj < 2; ++bj) { u32x4 w; w.x = cvt_pk_bf16(y[bj][0], y[bj][1]); w.y = cvt_pk_bf16(y[bj][2], y[bj][3]); w.z = cvt_pk_bf16(y[bj][4], y[bj][5]); w.w = cvt_pk_bf16(y[bj][6], y[bj][7]);
                    *(u32x4*)(rowp + 32 * bj) = w; } }
#undef QKV_SARV
    }
};
struct EpiRowScale {
    static constexpr bool PERM = true;
    bf16* out; int ldc; const float* rss;
    __device__ __forceinline__ void operator()(const f32x4 (&acc)[2][2][4][2], const Unit& u, int wr, int wc, int fr, int fq) const {
        const int row0 = u.pm * BM + wr * 64 + fr, col0 = u.pn * BM + wc * 32 + 8 * fq;
        float rstdv[8];
#pragma unroll
        for (int g = 0; g < 8; ++g) { const f32x4* p = (const f32x4*)(rss + (size_t)(row0 + (g >> 2) * HALF + (g & 3) * 16) * 16);
            const f32x4 s0 = p[0], s1 = p[1], s2 = p[2], s3 = p[3];
            const float ss = ((s0[0] + s0[1]) + (s0[2] + s0[3])) + ((s1[0] + s1[1]) + (s1[2] + s1[3])) + ((s2[0] + s2[1]) + (s2[2] + s2[3])) + ((s3[0] + s3[1]) + (s3[2] + s3[3]));
            rstdv[g] = rsqrtf(ss * (1.0f / DM) + EPS); }
#pragma unroll
        for (int ai = 0; ai < 2; ++ai)
#pragma unroll
            for (int m = 0; m < 4; ++m) { const int row = row0 + ai * HALF + m * 16; const float rstd = rstdv[ai * 4 + m];
                bf16* rowp = out + (size_t)row * ldc + col0;
#pragma unroll
                for (int bj = 0; bj < 2; ++bj) { const f32x4 v0 = acc[ai][bj][m][0] * rstd, v1 = acc[ai][bj][m][1] * rstd;
                    u32x4 w; w.x = cvt_pk_bf16(v0[0], v0[1]); w.y = cvt_pk_bf16(v0[2], v0[3]); w.z = cvt_pk_bf16(v1[0], v1[1]); w.w = cvt_pk_bf16(v1[2], v1[3]);
                    *(u32x4*)(rowp + bj * HALF) = w; } }
    }
};
struct EpiMix {
    static constexpr bool PERM = true;
    const unsigned char* g0; const unsigned char* g1; bf16* mix;
    __device__ __forceinline__ void mid(f32x4 (&acc)[2][2][4][2], const Unit& u, int wr, int wc, int fr, int fq) const {
        const size_t goff = ((size_t)(u.pm * 4 + u.pn) << 16) + (wr * 4 + wc) * 8192 + (fq * 16 + fr) * 16;
#pragma unroll
        for (int ai = 0; ai < 2; ++ai)
#pragma unroll
            for (int m = 0; m < 4; ++m) { const u32x4 a4 = *(const u32x4*)(g0 + goff + (ai * 4 + m) * 1024), b4 = *(const u32x4*)(g1 + goff + (ai * 4 + m) * 1024);
#pragma unroll
                for (int bj = 0; bj < 2; ++bj) {
#pragma unroll
                    for (int e = 0; e < 8; ++e) { const unsigned aw = bj == 0 ? (e < 4 ? a4.x : a4.y) : (e < 4 ? a4.z : a4.w), bw = bj == 0 ? (e < 4 ? b4.x : b4.y) : (e < 4 ? b4.z : b4.w); const int sh = 8 * (e & 3);
                        const float ga = (float)((aw >> sh) & 0xffu), gb = fmaxf((float)((bw >> sh) & 0xffu), 1.0f);
                        acc[ai][bj][m][e >> 2][e & 3] *= ga * fast_rcp(gb); } } }
    }
    __device__ __forceinline__ void operator()(const f32x4 (&acc)[2][2][4][2], const Unit& u, int wr, int wc, int fr, int fq) const {
        const int row0 = u.pm * BM + wr * 64 + fr, col0 = u.pn * BM + wc * 32 + 8 * fq;
        const size_t goff = ((size_t)(u.pm * 4 + u.pn) << 16) + (wr * 4 + wc) * 8192 + (fq * 16 + fr) * 16;
        u32x4 gb8[8];
#pragma unroll
        for (int g = 0; g < 8; ++g) gb8[g] = *(const u32x4*)(g1 + goff + g * 1024);
#pragma unroll
        for (int ai = 0; ai < 2; ++ai)
#pragma unroll
            for (int m = 0; m < 4; ++m) { const size_t off = (size_t)(row0 + ai * HALF + m * 16) * DM + col0; const u32x4 b4 = gb8[ai * 4 + m];
#pragma unroll
                for (int bj = 0; bj < 2; ++bj) { float v[8];
#pragma unroll
                    for (int e = 0; e < 8; ++e) { const unsigned bw = bj == 0 ? (e < 4 ? b4.x : b4.y) : (e < 4 ? b4.z : b4.w); const float gb = fmaxf((float)((bw >> (8 * (e & 3))) & 0xffu), 1.0f) * (1.0f / 255.0f);
                        v[e] = acc[ai][bj][m][e >> 2][e & 3] * gb; }
                    u32x4 w; w.x = cvt_pk_bf16(v[0], v[1]); w.y = cvt_pk_bf16(v[2], v[3]); w.z = cvt_pk_bf16(v[4], v[5]); w.w = cvt_pk_bf16(v[6], v[7]);
                    *(u32x4*)(mix + off + bj * HALF) = w; } }
    }
};
template <bool XF32> struct EpiResid {
    static constexpr bool PERM = true;
    const void* xin; bf16* xb; float* rss; float* amx;
    __device__ __forceinline__ void operator()(const f32x4 (&acc)[2][2][4][2], const Unit& u, int wr, int wc, int fr, int fq) const {
        const int row0 = u.pm * BM + wr * 64 + fr, col0 = u.pn * BM + wc * 32 + 8 * fq;
        constexpr int D = XF32 ? 3 : 4;
        f32x4 xv[D][XF32 ? 4 : 1]; u32x4 xw[D][XF32 ? 1 : 2];
#define ER_LOAD(g) do { const size_t o_ = (size_t)(row0 + ((g) >> 2) * HALF + ((g) & 3) * 16) * DM + col0; _Pragma("unroll") for (int q_ = 0; q_ < 2; ++q_) { const size_t oo_ = o_ + q_ * HALF; \
            if (XF32) { xv[(g) % D][XF32 ? 2 * q_ : 0] = __builtin_nontemporal_load((const f32x4*)((const float*)xin + oo_)); xv[(g) % D][XF32 ? 2 * q_ + 1 : 0] = __builtin_nontemporal_load((const f32x4*)((const float*)xin + oo_ + 4)); } \
            else xw[(g) % D][XF32 ? 0 : q_] = *(const u32x4*)((const bf16*)xin + oo_); } } while (0)
#pragma unroll
        for (int g = 0; g < D - 1; ++g) ER_LOAD(g);
#pragma unroll
        for (int ai = 0; ai < 2; ++ai)
#pragma unroll
            for (int m = 0; m < 4; ++m) { const int row = row0 + ai * HALF + m * 16; const size_t off = (size_t)row * DM + col0; float ss = 0.f, am = 0.f;
                const int gi = ai * 4 + m;
                if (gi + D - 1 < 8) ER_LOAD(gi + D - 1);
#pragma unroll
                for (int bj = 0; bj < 2; ++bj) { f32x4 v0, v1;
                    if (XF32) { v0 = xv[gi % D][XF32 ? 2 * bj : 0]; v1 = xv[gi % D][XF32 ? 2 * bj + 1 : 0]; }
                    else { const u32x4 w = xw[gi % D][XF32 ? 0 : bj]; v0 = (f32x4){bflo(w.x), bfhi(w.x), bflo(w.y), bfhi(w.y)}; v1 = (f32x4){bflo(w.z), bfhi(w.z), bflo(w.w), bfhi(w.w)}; }
                    v0 = v0 + acc[ai][bj][m][0]; v1 = v1 + acc[ai][bj][m][1];
                    u32x4 w; w.x = cvt_pk_bf16(v0[0], v0[1]); w.y = cvt_pk_bf16(v0[2], v0[3]); w.z = cvt_pk_bf16(v1[0], v1[1]); w.w = cvt_pk_bf16(v1[2], v1[3]); *(u32x4*)(xb + off + bj * HALF) = w;
                    ss += ((v0[0] * v0[0] + v0[1] * v0[1]) + (v0[2] * v0[2] + v0[3] * v0[3])) + ((v1[0] * v1[0] + v1[1] * v1[1]) + (v1[2] * v1[2] + v1[3] * v1[3]));
                    am = fmaxf(am, fmaxf(fmaxf(fmaxf(fabsf(v0[0]), fabsf(v0[1])), fmaxf(fabsf(v0[2]), fabsf(v0[3]))), fmaxf(fmaxf(fabsf(v1[0]), fabsf(v1[1])), fmaxf(fabsf(v1[2]), fabsf(v1[3]))))); }
                ss += __shfl_xor(ss, 16); ss += __shfl_xor(ss, 32);
                if (fq == 0) rss[(size_t)row * 16 + u.pn * 4 + wc] = ss;
                if (amx) { am = fmaxf(am, __shfl_xor(am, 16)); am = fmaxf(am, __shfl_xor(am, 32)); if (fq == 0) amx[(size_t)row * 16 + u.pn * 4 + wc] = am; } }
#undef ER_LOAD
    }
};
struct EpiLogit {
    static constexpr bool PERM = false;
    float* logit;
    __device__ __forceinline__ void operator()(const f32x4 (&acc)[2][2][4][2], const Unit& u, int wr, int wc, int fr, int fq) const {
        if (wc >= 2) return;
        const int row0 = u.pm * BM + wr * 64 + fr, col0 = wc * 32 + 4 * fq;
#pragma unroll
        for (int ai = 0; ai < 2; ++ai)
#pragma unroll
            for (int m = 0; m < 4; ++m) { float* rowp = logit + (size_t)(row0 + ai * HALF + m * 16) * 64 + col0;
#pragma unroll
                for (int n = 0; n < 2; ++n) *(f32x4*)(rowp + n * 16) = acc[ai][0][m][n]; }
    }
};
struct EpiGateUp {
    static constexpr bool PERM = true;
    bf16* H; const float* rstd; const float* xs; const float* wsc;
    __device__ __forceinline__ void operator()(const f32x4 (&acc)[2][2][4][2], const Unit& u, int wr, int wc, int fr, int fq) const {
        const int col0 = u.pn * 128 + wc * 32 + 8 * fq;
        int tok[8]; float rs[8];
#pragma unroll
        for (int i = 0; i < 8; ++i) { const int rt = (i >> 2) * HALF + wr * 64 + (i & 3) * 16 + fr; tok[i] = u.rows[rt < u.nvalid ? rt : 0]; }
#pragma unroll
        for (int i = 0; i < 8; ++i) rs[i] = rstd[tok[i]] * xs[tok[i]];
        const float* wcol = wsc + (size_t)u.crow0 * 1024 + u.pn * BM + wc * 32 + 8 * fq;
        float sg[8], su[8];
        { const f32x4 g0 = *(const f32x4*)wcol, g1 = *(const f32x4*)(wcol + 4), u0 = *(const f32x4*)(wcol + HALF), u1 = *(const f32x4*)(wcol + HALF + 4);
          sg[0] = g0[0]; sg[1] = g0[1]; sg[2] = g0[2]; sg[3] = g0[3]; sg[4] = g1[0]; sg[5] = g1[1]; sg[6] = g1[2]; sg[7] = g1[3];
          su[0] = u0[0]; su[1] = u0[1]; su[2] = u0[2]; su[3] = u0[3]; su[4] = u1[0]; su[5] = u1[1]; su[6] = u1[2]; su[7] = u1[3]; }
#pragma unroll
        for (int ai = 0; ai < 2; ++ai)
#pragma unroll
            for (int m = 0; m < 4; ++m) { const int rt = ai * HALF + wr * 64 + m * 16 + fr; const float r_ = rt < u.nvalid ? rs[ai * 4 + m] : 0.f;
                float h[8];
#pragma unroll
                for (int n = 0; n < 2; ++n)
#pragma unroll
                    for (int e = 0; e < 4; ++e) { const float g = (float)__float_as_int(acc[ai][0][m][n][e]) * (r_ * sg[n * 4 + e]), up = (float)__float_as_int(acc[ai][1][m][n][e]) * (r_ * su[n * 4 + e]); h[n * 4 + e] = g * sigmoid_f(g) * up; }
                u32x4 w; w.x = cvt_pk_bf16(h[0], h[1]); w.y = cvt_pk_bf16(h[2], h[3]); w.z = cvt_pk_bf16(h[4], h[5]); w.w = cvt_pk_bf16(h[6], h[7]);
                *(u32x4*)(H + (size_t)(u.pm * BM + rt) * EFF + col0) = w; }
    }
};
struct EpiY {
    static constexpr bool PERM = true;
    bf16* y0; bf16* y1;
    __device__ __forceinline__ void operator()(const f32x4 (&acc)[2][2][4][2], const Unit& u, int wr, int wc, int fr, int fq) const {
        bf16* base = (u.aux ? y1 : y0) + (size_t)u.crow0 * DM + u.pn * BM;
        const unsigned loff = (unsigned)((wr * 64 + fr) * DM + wc * 32 + 8 * fq); const int rt0 = wr * 64 + fr;
#pragma unroll
        for (int ai = 0; ai < 2; ++ai)
#pragma unroll
            for (int m = 0; m < 4; ++m) {
                if (rt0 + ai * HALF + m * 16 < u.nvalid) {
#pragma unroll
                    for (int bj = 0; bj < 2; ++bj) { const f32x4 v0 = acc[ai][bj][m][0], v1 = acc[ai][bj][m][1];
                        u32x4 w; w.x = cvt_pk_bf16(v0[0], v0[1]); w.y = cvt_pk_bf16(v0[2], v0[3]); w.z = cvt_pk_bf16(v1[0], v1[1]); w.w = cvt_pk_bf16(v1[2], v1[3]);
                        *(u32x4*)(base + loff + (unsigned)((ai * HALF + m * 16) * DM + bj * HALF)) = w; } } }
    }
};
}

#define XB_TMO      128
#define XB_XCNT(j)  (256  + 64 * (j))
#define XB_XSUB(j)  (1280 + 64 * (j))
#define XB_XGEN(j)  (2304 + 64 * (j))
#define XB_TOP      3328
#define XB_TOPGEN   3392
#define XCD_BAR_WORDS 3456
#define XB_SPIN_CAP (1u << 18)
__device__ __forceinline__ unsigned xb_ld(unsigned* p)              { return __hip_atomic_load(p, __ATOMIC_RELAXED, __HIP_MEMORY_SCOPE_AGENT); }
__device__ __forceinline__ unsigned xb_add(unsigned* p, unsigned v) { return __hip_atomic_fetch_add(p, v, __ATOMIC_RELAXED, __HIP_MEMORY_SCOPE_AGENT); }
__device__ __forceinline__ unsigned xb_xcc_id() { return (unsigned)__builtin_amdgcn_s_getreg((3 << 11) | 20) & 0xFu; }
#define XB_SPIN(cond, bar) do { unsigned _sp = 0; while (cond) { __builtin_amdgcn_s_sleep(1); \
    if ((++_sp & 255u) == 0u) { if (xb_ld(&(bar)[XB_TMO])) break; if (_sp > XB_SPIN_CAP) { atomicAdd(&(bar)[XB_TMO], 1u); break; } } } } while (0)
struct XcdBarrier { unsigned* bar; unsigned x; volatile LAS unsigned* st; };
__device__ __forceinline__ XcdBarrier xcd_barrier_post(unsigned* bar, volatile LAS unsigned* st) {
    XcdBarrier b; b.bar = bar; b.x = xb_xcc_id(); b.st = st;
    if (threadIdx.x == 0) (void)xb_add(&bar[XB_XCNT(b.x)], 1u);
    return b;
}
__device__ __forceinline__ void xcd_barrier_complete(unsigned* bar, unsigned x, unsigned& nloc, unsigned& nx) {
    const unsigned G = gridDim.x * gridDim.y * gridDim.z;
    unsigned sum, cnt, mine, sp = 0u;
    for (;;) {
        sum = 0u; cnt = 0u; mine = 0u;
#pragma unroll
        for (unsigned j = 0; j < 16; ++j) { const unsigned c = xb_ld(&bar[XB_XCNT(j)]); sum += c; cnt += (c > 0u) ? 1u : 0u; mine = (j == x) ? c : mine; }
        if (sum == G) break;
        __builtin_amdgcn_s_sleep(1);
        if ((++sp & 255u) == 0u) { if (xb_ld(&bar[XB_TMO])) break; if (sp > XB_SPIN_CAP) { atomicAdd(&bar[XB_TMO], 1u); break; } }
    }
    nloc = mine > 0u ? mine : 1u; nx = cnt > 0u ? cnt : 1u;
}
__device__ __forceinline__ void xcd_barrier(const XcdBarrier& b) {
    asm volatile("s_waitcnt vmcnt(0)" ::: "memory");
    __syncthreads();
    if (threadIdx.x == 0) {
        unsigned* bar = b.bar;
        __builtin_amdgcn_s_waitcnt(0);
        unsigned nloc = b.st[0], nx = b.st[1];
        if (nloc == 0u) { xcd_barrier_complete(bar, b.x, nloc, nx); b.st[0] = nloc; b.st[1] = nx; }
        const unsigned old = xb_add(&bar[XB_XSUB(b.x)], 1u);
        const unsigned gen = old / nloc;
        if (old + 1u == (gen + 1u) * nloc) {
            __builtin_amdgcn_fence(__ATOMIC_RELEASE, "agent");
            asm volatile("s_waitcnt vmcnt(0)" ::: "memory");
            const unsigned og = xb_add(&bar[XB_TOP], 1u);
            const unsigned tg = og / nx;
            if (og + 1u == (tg + 1u) * nx) xb_add(&bar[XB_TOPGEN], 1u);
            else XB_SPIN(xb_ld(&bar[XB_TOPGEN]) == tg, bar);
            __builtin_amdgcn_fence(__ATOMIC_ACQUIRE, "agent");
            xb_add(&bar[XB_XGEN(b.x)], 1u);
            asm volatile("s_waitcnt vmcnt(0)" ::: "memory");
        } else {
            XB_SPIN(xb_ld(&bar[XB_XGEN(b.x)]) == gen, bar);
            __builtin_amdgcn_fence(__ATOMIC_ACQUIRE, "agent");
            asm volatile("s_waitcnt vmcnt(0)" ::: "memory");
        }
    }
    __syncthreads();
}

struct Args { const void* in[36]; float* out; unsigned char* ws; int ph_lo, ph_hi, li, pad; };
enum { I_X = 0, I_MEM, I_POS, I_NORM_MIX, I_W_IN, I_CONV_W, I_CONV_B, I_LRU_WA, I_LRU_BA, I_LRU_WX, I_LRU_BX, I_LRU_LAMBDA, I_W_LRU_O, I_Q_NORM, I_K_NORM,
       I_LQ1, I_LK1, I_LQ2, I_LK2, I_SUBLN, I_W_ATTN_O, I_W_OUT, I_NORM_CX, I_NORM_MEM, I_W_CQ, I_W_CKV, I_CQ_NORM, I_CK_NORM, I_W_CO, I_NORM_FFN,
       I_W_GROUP, I_B_GROUP, I_W_ROUTER, I_B_ROUTER, I_W_GATE_UP, I_W_DOWN };

template <int MODE>
__device__ __forceinline__ void transpose_item(const float* W, int K, int N, bf16* WT, int row_off, const float* gain, LAS float* scr, int item, int lane) {
    const int nblk = N / 32, kb = item / nblk, nb = item % nblk, k0 = 64 * kb, n0 = 32 * nb;
    float tv[32];
#pragma unroll
    for (int i = 0; i < 32; ++i) { const int kk = 2 * i + (lane >> 5); tv[i] = W[(size_t)(k0 + kk) * N + n0 + (lane & 31)]; }
#pragma unroll
    for (int i = 0; i < 32; ++i) { const int kk = 2 * i + (lane >> 5); float v = tv[i]; if (gain) v *= gain[k0 + kk]; scr[kk * 33 + (lane & 31)] = v; }
    LDS_WAIT(); asm volatile("" ::: "memory");
    const int c = lane & 7;
#pragma unroll
    for (int j = 0; j < 4; ++j) { const int n = (lane >> 3) + 8 * j; const LAS float* s = scr + (8 * c) * 33 + n;
        u32x4 o; o.x = cvt_pk_bf16(s[0 * 33], s[1 * 33]); o.y = cvt_pk_bf16(s[2 * 33], s[3 * 33]); o.z = cvt_pk_bf16(s[4 * 33], s[5 * 33]); o.w = cvt_pk_bf16(s[6 * 33], s[7 * 33]);
        const int ng = n0 + n; int dr;
        if (MODE == 0) dr = row_off + ng; else { const int jj = ng & 511, up = ng >> 9; dr = row_off + (jj >> 7) * 256 + up * 128 + (jj & 127); }
        *(u32x4*)(WT + (size_t)dr * K + k0 + 8 * c) = o; }
    LDS_WAIT(); asm volatile("" ::: "memory");
}
__device__ __forceinline__ unsigned pack_i8x4(float a, float b, float c, float d) {
    const int ia = max(-127, min(127, __float2int_rn(a))), ib = max(-127, min(127, __float2int_rn(b))), ic = max(-127, min(127, __float2int_rn(c))), id = max(-127, min(127, __float2int_rn(d)));
    return (unsigned)(ia & 0xff) | ((unsigned)(ib & 0xff) << 8) | ((unsigned)(ic & 0xff) << 16) | ((unsigned)(id & 0xff) << 24);
}
__device__ __forceinline__ void rms_row_to_i8(const float* xrow, const float* g, unsigned char* orow, float* xs, int lane) {
    const f32x4* xr = (const f32x4*)xrow + lane; const f32x4* gr = (const f32x4*)g + lane;
    f32x4 v[4]; float s = 0.f;
#pragma unroll
    for (int j = 0; j < 4; ++j) { v[j] = __builtin_nontemporal_load(xr + 64 * j); s += (v[j].x * v[j].x + v[j].y * v[j].y) + (v[j].z * v[j].z + v[j].w * v[j].w); }
    const float rstd = rsqrtf(wave_sum(s) * (1.f / DM) + EPS); float mx = 0.f;
#pragma unroll
    for (int j = 0; j < 4; ++j) { const f32x4 gg = gr[64 * j]; v[j] = v[j] * gg * rstd; mx = fmaxf(mx, fmaxf(fmaxf(fabsf(v[j].x), fabsf(v[j].y)), fmaxf(fabsf(v[j].z), fabsf(v[j].w)))); }
    mx = wave_max(mx); const float sc = mx > 0.f ? mx * (1.0f / 127.0f) : 1.0f, inv = 1.0f / sc;
    if (lane == 0) *xs = sc;
    unsigned* o4 = (unsigned*)orow + lane;
#pragma unroll
    for (int j = 0; j < 4; ++j) o4[64 * j] = pack_i8x4(v[j].x * inv, v[j].y * inv, v[j].z * inv, v[j].w * inv);
}
__device__ __forceinline__ int win_dest(int n0) { if (n0 >= 2048 && n0 < 4096) { const int l0 = n0 & 255; return (n0 & ~255) + 128 * ((l0 >> 5) & 1) + 32 * (l0 >> 6); } return n0; }
__device__ __forceinline__ void win_absmax_item(const float* W, unsigned* wmax, int item, int lane) {
    constexpr int nblk = NWIN / 32; const int kb = item / nblk, nb = item % nblk, k0 = 64 * kb, n0 = 32 * nb;
    float tv[32], mx = 0.f;
#pragma unroll
    for (int i = 0; i < 32; ++i) { const int kk = 2 * i + (lane >> 5); tv[i] = W[(size_t)(k0 + kk) * NWIN + n0 + (lane & 31)]; }
#pragma unroll
    for (int i = 0; i < 32; ++i) mx = fmaxf(mx, fabsf(tv[i]));
    mx = fmaxf(mx, __shfl_xor(mx, 32));
    if (lane < 32) atomicMax(wmax + win_dest(n0) + lane, __float_as_uint(mx));
}
__device__ __forceinline__ void win_quant_item(const float* W, unsigned char* WT, const unsigned* wmax, float* wsc, LAS float* scr, int item, int lane) {
    constexpr int nblk = NWIN / 32; const int kb = item / nblk, nb = item % nblk, k0 = 64 * kb, n0 = 32 * nb, d0 = win_dest(n0);
    float tv[32];
#pragma unroll
    for (int i = 0; i < 32; ++i) { const int kk = 2 * i + (lane >> 5); tv[i] = W[(size_t)(k0 + kk) * NWIN + n0 + (lane & 31)]; }
    if (lane < 32) { const float mx = __uint_as_float(__hip_atomic_load(wmax + d0 + lane, __ATOMIC_RELAXED, __HIP_MEMORY_SCOPE_AGENT)); const float sc = mx > 0.f ? mx * (1.0f / 127.0f) : 1.0f;
        scr[64 * 33 + lane] = 1.0f / sc; if (kb == 0) wsc[d0 + lane] = sc; }
#pragma unroll
    for (int i = 0; i < 32; ++i) { const int kk = 2 * i + (lane >> 5); scr[kk * 33 + (lane & 31)] = tv[i]; }
    LDS_WAIT(); asm volatile("" ::: "memory");
    const int c = lane & 7;
#pragma unroll
    for (int j = 0; j < 4; ++j) { const int n = (lane >> 3) + 8 * j; const LAS float* sp = scr + (8 * c) * 33 + n; const float inv = scr[64 * 33 + n];
        u32x2 o; o.x = pack_i8x4(sp[0 * 33] * inv, sp[1 * 33] * inv, sp[2 * 33] * inv, sp[3 * 33] * inv); o.y = pack_i8x4(sp[4 * 33] * inv, sp[5 * 33] * inv, sp[6 * 33] * inv, sp[7 * 33] * inv);
        *(u32x2*)(WT + (size_t)(d0 + n) * DM + k0 + 8 * c) = o; }
    LDS_WAIT(); asm volatile("" ::: "memory");
}
__device__ __forceinline__ int gu_dest(int n) { const int jj = n & 511, up = n >> 9; return (jj >> 7) * 256 + up * 128 + (jj & 127); }
__device__ __forceinline__ void gu_absmax_item(const float* W, const float* gain, unsigned* wmax  , int item, int lane) {
    const int kb = item >> 5, nb = item & 31, k0 = 64 * kb, n0 = 32 * nb;
    float tv[32], mx = 0.f;
#pragma unroll
    for (int i = 0; i < 32; ++i) { const int kk = 2 * i + (lane >> 5); tv[i] = W[(size_t)(k0 + kk) * 1024 + n0 + (lane & 31)]; }
#pragma unroll
    for (int i = 0; i < 32; ++i) { const int kk = 2 * i + (lane >> 5); mx = fmaxf(mx, fabsf(tv[i] * gain[k0 + kk])); }
    mx = fmaxf(mx, __shfl_xor(mx, 32));
    if (lane < 32) atomicMax(wmax + gu_dest(n0) + lane, __float_as_uint(mx));
}
__device__ __forceinline__ void gu_quant_item(const float* W, const float* gain, unsigned char* WT  , const unsigned* wmax, float* wsc, LAS float* scr, int item, int lane) {
    const int kb = item >> 5, nb = item & 31, k0 = 64 * kb, n0 = 32 * nb, d0 = gu_dest(n0);
    float tv[32];
#pragma unroll
    for (int i = 0; i < 32; ++i) { const int kk = 2 * i + (lane >> 5); tv[i] = W[(size_t)(k0 + kk) * 1024 + n0 + (lane & 31)]; }
    if (lane < 32) { const float mx = __uint_as_float(__hip_atomic_load(wmax + d0 + lane, __ATOMIC_RELAXED, __HIP_MEMORY_SCOPE_AGENT)); const float sc = mx > 0.f ? mx * (1.0f / 127.0f) : 1.0f;
        scr[64 * 33 + lane] = 1.0f / sc; if (kb == 0) wsc[d0 + lane] = sc; }
#pragma unroll
    for (int i = 0; i < 32; ++i) { const int kk = 2 * i + (lane >> 5); scr[kk * 33 + (lane & 31)] = tv[i] * gain[k0 + kk]; }
    LDS_WAIT(); asm volatile("" ::: "memory");
    const int c = lane & 7;
#pragma unroll
    for (int j = 0; j < 4; ++j) { const int n = (lane >> 3) + 8 * j; const LAS float* sp = scr + (8 * c) * 33 + n; const float inv = scr[64 * 33 + n];
        u32x2 o; o.x = pack_i8x4(sp[0 * 33] * inv, sp[1 * 33] * inv, sp[2 * 33] * inv, sp[3 * 33] * inv); o.y = pack_i8x4(sp[4 * 33] * inv, sp[5 * 33] * inv, sp[6 * 33] * inv, sp[7 * 33] * inv);
        *(u32x2*)(WT + (size_t)(d0 + n) * DM + k0 + 8 * c) = o; }
    LDS_WAIT(); asm volatile("" ::: "memory");
}
__device__ __forceinline__ void rms_row_to_bf16(const float* xrow, const float* g, bf16* orow, int lane) {
    const f32x4* xr = (const f32x4*)xrow + lane; const f32x4* gr = (const f32x4*)g + lane;
    f32x4 v[4]; float s = 0.f;
#pragma unroll
    for (int j = 0; j < 4; ++j) { v[j] = xr[64 * j]; s += (v[j].x * v[j].x + v[j].y * v[j].y) + (v[j].z * v[j].z + v[j].w * v[j].w); }
    const float rstd = rsqrtf(wave_sum(s) * (1.f / DM) + EPS);
    u32x2* o8 = (u32x2*)orow + lane;
#pragma unroll
    for (int j = 0; j < 4; ++j) { const f32x4 gg = gr[64 * j]; u32x2 w; w.x = cvt_pk_bf16(v[j].x * rstd * gg.x, v[j].y * rstd * gg.y); w.y = cvt_pk_bf16(v[j].z * rstd * gg.z, v[j].w * rstd * gg.w); o8[64 * j] = w; }
}
__device__ __forceinline__ void colquant_wg_item(const float* W, int N, int n0, int d0, const LAS float* gain_l  , unsigned char* WT, float* wsc, LAS float* red, int tid) {
    const int ks = tid >> 5, nl = tid & 31;
    float v[64];
    const float* src = W + (size_t)(64 * ks) * N + n0 + nl;
#pragma unroll
    for (int i = 0; i < 64; ++i) v[i] = src[(size_t)i * N];
    if (gain_l) {
#pragma unroll
        for (int i = 0; i < 16; ++i) { const f32x4 g4 = *(const LAS f32x4*)(gain_l + 64 * ks + 4 * i); v[4 * i] *= g4[0]; v[4 * i + 1] *= g4[1]; v[4 * i + 2] *= g4[2]; v[4 * i + 3] *= g4[3]; } }
    float mx = 0.f;
#pragma unroll
    for (int i = 0; i < 64; ++i) mx = fmaxf(mx, fabsf(v[i]));
    red[ks * 32 + nl] = mx;
    __syncthreads();
    float cm = 0.f;
#pragma unroll
    for (int j = 0; j < 16; ++j) cm = fmaxf(cm, red[j * 32 + nl]);
    const float sc = cm > 0.f ? cm * (1.0f / 127.0f) : 1.0f, inv = 1.0f / sc;
    if (ks == 0) wsc[d0 + nl] = sc;
    unsigned char* dst = WT + (size_t)(d0 + nl) * DM + 64 * ks;
#pragma unroll
    for (int q = 0; q < 4; ++q) { u32x4 o;
        o.x = pack_i8x4(v[16 * q] * inv, v[16 * q + 1] * inv, v[16 * q + 2] * inv, v[16 * q + 3] * inv); o.y = pack_i8x4(v[16 * q + 4] * inv, v[16 * q + 5] * inv, v[16 * q + 6] * inv, v[16 * q + 7] * inv);
        o.z = pack_i8x4(v[16 * q + 8] * inv, v[16 * q + 9] * inv, v[16 * q + 10] * inv, v[16 * q + 11] * inv); o.w = pack_i8x4(v[16 * q + 12] * inv, v[16 * q + 13] * inv, v[16 * q + 14] * inv, v[16 * q + 15] * inv);
        *(u32x4*)(dst + 16 * q) = o; }
    __syncthreads();
}
__device__ __forceinline__ void prologue_phase(const Args& args, LAS unsigned char* lds, int vcu, int G, int wave, int lane) {
    unsigned char* ws = args.ws;
    LAS float* scr = (LAS float*)(lds + wave * 16384);
    const int gw = vcu * NWAVES + wave, NGW = G * NWAVES;
    constexpr int I0 = 0  , I1 = 512, I4 = 256, I5 = 512, I6 = 256, I7 = 0, I8 = 256  , I9 = 8  ;
    constexpr int E0 = I0, E1 = E0 + 3 * I1, E4 = E1 + I4, E5 = E4 + I5, E6 = E5 + I6, E7 = E6 + NEXP * I7, E8 = E7 + NEXP * I8, E9 = E8 + 16 * I9;
    for (int it = gw; it < E9; it += NGW) {
        if (it < E0) { win_absmax_item((const float*)args.in[I_W_IN], (unsigned*)(ws + WS_CTL) + CW_WMAX, it, lane); continue; }
        if (it < E1) { const int r = it - E0, w = r / I1; const float* src = (const float*)args.in[w == 0 ? I_W_LRU_O : (w == 1 ? I_W_ATTN_O : I_W_OUT)];
            bf16* dst = (bf16*)(ws + (w == 0 ? WS_WLRUO : (w == 1 ? WS_WATTNO : WS_WOUT))); transpose_item<0>(src, DM, DM, dst, 0, nullptr, scr, r % I1, lane); continue; }
        if (it < E4) { transpose_item<0>((const float*)args.in[I_W_CQ], DM, 512, (bf16*)(ws + WS_WCQ), 0, (const float*)args.in[I_NORM_CX], scr, it - E1, lane); continue; }
        if (it < E5) { transpose_item<0>((const float*)args.in[I_W_CKV], DM, DM, (bf16*)(ws + WS_WCKV), 0, nullptr, scr, it - E4, lane); continue; }
        if (it < E6) { transpose_item<0>((const float*)args.in[I_W_CO], 512, DM, (bf16*)(ws + WS_WCO), 0, nullptr, scr, it - E5, lane); continue; }
        if (it < E7) { const int r = it - E6, e = r / I7; gu_absmax_item((const float*)args.in[I_W_GATE_UP] + (size_t)e * DM * 1024, (const float*)args.in[I_NORM_FFN], (unsigned*)(ws + WS_CTL) + CW_WMAX2 + e * 1024, r % I7, lane); continue; }
        if (it < E8) { const int r = it - E7, e = r / I8; transpose_item<0>((const float*)args.in[I_W_DOWN] + (size_t)e * EFF * DM, EFF, DM, (bf16*)(ws + WS_WDN) + (size_t)e * DM * EFF, 0, nullptr, scr, r % I8, lane); continue; }
        { const int r = it - E8, blk = r / (2 * I9), which = (r / I9) & 1; const float* src = (const float*)args.in[which ? I_LRU_WX : I_LRU_WA] + (size_t)blk * 128 * 128;
          transpose_item<0>(src, 128, 128, (bf16*)(ws + WS_WLRU) + (size_t)blk * 256 * 128, which * 128, nullptr, scr, r % I9, lane); }
    }
    { const float* wg = (const float*)args.in[I_W_GROUP]; const float* wr_ = (const float*)args.in[I_W_ROUTER]; const float* gf = (const float*)args.in[I_NORM_FFN]; bf16* dst = (bf16*)(ws + WS_WRT);
      for (int idx = gw * 64 + lane; idx < 256 * DM; idx += NGW * 64) { const int n = idx >> 10, k = idx & 1023; float v = 0.f;
          if (n < 4) v = wg[k * 4 + n] * gf[k]; else if (n < 36) v = wr_[k * 32 + (n - 4)] * gf[k];
          dst[idx] = (bf16)(cvt_pk_bf16(v, 0.f) & 0xffffu); } }
    { const int* pos = (const int*)args.in[I_POS]; float* rope = (float*)(ws + WS_ROPE);
      for (int idx = gw * 64 + lane; idx < MTOK * 8; idx += NGW * 64) { const int row = idx >> 3, i = idx & 7;
          const float invf = expf(-13.122363377404328f * (float)i * 0.125f); float sn, cs; sincosf((float)pos[row] * invf, &sn, &cs);
          rope[(size_t)row * 16 + i] = cs; rope[(size_t)row * 16 + 8 + i] = sn; } }
    for (int m = gw; m < MTOK; m += 2 * NGW) {
        rms_row_to_i8((const float*)args.in[I_X] + (size_t)m * DM, (const float*)args.in[I_NORM_MIX], ws + WS_XN + (size_t)m * DM, (float*)(ws + WS_XS) + m, lane);
        if (m + NGW < MTOK) rms_row_to_i8((const float*)args.in[I_X] + (size_t)(m + NGW) * DM, (const float*)args.in[I_NORM_MIX], ws + WS_XN + (size_t)(m + NGW) * DM, (float*)(ws + WS_XS) + m + NGW, lane); }
    for (int m = gw; m < MEMROWS; m += NGW) rms_row_to_bf16((const float*)args.in[I_MEM] + (size_t)m * DM, (const float*)args.in[I_NORM_MEM], (bf16*)(ws + WS_MEMN) + (size_t)m * DM, lane);
}

__device__ __forceinline__ void qk16_process(const bf16* p, bf16* po, const float (&g)[16], const float (&cs)[8], const float (&sn)[8], int lane) {
    const u32x4 w0 = *(const u32x4*)p, w1 = *(const u32x4*)(p + 8);
    float v[16] = { bflo(w0.x), bfhi(w0.x), bflo(w0.y), bfhi(w0.y), bflo(w0.z), bfhi(w0.z), bflo(w0.w), bfhi(w0.w), bflo(w1.x), bfhi(w1.x), bflo(w1.y), bfhi(w1.y), bflo(w1.z), bfhi(w1.z), bflo(w1.w), bfhi(w1.w) };
    float ss = 0.f;
#pragma unroll
    for (int d = 0; d < 16; ++d) ss += v[d] * v[d];
    ss += __shfl_xor(ss, 1); ss += __shfl_xor(ss, 2);
    const float rstd = rsqrtf(ss * (1.f / 64.f) + EPS);
#pragma unroll
    for (int d = 0; d < 16; ++d) v[d] = v[d] * rstd * g[d];
    if ((lane & 3) == 0) {
#pragma unroll
        for (int i = 0; i < 8; ++i) { const float x1 = v[i], x2 = v[8 + i]; v[i] = x1 * cs[i] - x2 * sn[i]; v[8 + i] = x2 * cs[i] + x1 * sn[i]; } }
    u32x4 o0, o1; o0.x = cvt_pk_bf16(v[0], v[1]); o0.y = cvt_pk_bf16(v[2], v[3]); o0.z = cvt_pk_bf16(v[4], v[5]); o0.w = cvt_pk_bf16(v[6], v[7]);
    o1.x = cvt_pk_bf16(v[8], v[9]); o1.y = cvt_pk_bf16(v[10], v[11]); o1.z = cvt_pk_bf16(v[12], v[13]); o1.w = cvt_pk_bf16(v[14], v[15]);
    *(u32x4*)po = o0; *(u32x4*)(po + 8) = o1;
}
__device__ __forceinline__ void qknorm_phase(const bf16* Q, const bf16* Kb, bf16* Qo, bf16* Ko, const int* pos, const float* qg, const float* kg, int gw, int NGW, int lane) {
    float gq[16], gk[16];
#pragma unroll
    for (int d = 0; d < 16; ++d) { gq[d] = qg[16 * (lane & 3) + d] * (0.125f * LOG2E); gk[d] = kg[16 * (lane & 3) + d]; }
    const float invf = expf(-13.122363377404328f * (float)(lane & 7) * 0.125f);
    for (int row = gw; row < MTOK; row += NGW) {
        const float ang = (float)pos[row] * invf; float s_, c_; sincosf(ang, &s_, &c_);
        float cs[8], sn[8];
#pragma unroll
        for (int i = 0; i < 8; ++i) { cs[i] = __uint_as_float(__builtin_amdgcn_readlane(__float_as_uint(c_), i)); sn[i] = __uint_as_float(__builtin_amdgcn_readlane(__float_as_uint(s_), i)); }
        qk16_process(Q + (size_t)row * DM + 16 * lane, Qo + (size_t)row * DM + 16 * lane, gq, cs, sn, lane);
        qk16_process(Kb + (size_t)row * DM + 16 * lane, Ko + (size_t)row * DM + 16 * lane, gk, cs, sn, lane);
    }
}
__device__ __forceinline__ void headnorm128_phase(const bf16* X, bf16* Xo, int pitch, int nrows, const float* g, float scale, int gw, int NGW, int lane) {
    float gg[8];
#pragma unroll
    for (int e = 0; e < 8; ++e) gg[e] = g[8 * (lane & 15) + e] * scale;
    for (int row = gw; row < nrows; row += NGW) {
        const bf16* p = X + (size_t)row * pitch + 8 * lane; const u32x4 w = *(const u32x4*)p;
        float v[8] = { bflo(w.x), bfhi(w.x), bflo(w.y), bfhi(w.y), bflo(w.z), bfhi(w.z), bflo(w.w), bfhi(w.w) };
        float ss = 0.f;
#pragma unroll
        for (int e = 0; e < 8; ++e) ss += v[e] * v[e];
        ss += __shfl_xor(ss, 1); ss += __shfl_xor(ss, 2); ss += __shfl_xor(ss, 4); ss += __shfl_xor(ss, 8);
        const float rstd = rsqrtf(ss * (1.f / 128.f) + EPS);
        u32x4 o; o.x = cvt_pk_bf16(v[0] * rstd * gg[0], v[1] * rstd * gg[1]); o.y = cvt_pk_bf16(v[2] * rstd * gg[2], v[3] * rstd * gg[3]);
        o.z = cvt_pk_bf16(v[4] * rstd * gg[4], v[5] * rstd * gg[5]); o.w = cvt_pk_bf16(v[6] * rstd * gg[6], v[7] * rstd * gg[7]);
        *(u32x4*)(Xo + (size_t)row * pitch + 8 * lane) = o;
    }
}

constexpr int LRU_RAW = 0, LRU_RAWP = 528  , LRU_XC = 128 * LRU_RAWP, LRU_XCP = 272, LRU_GG = LRU_XC + 64 * 272, LRU_GGP = 144, LRU_UT = LRU_GG + 2 * 64 * 144;
static_assert(LRU_UT + 64 * 144 <= RING_BYTES, "LRU LDS map");
__device__ __forceinline__ float dpp_shr(float v, float old, int n) {
    const int o = __float_as_int(old), s = __float_as_int(v); int r;
    switch (n) { case 1: r = __builtin_amdgcn_update_dpp(o, s, 0x111, 0xf, 0xf, false); break; case 2: r = __builtin_amdgcn_update_dpp(o, s, 0x112, 0xf, 0xf, false); break;
                 case 4: r = __builtin_amdgcn_update_dpp(o, s, 0x114, 0xf, 0xf, false); break; default: r = __builtin_amdgcn_update_dpp(o, s, 0x118, 0xf, 0xf, false); break; }
    return __int_as_float(r);
}
__device__ __forceinline__ void lru_phase(const Args& args, LAS unsigned char* lds, int vcu, int G) {
    unsigned char* ws = args.ws;
    const int tid = threadIdx.x, lane = tid & 63, wid = __builtin_amdgcn_readfirstlane(tid >> 6), j16 = lane & 15, g4 = lane >> 4;
    const bf16* LIN = (const bf16*)(ws + WS_LIN); const bf16* GGb = (const bf16*)(ws + WS_GG); bf16* U = (bf16*)(ws + WS_U);
    const float* convw = (const float*)args.in[I_CONV_W]; const float* convb = (const float*)args.in[I_CONV_B];
    for (int unit = vcu; unit < NB * 16; unit += G) {
        const int b = unit >> 4, n = (unit >> 1) & 7, hh = unit & 1;
        const int cg = tid & 15;
        float cw[4][8], cb[8];
#pragma unroll
        for (int e = 0; e < 8; ++e) { cb[e] = convb[128 * n + 8 * cg + e];
#pragma unroll
            for (int k = 0; k < 4; ++k) cw[k][e] = convw[k * DM + 128 * n + 8 * cg + e]; }
        bf16x8 wf[4];
        { const int i = j16, grp = i >> 2, chl = (grp >> 1) * 4 + (i & 3), iswx = grp & 1, col = iswx * 128 + 64 * hh + 8 * wid + chl;
          const bf16* wp = (const bf16*)(ws + WS_WLRU) + ((size_t)n * 256 + col) * 128 + 8 * g4;
#pragma unroll
          for (int ks = 0; ks < 4; ++ks) wf[ks] = *(const bf16x8*)(wp + 32 * ks); }
        const int chl0 = 8 * wid + 4 * (g4 >> 1) + 2 * (g4 & 1);
        const int chg0 = 128 * n + 64 * hh + chl0;
        float ba[2], bx[2], sp8[2];
#pragma unroll
        for (int q = 0; q < 2; ++q) { ba[q] = ((const float*)args.in[I_LRU_BA])[chg0 + q]; bx[q] = ((const float*)args.in[I_LRU_BX])[chg0 + q];
            const float lam = ((const float*)args.in[I_LRU_LAMBDA])[chg0 + q]; sp8[q] = 8.0f * log1pf(expf(-lam)); }
        float hprev[2] = {0.f, 0.f};
        const size_t rowbase = (size_t)b * SEQ;
        const int lrow[2] = { tid >> 4, (tid + 512) >> 4 }, lpc = tid & 15;
        const int grow = tid >> 3, gpc = tid & 7, grho = (grow & 3) * 16 + (grow >> 2);
        u32x4 rl[2], rg;
#define LRU_FILL(row_, pc_, w_) do { LAS unsigned char* d_ = lds + LRU_RAW + (row_) * LRU_RAWP + (pc_) * 16; \
            *(LAS f32x4*)d_ = (f32x4){bflo((w_).x), bfhi((w_).x), bflo((w_).y), bfhi((w_).y)}; *(LAS f32x4*)(d_ + 256) = (f32x4){bflo((w_).z), bfhi((w_).z), bflo((w_).w), bfhi((w_).w)}; } while (0)
        if (tid < 3 * 32) *(LAS u32x4*)(lds + LRU_RAW + (125 + tid / 32) * LRU_RAWP + (tid & 31) * 16) = (u32x4){0u, 0u, 0u, 0u};
#pragma unroll
        for (int i = 0; i < 2; ++i) rl[i] = *(const u32x4*)(LIN + (rowbase + lrow[i]) * DM + 128 * n + 8 * lpc);
        rg = *(const u32x4*)(GGb + (rowbase + grow) * DM + 128 * n + 64 * hh + 8 * gpc);
#pragma unroll
        for (int i = 0; i < 2; ++i) LRU_FILL(lrow[i], lpc, rl[i]);
        *(LAS u32x4*)(lds + LRU_GG + grho * LRU_GGP + gpc * 16) = rg;
#pragma unroll
        for (int i = 0; i < 2; ++i) rl[i] = *(const u32x4*)(LIN + (rowbase + 64 + lrow[i]) * DM + 128 * n + 8 * lpc);
        rg = *(const u32x4*)(GGb + (rowbase + 64 + grow) * DM + 128 * n + 64 * hh + 8 * gpc);
        __syncthreads();
        for (int it = 0; it < SEQ / 64; ++it) {
            const int t0 = 64 * it;
#pragma unroll
            for (int i = 0; i < 2; ++i) { const int t = (tid >> 4) + 32 * i; f32x2 a2[4];
#pragma unroll
                for (int e = 0; e < 4; ++e) a2[e] = (f32x2){cb[2 * e], cb[2 * e + 1]};
#pragma unroll
                for (int k = 0; k < 4; ++k) { const int rr = (t0 + t - 3 + k) & 127; const LAS unsigned char* rp_ = lds + LRU_RAW + rr * LRU_RAWP + cg * 16;
                    const f32x4 xa = *(const LAS f32x4*)rp_, xb4 = *(const LAS f32x4*)(rp_ + 256);
                    a2[0] = __builtin_elementwise_fma((f32x2){cw[k][0], cw[k][1]}, (f32x2){xa.x, xa.y}, a2[0]); a2[1] = __builtin_elementwise_fma((f32x2){cw[k][2], cw[k][3]}, (f32x2){xa.z, xa.w}, a2[1]);
                    a2[2] = __builtin_elementwise_fma((f32x2){cw[k][4], cw[k][5]}, (f32x2){xb4.x, xb4.y}, a2[2]); a2[3] = __builtin_elementwise_fma((f32x2){cw[k][6], cw[k][7]}, (f32x2){xb4.z, xb4.w}, a2[3]); }
                u32x4 o; o.x = cvt_pk_bf16(a2[0].x, a2[0].y); o.y = cvt_pk_bf16(a2[1].x, a2[1].y); o.z = cvt_pk_bf16(a2[2].x, a2[2].y); o.w = cvt_pk_bf16(a2[3].x, a2[3].y);
                const int rho = (t & 3) * 16 + (t >> 2);
                *(LAS u32x4*)(lds + LRU_XC + rho * LRU_XCP + cg * 16) = o; }
            __syncthreads();
            if (it + 1 < SEQ / 64) {
#pragma unroll
                for (int i = 0; i < 2; ++i) LRU_FILL((t0 + 64 + lrow[i]) & 127, lpc, rl[i]);
                *(LAS u32x4*)(lds + LRU_GG + ((it + 1) & 1) * 64 * LRU_GGP + grho * LRU_GGP + gpc * 16) = rg;
                if (it + 2 < SEQ / 64) {
#pragma unroll
                    for (int i = 0; i < 2; ++i) rl[i] = *(const u32x4*)(LIN + (rowbase + t0 + 128 + lrow[i]) * DM + 128 * n + 8 * lpc);
                    rg = *(const u32x4*)(GGb + (rowbase + t0 + 128 + grow) * DM + 128 * n + 64 * hh + 8 * gpc); } }
            f32x4 acc[4];
#pragma unroll
            for (int tb = 0; tb < 4; ++tb) { acc[tb] = (f32x4){0.f, 0.f, 0.f, 0.f};
#pragma unroll
                for (int ks = 0; ks < 4; ++ks) { const bf16x8 xf = *(const LAS bf16x8*)(lds + LRU_XC + (tb * 16 + j16) * LRU_XCP + (32 * ks + 8 * g4) * 2);
                    acc[tb] = __builtin_amdgcn_mfma_f32_16x16x32_bf16(wf[ks], xf, acc[tb], 0, 0, 0); } }
            float pr[4][2], pi[4][2];
#pragma unroll
            for (int tb = 0; tb < 4; ++tb)
#pragma unroll
                for (int q = 0; q < 2; ++q) {
                    const auto sw_ = __builtin_amdgcn_permlane16_swap(__float_as_uint(acc[tb][q]), __float_as_uint(acc[tb][2 + q]), false, false);
                    pr[tb][q] = __uint_as_float(sw_[0]); pi[tb][q] = __uint_as_float(sw_[1]); }
            const LAS unsigned char* ggp = lds + LRU_GG + (it & 1) * 64 * LRU_GGP;
            unsigned uo[4];
            f32x2 hq2[4];
            { const f32x2 ba2 = (f32x2){ba[0], ba[1]}, bx2 = (f32x2){bx[0], bx[1]}, nsp2 = (f32x2){-sp8[0], -sp8[1]};
              f32x2 a2v[4], bb2[4];
#pragma unroll
              for (int tb = 0; tb < 4; ++tb) {
                  const f32x2 zr = ((f32x2){pr[tb][0], pr[tb][1]} + ba2) * (-LOG2E), zi = ((f32x2){pi[tb][0], pi[tb][1]} + bx2) * (-LOG2E);
                  const f32x2 er = (f32x2){fast_exp2(zr.x), fast_exp2(zr.y)} + 1.0f, ei = (f32x2){fast_exp2(zi.x), fast_exp2(zi.y)} + 1.0f;
                  const f32x2 r = (f32x2){fast_rcp(er.x), fast_rcp(er.y)}, ig = (f32x2){fast_rcp(ei.x), fast_rcp(ei.y)};
                  const f32x2 la = nsp2 * r, lal = la * LOG2E, x2v = la + la;
                  const f32x2 av = (f32x2){fast_exp2(lal.x), fast_exp2(lal.y)}; a2v[tb] = av;
                  f32x2 pe = x2v * 0.0013888889f + 0.0083333338f; pe = pe * x2v + 0.041666668f; pe = pe * x2v + 0.16666667f; pe = pe * x2v + 0.5f; pe = pe * x2v + 1.0f;
                  f32x2 emv = -x2v * pe;
                  if (__builtin_amdgcn_ballot_w64(fminf(x2v.x, x2v.y) <= -0.25f) != 0ull) { const f32x2 dv = 1.0f - av * av;
                      emv.x = x2v.x > -0.25f ? emv.x : dv.x; emv.y = x2v.y > -0.25f ? emv.y : dv.y; }
                  const f32x2 coef = (f32x2){__builtin_amdgcn_sqrtf(emv.x), __builtin_amdgcn_sqrtf(emv.y)};
                  const unsigned xw = *(const LAS unsigned*)(lds + LRU_XC + (tb * 16 + j16) * LRU_XCP + (64 * hh + chl0) * 2);
                  bb2[tb] = coef * ig * (f32x2){bflo(xw), bfhi(xw)}; }
              f32x2 A = a2v[0], H = bb2[0];
#pragma unroll
              for (int tb = 1; tb < 4; ++tb) { H = __builtin_elementwise_fma(a2v[tb], H, bb2[tb]); A = A * a2v[tb]; }
#pragma unroll
              for (int sft = 1; sft < 16; sft <<= 1) { const f32x2 As = (f32x2){dpp_shr(A.x, 1.0f, sft), dpp_shr(A.y, 1.0f, sft)}, Hs = (f32x2){dpp_shr(H.x, 0.0f, sft), dpp_shr(H.y, 0.0f, sft)};
                  H = __builtin_elementwise_fma(A, Hs, H); A = A * As; }
              const f32x2 Aex = (f32x2){dpp_shr(A.x, 1.0f, 1), dpp_shr(A.y, 1.0f, 1)}, Hex = (f32x2){dpp_shr(H.x, 0.0f, 1), dpp_shr(H.y, 0.0f, 1)};
              f32x2 h = __builtin_elementwise_fma(Aex, (f32x2){hprev[0], hprev[1]}, Hex);
#pragma unroll
              for (int tb = 0; tb < 4; ++tb) { h = __builtin_elementwise_fma(a2v[tb], h, bb2[tb]); hq2[tb] = h; }
              hprev[0] = __shfl(h.x, (lane & 48) | 15); hprev[1] = __shfl(h.y, (lane & 48) | 15);
            }
#pragma unroll
            for (int tb = 0; tb < 4; ++tb) { const unsigned gw2 = *(const LAS unsigned*)(ggp + (tb * 16 + j16) * LRU_GGP + chl0 * 2);
                const f32x2 gv = (f32x2){bflo(gw2), bfhi(gw2)};
                const f32x2 uu = (gv + (gv * gv * gv) * 0.044715f) * (-2.0f * 0.7978845608028654f * LOG2E);
                const f32x2 den = (f32x2){fast_exp2(uu.x), fast_exp2(uu.y)} + 1.0f;
                const f32x2 outv = hq2[tb] * gv * (f32x2){fast_rcp(den.x), fast_rcp(den.y)};
                uo[tb] = cvt_pk_bf16(outv.x, outv.y);
                *(LAS unsigned*)(lds + LRU_UT + (tb * 16 + j16) * LRU_GGP + chl0 * 2) = uo[tb]; }
            __syncthreads();
            { const u32x4 v = *(const LAS u32x4*)(lds + LRU_UT + grho * LRU_GGP + gpc * 16);
              *(u32x4*)(U + (rowbase + t0 + grow) * DM + 128 * n + 64 * hh + 8 * gpc) = v; }
        }
        __syncthreads();
    }
}

constexpr int AT_SLOT = 32768, AT_V = 16384, AT_STG = 3 * AT_SLOT;
static_assert(AT_STG + 8 * 4096 <= RING_BYTES, "attention LDS map");
__device__ __forceinline__ void glds16(const void* gsrc, unsigned lds_dst) { unsigned keep;
    asm volatile("s_mov_b32 %0, m0\n\ts_mov_b32 m0, %2\n\ts_nop 0\n\tglobal_load_lds_dwordx4 %1, off\n\ts_mov_b32 m0, %0" : "=&s"(keep) : "v"(gsrc), "s"(lds_dst) : "memory"); }
__device__ __forceinline__ int crow(int r, int hi) { return (r & 3) + 8 * (r >> 2) + 4 * hi; }
typedef short v4i16_t __attribute__((ext_vector_type(4)));
__device__ __forceinline__ s16x4 vtr(const LAS unsigned char* p) { return __builtin_bit_cast(s16x4, __builtin_amdgcn_ds_read_tr16_b64_v4i16((LAS v4i16_t*)p)); }

template <int K> __device__ __forceinline__ float swz_xor(float v) { return __int_as_float(__builtin_amdgcn_ds_swizzle(__float_as_int(v), (K << 10) | 0x1f)); }
__device__ __forceinline__ float xor32_sum(float v) { auto rr = __builtin_amdgcn_permlane32_swap(__float_as_uint(v), __float_as_uint(v), false, false); return __uint_as_float(rr[0]) + __uint_as_float(rr[1]); }
template <int NMAP>
__device__ __forceinline__ void attn_unit(LAS unsigned char* ldsb, const bf16* Qw  , int pitchQ,
                                          const bf16* Kp, int pitchK, const bf16* Vp, int pitchV, int NT, int ntv,
                                          bf16* Ow, int pitchO, float cref, float lam, const float* subln, float oscale, const float* qgain = nullptr, float qscale = 1.0f) {
    int tid = threadIdx.x; asm volatile("" : "+v"(tid));
    const int lane = tid & 63, r32 = lane & 31, hi = lane >> 5; const int wid = __builtin_amdgcn_readfirstlane(tid >> 6);
    const unsigned lds0 = (unsigned)(size_t)ldsb;
    constexpr int NQR = (NMAP == 2) ? 4 : 8;
    bf16x8 qr[NQR];
#pragma unroll
    for (int j = 0; j < NQR; ++j) qr[j] = *(const bf16x8*)(Qw + (size_t)r32 * pitchQ + 16 * j + 8 * hi);
    if (NMAP == 1 && qgain) {
        float ss = 0.f;
#pragma unroll
        for (int j = 0; j < 8; ++j) { const u32x4 w = __builtin_bit_cast(u32x4, qr[j]);
            ss += bflo(w.x) * bflo(w.x) + bfhi(w.x) * bfhi(w.x) + bflo(w.y) * bflo(w.y) + bfhi(w.y) * bfhi(w.y) + bflo(w.z) * bflo(w.z) + bfhi(w.z) * bfhi(w.z) + bflo(w.w) * bflo(w.w) + bfhi(w.w) * bfhi(w.w); }
        ss = xor32_sum(ss);
        const float rs = rsqrtf(ss * (1.f / 128.f) + EPS) * qscale;
#pragma unroll
        for (int j = 0; j < 8; ++j) { const u32x4 w = __builtin_bit_cast(u32x4, qr[j]); const f32x4 g0 = *(const f32x4*)(qgain + 16 * j + 8 * hi), g1 = *(const f32x4*)(qgain + 16 * j + 8 * hi + 4);
            u32x4 o; o.x = cvt_pk_bf16(bflo(w.x) * rs * g0[0], bfhi(w.x) * rs * g0[1]); o.y = cvt_pk_bf16(bflo(w.y) * rs * g0[2], bfhi(w.y) * rs * g0[3]);
            o.z = cvt_pk_bf16(bflo(w.z) * rs * g1[0], bfhi(w.z) * rs * g1[1]); o.w = cvt_pk_bf16(bflo(w.w) * rs * g1[2], bfhi(w.w) * rs * g1[3]);
            qr[j] = __builtin_bit_cast(bf16x8, o); }
    }
    const LAS unsigned char* qpark = ldsb + AT_STG + wid * 4096 + lane * 16;
    if (NMAP == 2) {
#pragma unroll
        for (int j = 4; j < 8; ++j) { const bf16x8 t_ = *(const bf16x8*)(Qw + (size_t)r32 * pitchQ + 16 * j + 8 * hi); *(LAS bf16x8*)(ldsb + AT_STG + wid * 4096 + lane * 16 + (j - 4) * 1024) = t_; } }
    const bf16* ksrc = Kp + (size_t)lane * pitchK + wid * 8;
    const bf16* vsrc = Vp + (size_t)(16 * (wid & 3) + (lane >> 2)) * pitchV + (wid >> 2) * 32 + (lane & 3) * 8;
#define AT_DMA(t, slot) do { const unsigned _sb = lds0 + (unsigned)(slot) * AT_SLOT; \
        glds16(ksrc + (size_t)(t) * 64 * pitchK, (unsigned)__builtin_amdgcn_readfirstlane(_sb + wid * 1024)); \
        glds16(ksrc + (size_t)(t) * 64 * pitchK + 64, (unsigned)__builtin_amdgcn_readfirstlane(_sb + (wid + 8) * 1024)); \
        glds16(vsrc + (size_t)(t) * 64 * pitchV, (unsigned)__builtin_amdgcn_readfirstlane(_sb + AT_V + wid * 1024)); \
        glds16(vsrc + (size_t)(t) * 64 * pitchV + 64, (unsigned)__builtin_amdgcn_readfirstlane(_sb + AT_V + (wid + 8) * 1024)); } while (0)
    const LAS unsigned char* kp0 = ldsb + hi * 1024 + r32 * 16;
    const LAS unsigned char* vp0 = ldsb + AT_V + ((lane >> 4) & 1) * 32 + (lane & 3) * 8 + (4 * hi + ((lane & 15) >> 2)) * 64;
    f32x16 o[NMAP][4];
#pragma unroll
    for (int m = 0; m < NMAP; ++m)
#pragma unroll
        for (int d = 0; d < 4; ++d) o[m][d] = (f32x16){};
    float lsum[NMAP];
#pragma unroll
    for (int m = 0; m < NMAP; ++m) lsum[m] = 0.f;
    AT_DMA(0, 0);
    if (NT > 1) AT_DMA(1, 1);
    int slot = 0;
#pragma unroll 1
    for (int t = 0; t < NT; ++t) {
        if (t + 1 < NT) asm volatile("s_waitcnt vmcnt(4)" ::: "memory"); else asm volatile("s_waitcnt vmcnt(0)" ::: "memory");
        __builtin_amdgcn_s_barrier(); asm volatile("" ::: "memory");
        if (t + 2 < NT) { const int s2 = slot == 0 ? 2 : slot - 1; AT_DMA(t + 2, s2); }
        if (t < ntv) {
            const LAS unsigned char* kp = kp0 + slot * AT_SLOT; const LAS unsigned char* vp = vp0 + slot * AT_SLOT;
#define AT_SB() __builtin_amdgcn_sched_barrier(0)
#pragma unroll
            for (int m = 0; m < NMAP; ++m) {
                constexpr int JN = 8 / NMAP;
#pragma unroll
                for (int hk = 0; hk < 2; ++hk) {
                    f32x16 p = (f32x16){};
                    bf16x8 kb = *(const LAS bf16x8*)(kp + (m * JN) * 2048 + hk * 512);
                    AT_SB();
#pragma unroll
                    for (int jj = 0; jj < JN; ++jj) { const int j = m * JN + jj; bf16x8 nb = kb;
                        if (jj + 1 < JN) nb = *(const LAS bf16x8*)(kp + (j + 1) * 2048 + hk * 512);
                        const bf16x8 qf = (NMAP == 2 && m == 1) ? *(const LAS bf16x8*)(qpark + jj * 1024) : qr[(NMAP == 2 && m == 1) ? 0 : j];
                        p = __builtin_amdgcn_mfma_f32_32x32x16_bf16(kb, qf, p, 0, 0, 0);
                        AT_SB(); kb = nb; }
                    s16x4 lo = vtr(vp + (2 * hk) * 1024), hh = vtr(vp + (2 * hk) * 1024 + 512);
                    float s = 0.f;
#pragma unroll
                    for (int r = 0; r < 16; ++r) { p[r] = fast_exp2(p[r]); s += p[r]; }
                    lsum[m] += s;
                    u32x4 pw[2];
                    pw[0] = (u32x4){cvt_pk_bf16(p[0], p[1]), cvt_pk_bf16(p[2], p[3]), cvt_pk_bf16(p[4], p[5]), cvt_pk_bf16(p[6], p[7])};
                    pw[1] = (u32x4){cvt_pk_bf16(p[8], p[9]), cvt_pk_bf16(p[10], p[11]), cvt_pk_bf16(p[12], p[13]), cvt_pk_bf16(p[14], p[15])};
                    AT_SB();
#pragma unroll
                    for (int idx = 0; idx < 8; ++idx) { const int d0 = idx >> 1, ksl = idx & 1;
                        const bf16x8 vf = (bf16x8){lo[0], lo[1], lo[2], lo[3], hh[0], hh[1], hh[2], hh[3]};
                        if (idx + 1 < 8) { const int nd0 = (idx + 1) >> 1, nks = 2 * hk + ((idx + 1) & 1); lo = vtr(vp + (nd0 * 4 + nks) * 1024); hh = vtr(vp + (nd0 * 4 + nks) * 1024 + 512); }
                        o[m][d0] = __builtin_amdgcn_mfma_f32_32x32x16_bf16(__builtin_bit_cast(bf16x8, pw[ksl]), vf, o[m][d0], 0, 0, 0);
                        AT_SB(); }
                }
            }
#undef AT_SB
        }
        slot = slot == 2 ? 0 : slot + 1;
    }
#undef AT_DMA
    int hie = hi, r32e = r32, lanee = lane;
    asm volatile("" : "+v"(hie), "+v"(r32e), "+v"(lanee));
    float inv[NMAP];
#pragma unroll
    for (int m = 0; m < NMAP; ++m) { const float l = xor32_sum(lsum[m]); inv[m] = 1.0f / l; }
    float gsub[4];
#pragma unroll
    for (int d0 = 0; d0 < 4; ++d0) gsub[d0] = (NMAP == 2) ? subln[32 * d0 + r32e] * oscale : oscale;
    LAS bf16* stg = (LAS bf16*)(ldsb + AT_STG + wid * 4096);
#pragma unroll
    for (int half = 0; half < 2; ++half) {
#pragma unroll
        for (int rr = 0; rr < 8; ++rr) { const int r = half * 8 + rr; const int orow = crow(r, hie);
            const float i0 = __shfl(inv[0], orow); float val[4];
            if (NMAP == 2) { const float i1 = __shfl(inv[NMAP - 1], orow) * lam; float ss = 0.f;
#pragma unroll
                for (int d0 = 0; d0 < 4; ++d0) { val[d0] = o[0][d0][r] * i0 - o[NMAP - 1][d0][r] * i1; ss += val[d0] * val[d0]; }
                ss += swz_xor<1>(ss); ss += swz_xor<2>(ss); ss += swz_xor<4>(ss); ss += swz_xor<8>(ss); ss += swz_xor<16>(ss);
                const float rstd = rsqrtf(ss * (1.f / 128.f) + EPS);
#pragma unroll
                for (int d0 = 0; d0 < 4; ++d0) val[d0] *= rstd;
            } else {
#pragma unroll
                for (int d0 = 0; d0 < 4; ++d0) val[d0] = o[0][d0][r] * i0; }
#pragma unroll
            for (int d0 = 0; d0 < 4; ++d0) stg[(orow & 15) * 128 + d0 * 32 + r32e] = (bf16)(cvt_pk_bf16(val[d0] * gsub[d0], 0.f) & 0xffffu);
            __builtin_amdgcn_sched_barrier(0); }
        LDS_WAIT();
#pragma unroll
        for (int i = 0; i < 4; ++i) { const int id = i * 64 + lanee, row = id >> 4, ch = id & 15; const u32x4 v = *(const LAS u32x4*)(stg + row * 128 + ch * 8);
            *(u32x4*)(Ow + (size_t)(16 * half + row) * pitchO + ch * 8) = v; }
        LDS_WAIT();
    }
    asm volatile("s_waitcnt lgkmcnt(0)" ::: "memory"); __builtin_amdgcn_s_barrier(); asm volatile("" ::: "memory");
}

__device__ __forceinline__ float softmax_cref(const float* gq, const float* gk, int n, float dotscale, int lane) {
    float a = 0.f, b = 0.f;
    for (int d = lane; d < n; d += 64) { a = fmaxf(a, fabsf(gq[d])); b = fmaxf(b, fabsf(gk[d])); }
    a = wave_max(a); b = wave_max(b);
    return fmaxf(0.f, (float)n * dotscale * a * b * LOG2E - 100.f);
}

#ifndef PROBE_VAR
#define PROBE_VAR 0
#endif
constexpr int A2_KS = 16384, A2_V = 3 * 16384, A2_NV = 5;
static_assert(A2_V + A2_NV * 16384 <= RING_BYTES, "attention LDS map");
#define A2_SB() __builtin_amdgcn_sched_barrier(0)
#define A2_PV(S_, PWA) do { const int s_ = (S_); \
              const bf16x8 vf_ = (bf16x8){vl_[s_ & 1][0], vl_[s_ & 1][1], vl_[s_ & 1][2], vl_[s_ & 1][3], vh_[s_ & 1][0], vh_[s_ & 1][1], vh_[s_ & 1][2], vh_[s_ & 1][3]}; \
              if (s_ + 2 < 16) { const int pc_ = ((s_ + 2) & 3) * 4 + ((s_ + 2) >> 2); vl_[s_ & 1] = vtr(vp_ + pc_ * 1024); vh_[s_ & 1] = vtr(vp_ + pc_ * 1024 + 512); } \
              o[s_ & 3] = __builtin_amdgcn_mfma_f32_32x32x16_bf16(__builtin_bit_cast(bf16x8, PWA[s_ >> 2]), vf_, o[s_ & 3], 0, 0, 0); } while (0)
#define A2_ITER(t, PC0, PC1, PN0, PN1, PW, PWN) do { \
        if ((t) < NT) { \
            if ((t) + 1 < NT) asm volatile("s_waitcnt vmcnt(4)" ::: "memory"); else asm volatile("s_waitcnt vmcnt(0)" ::: "memory"); \
            __builtin_amdgcn_s_barrier(); asm volatile("" ::: "memory"); \
            if ((t) + 2 < NT) { A2_DMA((t) + 2, ((t) + 2) % 3, ((t) + 2) % A2_NV); } \
        } \
        const bool vis_ = (t) < ntv; \
        const LAS unsigned char* kp_ = ldsb + ((t) % 3) * A2_KS; \
        const LAS unsigned char* vp_ = vp0 + (((t) >= 2 ? (t) - 2 : 0) % A2_NV) * 16384; \
        PN0 = (f32x16){}; PN1 = (f32x16){}; \
        bf16x8 kq_[2]; s16x4 vl_[2], vh_[2]; \
        kq_[0] = *(const LAS bf16x8*)(kp_ + kad[0]); kq_[1] = *(const LAS bf16x8*)(kp_ + kad[0] + 8192); \
        _Pragma("unroll") for (int i_ = 0; i_ < 2; ++i_) { vl_[i_] = vtr(vp_ + (i_ * 4) * 1024); vh_[i_] = vtr(vp_ + (i_ * 4) * 1024 + 512); } \
        A2_SB(); \
        _Pragma("unroll") for (int i_ = 0; i_ < 8; ++i_) { \
            { const bf16x8 kf_ = kq_[i_ & 1]; \
              if (i_ + 2 < 8) kq_[i_ & 1] = *(const LAS bf16x8*)(kp_ + kad[(i_ + 2) >> 1] + ((i_ + 2) & 1) * 8192); \
              if (vis_) { if (i_ & 1) PN1 = __builtin_amdgcn_mfma_f32_32x32x16_bf16(kf_, qr[i_ >> 1], PN1, 0, 0, 0); else PN0 = __builtin_amdgcn_mfma_f32_32x32x16_bf16(kf_, qr[i_ >> 1], PN0, 0, 0, 0); } \
              if (i_ == 0) KEEP_AB(PN0, kf_, qr[0]); if (i_ == 1) KEEP_AB(PN1, kf_, qr[0]); } \
            A2_SB(); \
              \
            float e0_ = fast_exp2(PC0[2 * i_]), e1_ = fast_exp2(PC0[2 * i_ + 1]); \
            asm volatile("" : "+v"(e0_), "+v"(e1_)); \
            A2_SB(); \
            A2_PV(2 * i_, PW); \
            A2_SB(); \
            float e2_ = fast_exp2(PC1[2 * i_]), e3_ = fast_exp2(PC1[2 * i_ + 1]); \
            asm volatile("" : "+v"(e2_), "+v"(e3_)); \
            A2_SB(); \
            A2_PV(2 * i_ + 1, PW); \
            A2_SB(); \
            s0 += e0_ + e1_; s1 += e2_ + e3_; asm volatile("" : "+v"(s0), "+v"(s1));        \
            PWN[i_ >> 2][i_ & 3] = cvt_pk_bf16(e0_, e1_); PWN[2 + (i_ >> 2)][i_ & 3] = cvt_pk_bf16(e2_, e3_); \
            A2_SB(); \
        } \
        if (!vis_) { _Pragma("unroll") for (int r_ = 0; r_ < 16; ++r_) { PN0[r_] = -INFINITY; PN1[r_] = -INFINITY; } } \
    } while (0)
template <int VAR>
__device__ __forceinline__ void attn2_unit(LAS unsigned char* ldsb, const bf16* Qw  , const bf16* Kp, const bf16* Vp,
                                           int NT, int ntv, bf16* Ow  , float lam, const float* subln) {
    int tid = threadIdx.x; asm volatile("" : "+v"(tid));
    const int lane = tid & 63, r32 = lane & 31, hi = lane >> 5; const int wid = __builtin_amdgcn_readfirstlane(tid >> 6); const int g = wid & 3, m = wid >> 2;
    const unsigned lds0 = (unsigned)(size_t)ldsb;
    bf16x8 qr[4];
#pragma unroll
    for (int j = 0; j < 4; ++j) qr[j] = *(const bf16x8*)(Qw + (size_t)r32 * DM + 16 * j + 8 * hi);
    asm volatile("s_waitcnt vmcnt(0)" : "+v"(qr[0]), "+v"(qr[1]), "+v"(qr[2]), "+v"(qr[3]) :: "memory");
    const int kkey = 4 * wid + (lane >> 4);
    const bf16* ksrc = Kp + (size_t)kkey * DM + (((lane & 15) ^ (kkey & 15)) << 3);
    const bf16* vsrc = Vp + (size_t)(16 * (wid & 3) + (lane >> 2)) * DM + (wid >> 2) * 32 + (lane & 3) * 8;
#define A2_DMA(t, ks, vs) do { const unsigned _kb = lds0 + (unsigned)(ks) * A2_KS, _vb = lds0 + A2_V + (unsigned)(vs) * 16384; \
        glds16(ksrc + (size_t)(t) * 64 * DM, (unsigned)__builtin_amdgcn_readfirstlane(_kb + wid * 1024)); \
        glds16(ksrc + (size_t)((t) * 64 + 32) * DM, (unsigned)__builtin_amdgcn_readfirstlane(_kb + (wid + 8) * 1024)); \
        glds16(vsrc + (size_t)(t) * 64 * DM, (unsigned)__builtin_amdgcn_readfirstlane(_vb + wid * 1024)); \
        glds16(vsrc + (size_t)(t) * 64 * DM + 64, (unsigned)__builtin_amdgcn_readfirstlane(_vb + (wid + 8) * 1024)); } while (0)
    unsigned kad[4];
#pragma unroll
    for (int jj = 0; jj < 4; ++jj) kad[jj] = (unsigned)(r32 * 256 + ((((8 * m + 2 * jj + hi) ^ (r32 & 15))) << 4));
    const LAS unsigned char* vp0 = ldsb + A2_V + ((lane >> 4) & 1) * 32 + (lane & 3) * 8 + (4 * hi + ((lane & 15) >> 2)) * 64;
    f32x16 o[4];
#pragma unroll
    for (int d = 0; d < 4; ++d) o[d] = (f32x16){};
    float s0 = 0.f, s1 = 0.f;
    u32x4 pwA[4], pwB[4];
#pragma unroll
    for (int i = 0; i < 4; ++i) { pwA[i] = (u32x4){0u, 0u, 0u, 0u}; pwB[i] = (u32x4){0u, 0u, 0u, 0u}; }
    f32x16 pA0, pA1, pB0, pB1;
#pragma unroll
    for (int r = 0; r < 16; ++r) { pA0[r] = -INFINITY; pA1[r] = -INFINITY; pB0[r] = -INFINITY; pB1[r] = -INFINITY; }
    A2_DMA(0, 0, 0);
    if (NT > 1) A2_DMA(1, 1, 1);
#pragma unroll 1
    for (int t = 0; t < NT + 2; t += 2) {
        A2_ITER(t,     pA0, pA1, pB0, pB1, pwA, pwB);
        A2_ITER(t + 1, pB0, pB1, pA0, pA1, pwB, pwA);
    }
#undef A2_DMA
    asm volatile("s_waitcnt lgkmcnt(0)" ::: "memory"); __builtin_amdgcn_s_barrier(); asm volatile("" ::: "memory");
    int tid2 = threadIdx.x; asm volatile("" : "+v"(tid2));
    const int lanee = tid2 & 63, r32e = lanee & 31, hie = lanee >> 5;
    const float inv = 1.0f / xor32_sum(s0 + s1);
    LAS float* exch = (LAS float*)(ldsb + g * 16384) + lanee;
    if (m == 1) {
#pragma unroll
        for (int r = 0; r < 16; ++r) { const float ir = __shfl(inv, crow(r, hie)) * lam;
#pragma unroll
            for (int d0 = 0; d0 < 4; ++d0) exch[(d0 * 16 + r) * 64] = o[d0][r] * ir; }
    }
    asm volatile("s_waitcnt lgkmcnt(0)" ::: "memory"); __builtin_amdgcn_s_barrier(); asm volatile("" ::: "memory");
    if (m == 0) {
        float gsub[4];
#pragma unroll
        for (int d0 = 0; d0 < 4; ++d0) gsub[d0] = subln[32 * d0 + r32e] * 0.8f;
        LAS bf16* stg = (LAS bf16*)(ldsb + 65536 + g * 4096);
#pragma unroll
        for (int half = 0; half < 2; ++half) {
#pragma unroll
            for (int rr = 0; rr < 8; ++rr) { const int r = half * 8 + rr; const int orow = crow(r, hie);
                const float i0 = __shfl(inv, orow); float val[4]; float ss = 0.f;
#pragma unroll
                for (int d0 = 0; d0 < 4; ++d0) { val[d0] = o[d0][r] * i0 - exch[(d0 * 16 + r) * 64]; ss += val[d0] * val[d0]; }
                ss += swz_xor<1>(ss); ss += swz_xor<2>(ss); ss += swz_xor<4>(ss); ss += swz_xor<8>(ss); ss += swz_xor<16>(ss);
                const float rstd = rsqrtf(ss * (1.f / 128.f) + EPS);
#pragma unroll
                for (int d0 = 0; d0 < 4; ++d0) stg[(orow & 15) * 128 + d0 * 32 + r32e] = (bf16)(cvt_pk_bf16(val[d0] * rstd * gsub[d0], 0.f) & 0xffffu);
                __builtin_amdgcn_sched_barrier(0); }
            LDS_WAIT();
#pragma unroll
            for (int i = 0; i < 4; ++i) { const int id = i * 64 + lanee, row = id >> 4, ch = id & 15; const u32x4 v = *(const LAS u32x4*)(stg + row * 128 + ch * 8);
                *(u32x4*)(Ow + (size_t)(16 * half + row) * DM + ch * 8) = v; }
            LDS_WAIT();
        }
    }
    asm volatile("s_waitcnt lgkmcnt(0)" ::: "memory"); __builtin_amdgcn_s_barrier(); asm volatile("" ::: "memory");
}
__device__ __forceinline__ void diffattn_phase(const Args& args, LAS unsigned char* lds, int vcu, int G, bf16* Oreal, bf16* Odmy, int nrep) {
    unsigned char* ws = args.ws;
    const int lane = threadIdx.x & 63, wid = __builtin_amdgcn_readfirstlane(threadIdx.x >> 6), g = wid & 3, m = wid >> 2;
    const bf16* Q = (const bf16*)(ws + WS_Q); const bf16* Kb = (const bf16*)(ws + WS_K); const bf16* Vb = (const bf16*)(ws + WS_V);
    float lam;
    { const float a = ((const float*)args.in[I_LQ1])[lane] * ((const float*)args.in[I_LK1])[lane], b = ((const float*)args.in[I_LQ2])[lane] * ((const float*)args.in[I_LK2])[lane];
      lam = expf(wave_sum(a)) - expf(wave_sum(b)) + 0.2f; lam = __uint_as_float(__builtin_amdgcn_readfirstlane(__float_as_uint(lam))); }
    for (int pp = vcu; pp < nrep * NB * 8 * 16; pp += G) {
        const int p = pp & 2047; bf16* O = (pp >> 11) ? Odmy : Oreal;
        const int bh = p >> 4, s = p & 15, b = bh >> 3, h = bh & 7;
#pragma unroll 1
        for (int half = 0; half < 2; ++half) {
            const int qb = half ? 31 - s : s;
            const size_t row0 = (size_t)b * SEQ + 128 * qb + 32 * g;
            if ((pp >> 11) == 0)
            attn2_unit<0>(lds, Q + row0 * DM + h * 128 + m * 64, Kb + (size_t)b * SEQ * DM + h * 128, Vb + (size_t)b * SEQ * DM + h * 128,
                       2 * qb + 2, 2 * qb + (g >> 1) + 1, O + row0 * DM + h * 128, lam, (const float*)args.in[I_SUBLN]);
#if PROBE_VAR
            else
            attn2_unit<PROBE_VAR>(lds, Q + row0 * DM + h * 128 + m * 64, Kb + (size_t)b * SEQ * DM + h * 128, Vb + (size_t)b * SEQ * DM + h * 128,
                       2 * qb + 2, 2 * qb + (g >> 1) + 1, O + row0 * DM + h * 128, lam, (const float*)args.in[I_SUBLN]);
#endif
        }
    }
}
__device__ __forceinline__ void crossattn_phase(const Args& args, LAS unsigned char* lds, int vcu, int G) {
    unsigned char* ws = args.ws;
    const int lane = threadIdx.x & 63, wid = __builtin_amdgcn_readfirstlane(threadIdx.x >> 6);
    const bf16* QC = (const bf16*)(ws + WS_QC); const bf16* KV = (const bf16*)(ws + WS_KVC); bf16* OC = (bf16*)(ws + WS_OC);
    const float cref = softmax_cref((const float*)args.in[I_CQ_NORM], (const float*)args.in[I_CK_NORM], 128, 0.08838834764831845f, lane);
#pragma unroll 1
    for (int p = vcu; p < NB * 4 * 16; p += G) {
        const int b = p >> 6, h = (p >> 4) & 3, qb = p & 15;
        const size_t row0 = (size_t)b * SEQ + 256 * qb + 32 * wid;
        attn_unit<1>(lds, QC + row0 * 512 + h * 128, 512, KV + (size_t)b * MEMTOK * DM + h * 128, DM, KV + (size_t)b * MEMTOK * DM + 512 + h * 128, DM,
                     4, 4, OC + row0 * 512 + h * 128, 512, cref, 0.f, nullptr, 1.0f, (const float*)args.in[I_CQ_NORM], 0.08838834764831845f * LOG2E);
    }
}

template <class Sched>
__device__ __forceinline__ void router_select(const Args& args, LAS unsigned char* lds, const Sched& S) {
    unsigned char* ws = args.ws;
    const int tid = threadIdx.x;
    LAS int* cnt_l = (LAS int*)lds; LAS int* base_l = cnt_l + 64;
    const float* logit = (const float*)(ws + WS_LOGIT); const float* rss = (const float*)(ws + WS_RSS2);
    float* rstd2 = (float*)(ws + WS_RSTD2); float* wts = (float*)(ws + WS_WTS); int* idx = (int*)(ws + WS_IDX); int* asg = (int*)(ws + WS_ASG); unsigned* gcnt = (unsigned*)(ws + WS_CTL) + CW_CNT;
    const float* bg = (const float*)args.in[I_B_GROUP]; const float* br = (const float*)args.in[I_B_ROUTER];
    VM_WAIT(); __syncthreads();
    __builtin_amdgcn_fence(__ATOMIC_ACQUIRE, "agent"); VM_WAIT();
    pg8::Unit u;
    for (int i = 0; S.next(i, u); ++i) {
        if (tid < 64) cnt_l[tid] = 0;
        __syncthreads();
        int row = 0, b0 = 0, b1 = 0, rk0 = 0, rk1 = 0; float w0 = 0.f, w1 = 0.f;
        if (tid < 256) {
            row = u.pm * 256 + tid;
            const f32x4* p = (const f32x4*)(rss + (size_t)row * 16); const f32x4 s0 = p[0], s1 = p[1], s2 = p[2], s3 = p[3];
            const float ss = ((s0[0] + s0[1]) + (s0[2] + s0[3])) + ((s1[0] + s1[1]) + (s1[2] + s1[3])) + ((s2[0] + s2[1]) + (s2[2] + s2[3])) + ((s3[0] + s3[1]) + (s3[2] + s3[3]));
            const float rstd = rsqrtf(ss * (1.0f / DM) + EPS); rstd2[row] = rstd;
            { const f32x4* q = (const f32x4*)((const float*)(ws + WS_RSS1) + (size_t)row * 16); const f32x4 m0 = q[0], m1 = q[1], m2 = q[2], m3 = q[3];
              const float mx = fmaxf(fmaxf(fmaxf(fmaxf(m0[0], m0[1]), fmaxf(m0[2], m0[3])), fmaxf(fmaxf(m1[0], m1[1]), fmaxf(m1[2], m1[3]))), fmaxf(fmaxf(fmaxf(m2[0], m2[1]), fmaxf(m2[2], m2[3])), fmaxf(fmaxf(m3[0], m3[1]), fmaxf(m3[2], m3[3]))));
              const float sc = mx > 0.f ? mx * (1.0f / 127.0f) : 1.0f; ((float*)(ws + WS_XS2))[row] = sc; ((LAS float*)(lds + 1024))[tid] = 1.0f / sc; }
            const f32x4* lp = (const f32x4*)(logit + (size_t)row * 64);
            const f32x4 gl4 = lp[0];
            float gl[4]; int gi = 0;
#pragma unroll
            for (int j = 0; j < 4; ++j) gl[j] = gl4[j] * rstd + bg[j];
            float gm = gl[0];
#pragma unroll
            for (int j = 1; j < 4; ++j) if (gl[j] > gm) { gm = gl[j]; gi = j; }
            float den = 0.f;
#pragma unroll
            for (int j = 0; j < 4; ++j) den += expf(gl[j] - gm);
            const float gval = 1.0f / den;
            const f32x4 e0 = lp[1 + 2 * gi], e1 = lp[2 + 2 * gi];
            float el[8];
#pragma unroll
            for (int j = 0; j < 4; ++j) { el[j] = e0[j] * rstd + br[gi * 8 + j]; el[4 + j] = e1[j] * rstd + br[gi * 8 + 4 + j]; }
            int i0 = 0; float v0 = el[0];
#pragma unroll
            for (int j = 1; j < 8; ++j) if (el[j] > v0) { v0 = el[j]; i0 = j; }
            int i1 = -1; float v1 = -INFINITY;
#pragma unroll
            for (int j = 0; j < 8; ++j) if (j != i0 && el[j] > v1) { v1 = el[j]; i1 = j; }
            const float ex = expf(v1 - v0); w0 = gval / (1.0f + ex); w1 = gval * ex / (1.0f + ex);
            b0 = gi * 8 + i0; b1 = 32 + gi * 8 + i1;
            rk0 = atomicAdd((int*)&cnt_l[b0], 1); rk1 = atomicAdd((int*)&cnt_l[b1], 1);
        }
        __syncthreads();
        if (tid < 64) base_l[tid] = (int)__hip_atomic_fetch_add(gcnt + tid, (unsigned)cnt_l[tid], __ATOMIC_RELAXED, __HIP_MEMORY_SCOPE_AGENT);
        __syncthreads();
        {
          const bf16* xb = (const bf16*)(ws + WS_X2B) + (size_t)u.pm * 256 * DM; unsigned char* xq = ws + WS_X2Q + (size_t)u.pm * 256 * DM; const LAS float* invs = (const LAS float*)(lds + 1024);
          for (int p = tid; p < 256 * 64; p += NWAVES * 64) { const int r = p >> 6, c = (p & 63) * 16; const float inv = invs[r];
              const u32x4 a = *(const u32x4*)(xb + (size_t)r * DM + c), b = *(const u32x4*)(xb + (size_t)r * DM + c + 8);
              u32x4 o; o.x = pack_i8x4(bflo(a.x) * inv, bfhi(a.x) * inv, bflo(a.y) * inv, bfhi(a.y) * inv); o.y = pack_i8x4(bflo(a.z) * inv, bfhi(a.z) * inv, bflo(a.w) * inv, bfhi(a.w) * inv);
              o.z = pack_i8x4(bflo(b.x) * inv, bfhi(b.x) * inv, bflo(b.y) * inv, bfhi(b.y) * inv); o.w = pack_i8x4(bflo(b.z) * inv, bfhi(b.z) * inv, bflo(b.w) * inv, bfhi(b.w) * inv);
              *(u32x4*)(xq + (size_t)r * DM + c) = o; } }
        if (tid < 256) { idx[(size_t)b0 * MTOK + base_l[b0] + rk0] = row; idx[(size_t)b1 * MTOK + base_l[b1] + rk1] = row; wts[(size_t)row * 2] = w0; wts[(size_t)row * 2 + 1] = w1;
            asg[(size_t)row * 2] = (b0 << 20) | (base_l[b0] + rk0); asg[(size_t)row * 2 + 1] = (b1 << 20) | (base_l[b1] + rk1); }
        __syncthreads();
    }
}
__device__ __forceinline__ void moe_tables(const Args& args, LAS int* pblk, LAS int* cntl) {
    const unsigned* gcnt = (const unsigned*)(args.ws + WS_CTL) + CW_CNT;
    if (threadIdx.x < 64) cntl[threadIdx.x] = (int)__hip_atomic_load(gcnt + threadIdx.x, __ATOMIC_RELAXED, __HIP_MEMORY_SCOPE_AGENT);
    __syncthreads();
    if (threadIdx.x == 0) { int acc = 0; for (int j = 0; j < 64; ++j) { pblk[j] = acc; acc += (cntl[j] + 255) >> 8; } pblk[64] = acc;
        LAS int* cst = cntl + 64; int a2 = 0; for (int j = 0; j < 64; ++j) { if (j == 32) a2 = 0; cst[j] = a2; a2 += cntl[j]; } }
    __syncthreads();
}

__device__ __forceinline__ void moe_combine_phase(const Args& args, const LAS int* cst, int gw, int NGW, int lane) {
    unsigned char* ws = args.ws;
    const bf16* x2b = (const bf16*)(ws + WS_X2B); const bf16* y0 = (const bf16*)(ws + WS_S0); const bf16* y1 = (const bf16*)(ws + WS_S4);
    const float* wts = (const float*)(ws + WS_WTS); const int* asg = (const int*)(ws + WS_ASG);
    int2 an[2]; float2 wn[2];
#pragma unroll
    for (int t = 0; t < 2; ++t) { const int tk = gw + t * NGW; const bool ok = tk < MTOK; an[t] = ok ? *(const int2*)(asg + (size_t)tk * 2) : make_int2(0, 0); wn[t] = ok ? *(const float2*)(wts + (size_t)tk * 2) : make_float2(0.f, 0.f); }
    for (int tok = gw; tok < MTOK; tok += 2 * NGW) {
        int2 ac[2]; float2 wc2[2];
#pragma unroll
        for (int t = 0; t < 2; ++t) { ac[t] = an[t]; wc2[t] = wn[t]; }
#pragma unroll
        for (int t = 0; t < 2; ++t) { const int tk = tok + (2 + t) * NGW; const bool ok = tk < MTOK; an[t] = ok ? *(const int2*)(asg + (size_t)tk * 2) : make_int2(0, 0); wn[t] = ok ? *(const float2*)(wts + (size_t)tk * 2) : make_float2(0.f, 0.f); }
        u32x2 xv[2][4], p[2][4], q[2][4];
#pragma unroll
        for (int t = 0; t < 2; ++t) { const int tk = tok + t * NGW; if (tk < MTOK) {
            const size_t r0 = (size_t)(cst[ac[t].x >> 20] + (ac[t].x & 0xfffff)), r1 = (size_t)(cst[ac[t].y >> 20] + (ac[t].y & 0xfffff));
#pragma unroll
            for (int k = 0; k < 4; ++k) { const int c = 4 * lane + 256 * k;
                xv[t][k] = *(const u32x2*)(x2b + (size_t)tk * DM + c); p[t][k] = *(const u32x2*)(y0 + r0 * DM + c); q[t][k] = *(const u32x2*)(y1 + r1 * DM + c); } } }
#pragma unroll
        for (int t = 0; t < 2; ++t) { const int tk = tok + t * NGW; if (tk < MTOK) { const float w0 = wc2[t].x, w1 = wc2[t].y;
#pragma unroll
            for (int k = 0; k < 4; ++k) { const int c = 4 * lane + 256 * k; const u32x2 X = xv[t][k], P = p[t][k], Q = q[t][k]; f32x4 o;
                o[0] = bflo(X.x) + w0 * bflo(P.x) + w1 * bflo(Q.x); o[1] = bfhi(X.x) + w0 * bfhi(P.x) + w1 * bfhi(Q.x); o[2] = bflo(X.y) + w0 * bflo(P.y) + w1 * bflo(Q.y); o[3] = bfhi(X.y) + w0 * bfhi(P.y) + w1 * bfhi(Q.y);
                __builtin_nontemporal_store(o, (f32x4*)(args.out + (size_t)tk * DM + c)); } } }
    }
}

constexpr int N_PHASES = 17;
__global__ void __launch_bounds__(NWAVES * 64, 2) fwd_kernel(Args args) {
    extern __shared__ __attribute__((aligned(16))) unsigned char lds_raw[];
    LAS unsigned char* lds = (LAS unsigned char*)lds_raw;
    volatile LAS unsigned* MISC = (volatile LAS unsigned*)(lds + MISC_OFF);
    const int tid = threadIdx.x, lane = tid & 63, wave = __builtin_amdgcn_readfirstlane(tid >> 6);
    const int G = gridDim.x; const int bx = blockIdx.x; const int vcu = (G % 8 == 0) ? (bx % 8) * (G / 8) + bx / 8 : bx;
    const int gw = vcu * NWAVES + wave, NGW = G * NWAVES;
    unsigned char* ws = args.ws;
    for (int u = tid; u < (LDS_BYTES - MISC_OFF) / 4; u += NWAVES * 64) MISC[u] = 0u;
    __syncthreads();
    const int lo = args.ph_lo, hi = args.ph_hi;
    XcdBarrier bar; bar.bar = (unsigned*)(ws + WS_CTL) + CW_BAR + args.li * XCD_BAR_WORDS; bar.x = 0; bar.st = nullptr;
    bar = xcd_barrier_post((unsigned*)(ws + WS_CTL) + CW_BAR + args.li * XCD_BAR_WORDS, MISC);
    LAS int* pblk = (LAS int*)(lds + MISC_OFF + 64); LAS int* cntl = pblk + 72;
#ifndef PH_MASK
#define PH_MASK 0x1ffff
#endif
#define IN(k) (((PH_MASK >> (k)) & 1) && lo <= (k) && (k) < hi)
#define SEAM(k) do { if (IN(k) && IN((k) + 1)) xcd_barrier(bar); } while (0)
    using namespace pg8;

#ifndef PROBE_DUP
#define PROBE_DUP 0
#endif
#define REPS(k) (1 + ((PROBE_DUP >> (k)) & 1))
    unsigned char* const dmyA = ws + WS_QC;
    if (IN(0)) { _Pragma("unroll") for (int rep = 0; rep < REPS(0); ++rep) prologue_phase(args, lds, vcu, G, wave, lane);
        xcd_barrier(bar);
        if (G >= 128 && bx < 64) {
            DenseOrder S; S.init(ws + WS_MEMN, ws + WS_WCKV, MEMROWS, DM, DM, 64, bx);
            EpiAct E{(bf16*)(ws + WS_KVC), 0, 0, DM, nullptr, nullptr};
            gemm_phase<EpiAct, DenseOrder, true, false>(lds, DM, S, E);
        } else {
          const bool split = G >= 128; const int qw = split ? bx - 64 : bx, QW = split ? G - 64 : G;
          LAS float* red = (LAS float*)lds; LAS float* gain_l = (LAS float*)(lds + 4096);
          for (int k = tid; k < DM; k += NWAVES * 64) gain_l[k] = ((const float*)args.in[I_NORM_FFN])[k];
          __syncthreads();
          for (int it = qw; it < NWIN / 32 + NEXP * 32; it += QW) {
              if (it < NWIN / 32) colquant_wg_item((const float*)args.in[I_W_IN], NWIN, 32 * it, win_dest(32 * it), nullptr, ws + WS_WIN, (float*)(ws + WS_WSC), red, tid);
              else { const int r = it - NWIN / 32, e = r >> 5, nb = r & 31;
                  colquant_wg_item((const float*)args.in[I_W_GATE_UP] + (size_t)e * DM * 1024, 1024, 32 * nb, gu_dest(32 * nb), gain_l, ws + WS_WGU + (size_t)e * 1024 * DM, (float*)(ws + WS_WSC2) + e * 1024, red, tid); } }
          if (!split) { DenseOrder S; S.init(ws + WS_MEMN, ws + WS_WCKV, MEMROWS, DM, DM, G, bx);
            EpiAct E{(bf16*)(ws + WS_KVC), 0, 0, DM, nullptr, nullptr};
            gemm_phase<EpiAct, DenseOrder, true, false>(lds, DM, S, E); }
        }
        SEAM(0); }

    if (IN(1)) {
        _Pragma("unroll") for (int rep = 0; rep < REPS(1); ++rep)
        { DenseOrder S; S.init(ws + WS_XN, ws + WS_WIN, MTOK, 2048, DM / 2, G, bx);
          EpiAct E{(bf16*)(ws + WS_LIN), SLOT_ELEMS, 0, DM, (const float*)(ws + WS_XS), (const float*)(ws + WS_WSC)};
          gemm_phase<EpiAct, DenseOrder, true, false, true>(lds, DM / 2, S, E); }
        SEAM(1);
#ifdef PROBE_BARRIERS
        for (int q_ = 0; q_ < 8; ++q_) xcd_barrier(bar);
#endif
    }
    if (IN(2)) {
        headnorm128_phase((const bf16*)(ws + WS_KVC), (bf16*)(ws + WS_KVC), DM, MEMROWS, (const float*)args.in[I_CK_NORM], 1.0f, gw, NGW, lane);
        _Pragma("unroll") for (int rep = 0; rep < REPS(2); ++rep) lru_phase(args, lds, vcu, G);
        SEAM(2);
    }
    if (IN(3)) {
        _Pragma("unroll") for (int rep = 0; rep < REPS(3); ++rep) {
        DenseOrder S; S.init(ws + WS_XN, ws + WS_WIN + (size_t)2048 * DM, MTOK, 5120, DM / 2, G, bx);
        EpiQKV E{(bf16*)(ws + WS_Q), SLOT_ELEMS, (const float*)(ws + WS_XS), (const float*)(ws + WS_WSC) + 2048, (const float*)args.in[I_Q_NORM], (const float*)args.in[I_K_NORM], (const float*)(ws + WS_ROPE), 0.125f * LOG2E, ws + WS_SG8};
        gemm_phase<EpiQKV, DenseOrder, true, false, true>(lds, DM / 2, S, E); }
        if (IN(3) && IN(5)) xcd_barrier(bar);
    }
    if (IN(5)) { diffattn_phase(args, lds, vcu, G, (bf16*)(ws + WS_Q), (bf16*)dmyA, REPS(5)); SEAM(5); }
    if (IN(7)) {
        _Pragma("unroll") for (int rep = 0; rep < REPS(7); ++rep) {
        PairOrder S; S.nM = MTOK / 256; S.nN = DM / 256; S.ntile = S.nM * S.nN; S.G = G; S.c = bx; S.tstep = (size_t)256 * DM * 2;
        S.A0 = (const char*)(ws + WS_U); S.B0 = (const char*)(ws + WS_WLRUO); S.A1 = (const char*)(ws + WS_Q); S.B1 = (const char*)(ws + WS_WATTNO);
        EpiMix E{ws + WS_SG8, ws + WS_SG8 + (size_t)MTOK * DM, (bf16*)(ws + WS_MIX)};
        gemm_phase<EpiMix, PairOrder, true, false, false, true>(lds, DM, S, E); }
        SEAM(7);
    }
    if (IN(8)) {
        _Pragma("unroll") for (int rep = 0; rep < REPS(8); ++rep) {
        DenseOrder S; S.init(ws + WS_MIX, ws + WS_WOUT, MTOK, DM, DM, G, bx);
        EpiResid<true> E{args.in[I_X], (bf16*)(ws + WS_X1B), (float*)(ws + WS_RSS1), nullptr};
        gemm_phase<EpiResid<true>, DenseOrder, true, false>(lds, DM, S, E); }
        SEAM(8);
    }
    if (IN(9)) {
        _Pragma("unroll") for (int rep = 0; rep < REPS(9); ++rep) {
        DenseOrder S; S.init(ws + WS_X1B, ws + WS_WCQ, MTOK, 512, DM, G, bx);
        EpiRowScale E{(bf16*)(ws + WS_QC), 512, (const float*)(ws + WS_RSS1)};
        gemm_phase<EpiRowScale, DenseOrder, true, false>(lds, DM, S, E); }
        if (IN(9) && IN(11)) xcd_barrier(bar);
    }
    if (IN(11)) { _Pragma("unroll") for (int rep = 0; rep < REPS(11); ++rep) crossattn_phase(args, lds, vcu, G); SEAM(11); }
    if (IN(12)) {
        _Pragma("unroll") for (int rep = 0; rep < REPS(12); ++rep) {
        DenseOrder S; S.init(ws + WS_OC, ws + WS_WCO, MTOK, DM, 512, G, bx);
        EpiResid<false> E{ws + WS_X1B, (bf16*)(ws + WS_X2B), (float*)(ws + WS_RSS2), (float*)(ws + WS_RSS1)};
        gemm_phase<EpiResid<false>, DenseOrder, true, false>(lds, 512, S, E); }
        SEAM(12);
    }
    if (IN(13)) {
        DenseOrder S; S.init(ws + WS_X2B, ws + WS_WRT, MTOK, 256, DM, G, bx);
        EpiLogit E{(float*)(ws + WS_LOGIT)};
        gemm_phase<EpiLogit, DenseOrder, true, false>(lds, DM, S, E);
        router_select(args, lds, S);
        SEAM(13);
    }
    if (IN(14)) {
        moe_tables(args, pblk, cntl);
        _Pragma("unroll") for (int rep = 0; rep < REPS(14); ++rep) {
        MoeOrder S{pblk, cntl, 0, 0, G, bx, DM / 2, 1, (const char*)(ws + WS_X2Q), (const char*)(ws + WS_WGU), (size_t)1024 * DM, (const int*)(ws + WS_IDX), 0};
        S.rb_hi = pblk[64];
        EpiGateUp E{(bf16*)(ws + WS_H), (const float*)(ws + WS_RSTD2), (const float*)(ws + WS_XS2), (const float*)(ws + WS_WSC2)};
        gemm_phase<EpiGateUp, MoeOrder, true, true, true>(lds, DM / 2, S, E); }
        SEAM(14);
    }
    if (IN(15)) {
        moe_tables(args, pblk, cntl);
        _Pragma("unroll") for (int rep = 0; rep < REPS(15); ++rep) {
        MoeOrder S{pblk, cntl, 0, 0, G, bx, EFF, 0, (const char*)(ws + WS_H), (const char*)(ws + WS_WDN), (size_t)DM * EFF * 2, (const int*)(ws + WS_IDX), 0};
        S.rb_lo = pblk[0]; S.rb_hi = pblk[64];
        EpiY E{(bf16*)(ws + WS_S0), (bf16*)(ws + WS_S4)};
        gemm_phase<EpiY, MoeOrder, true, false>(lds, EFF, S, E); }
        SEAM(15);
    }
    if (IN(16)) {
        moe_tables(args, pblk, cntl);
        _Pragma("unroll") for (int rep = 0; rep < REPS(16); ++rep) moe_combine_phase(args, cntl + 64, gw, NGW, lane);
    }
#undef REPS
#undef IN
#undef SEAM
}

#ifndef MK_CUTS
#define MK_CUTS 1
#endif
extern "C" void kernel_launch(void* const* d_in, const int* in_sizes, int n_in, void* d_out, int out_size, void* d_ws, size_t ws_size, hipStream_t stream) {
    static int grid = 0;
    if (grid == 0) {
        if (n_in != 36 || out_size != MTOK * DM || ws_size < WS_END) { fprintf(stderr, "kernel_launch: unexpected shapes / workspace (n_in %d out %d ws %zu, need %zu)\n", n_in, out_size, ws_size, (size_t)WS_END); grid = -1; return; }
        int dev = 0, cus = 0, per_cu = 0;
        if (hipGetDevice(&dev) != hipSuccess || hipDeviceGetAttribute(&cus, hipDeviceAttributeMultiprocessorCount, dev) != hipSuccess) { grid = -1; return; }
        if (hipFuncSetAttribute((const void*)fwd_kernel, hipFuncAttributeMaxDynamicSharedMemorySize, LDS_BYTES) != hipSuccess) { fprintf(stderr, "kernel_launch: hipFuncSetAttribute failed\n"); grid = -1; return; }
        if (hipOccupancyMaxActiveBlocksPerMultiprocessor(&per_cu, (const void*)fwd_kernel, NWAVES * 64, LDS_BYTES) != hipSuccess || per_cu < 1) { fprintf(stderr, "kernel_launch: occupancy query says %d blocks per CU\n", per_cu); }
        (void)hipGetLastError();
        grid = cus;
    }
    if (grid < 0) return;
    (void)hipMemsetAsync((char*)d_ws + WS_CTL, 0, CTL_ZERO_BYTES, stream);
    Args a{};
    for (int i = 0; i < 36; ++i) a.in[i] = d_in[i];
    a.out = (float*)d_out; a.ws = (unsigned char*)d_ws;
    constexpr int NL = MK_CUTS;
    for (int li = 0; li < NL; ++li) {
        a.ph_lo = (li * N_PHASES) / NL; a.ph_hi = ((li + 1) * N_PHASES) / NL; a.li = li;
        hipLaunchKernelGGL(fwd_kernel, dim3(grid), dim3(NWAVES * 64), LDS_BYTES, stream, a);
    }
}
```

```cpp
#include <hip/hip_runtime.h>
#include <cstdio>
#include <cstdint>
#include <cmath>

#define GAS __attribute__((address_space(1)))
#define LAS __attribute__((address_space(3)))
typedef unsigned short bf16;
typedef short bf16x8 __attribute__((ext_vector_type(8)));
typedef short s16x4 __attribute__((ext_vector_type(4)));
typedef float f32x2 __attribute__((ext_vector_type(2)));
typedef float f32x4 __attribute__((ext_vector_type(4)));
typedef float f32x16 __attribute__((ext_vector_type(16)));
typedef unsigned u32x2 __attribute__((ext_vector_type(2)));
typedef unsigned u32x4 __attribute__((ext_vector_type(4)));

constexpr int NB = 16, SEQ = 4096, DM = 1024, MTOK = NB * SEQ;
constexpr int NWIN = 7168;
constexpr int MEMTOK = 256, MEMROWS = NB * MEMTOK;
constexpr int NEXP = 32, EFF = 512;
constexpr float EPS = 1e-6f;
constexpr float LOG2E = 1.4426950408889634f;
constexpr int NWAVES = 8;

constexpr size_t MiB = 1u << 20;
constexpr size_t WS_CTL = 0, CTL_ZERO_BYTES = 1 * MiB;
constexpr size_t WS_WIN = 2 * MiB;
constexpr size_t WS_WLRUO = 16 * MiB, WS_WATTNO = 18 * MiB, WS_WOUT = 20 * MiB;
constexpr size_t WS_WCQ = 22 * MiB;
constexpr size_t WS_WCKV = 23 * MiB;
constexpr size_t WS_WCO = 25 * MiB;
constexpr size_t WS_WRT = 26 * MiB;
constexpr size_t WS_WLRU = 26 * MiB + 512 * 1024;
constexpr size_t WS_WGU = 27 * MiB;
constexpr size_t WS_WDN = 91 * MiB;
constexpr size_t WS_S0 = 128 * MiB, WS_S1 = 256 * MiB, WS_S2 = 384 * MiB, WS_S3 = 512 * MiB, WS_S4 = 640 * MiB;
constexpr size_t WS_MEMN = 768 * MiB;
constexpr size_t WS_KVC = 776 * MiB;
constexpr size_t WS_QC = 784 * MiB;
constexpr size_t WS_OC = 848 * MiB;
constexpr size_t WS_IDX = 912 * MiB;
constexpr size_t WS_WTS = 928 * MiB;
constexpr size_t WS_RSS1 = 929 * MiB;
constexpr size_t WS_RSS2 = 933 * MiB;
constexpr size_t WS_RSTD2 = 937 * MiB;
constexpr size_t WS_XS = 937 * MiB + 256 * 1024;
constexpr size_t WS_WSC = 937 * MiB + 512 * 1024;
constexpr size_t WS_LOGIT = 938 * MiB;
constexpr size_t WS_ROPE = 954 * MiB;
constexpr size_t WS_XS2 = 958 * MiB + 512 * 1024;
constexpr size_t WS_WSC2 = 958 * MiB + 768 * 1024;
constexpr size_t WS_ASG = 958 * MiB;
constexpr size_t WS_END = 959 * MiB;
constexpr size_t WS_XN = WS_S0, WS_MIX = WS_S0, WS_LIN = WS_S1, WS_Q = WS_S1, WS_X2B = WS_S1, WS_GG = WS_S2, WS_K = WS_S2, WS_SGL = WS_S2,
                 WS_H = WS_S2, WS_V = WS_S3, WS_SGA = WS_S3, WS_U = WS_S4, WS_X1B = WS_S4;
constexpr size_t WS_X2Q = WS_S0;
constexpr size_t WS_SG8 = WS_QC;
constexpr size_t SLOT_ELEMS = (WS_S2 - WS_S1) / 2;
constexpr int CW_CNT = 1024;
constexpr int CW_WMAX2 = 139264;
constexpr int CW_WMAX = 131072;
constexpr int CW_BAR = 4096;
constexpr int MAX_LAUNCHES = 24;

constexpr int RING_BYTES = 131072;
constexpr int MISC_OFF = RING_BYTES;
constexpr int LDS_BYTES = 147456;

__device__ __forceinline__ unsigned cvt_pk_bf16(float lo, float hi) { unsigned r; asm volatile("v_cvt_pk_bf16_f32 %0, %1, %2" : "=v"(r) : "v"(lo), "v"(hi)); return r; }
__device__ __forceinline__ float bflo(unsigned w) { return __uint_as_float(w << 16); }
__device__ __forceinline__ float bfhi(unsigned w) { return __uint_as_float(w & 0xffff0000u); }
__device__ __forceinline__ float bf2f(bf16 h) { return __uint_as_float((unsigned)h << 16); }
__device__ __forceinline__ float fast_exp2(float x) { return __builtin_amdgcn_exp2f(x); }
__device__ __forceinline__ float fast_rcp(float x) { return __builtin_amdgcn_rcpf(x); }
__device__ __forceinline__ float sigmoid_f(float v) { return fast_rcp(1.0f + fast_exp2(-LOG2E * v)); }
__device__ __forceinline__ float gelu_tanh_f(float v) { const float u = v + 0.044715f * v * v * v; return v * fast_rcp(1.0f + fast_exp2(-2.0f * 0.7978845608028654f * LOG2E * u)); }
__device__ __forceinline__ float wave_sum(float v) {
#pragma unroll
    for (int o = 1; o < 64; o <<= 1) v += __shfl_xor(v, o);
    return v;
}
__device__ __forceinline__ float wave_max(float v) {
#pragma unroll
    for (int o = 1; o < 64; o <<= 1) v = fmaxf(v, __shfl_xor(v, o));
    return v;
}
#define LDS_WAIT() asm volatile("s_waitcnt lgkmcnt(0)" ::: "memory")
#define KEEP_AB(r, a, b) asm volatile("" : "+v"(r) : "v"(a), "v"(b))
#define VM_WAIT() asm volatile("s_waitcnt vmcnt(0)" ::: "memory")

namespace pg8 {
constexpr int BM = 256, BK = 64, HALF = 128, HTB = HALF * BK * 2, STAGE_BYTES = 8 * HTB;
__host__ __device__ __forceinline__ int lds_byte(int r, int c) { const int st = (r >> 4) * 2 + (c >> 5), rr = r & 15, cc = c & 31, ob = rr * 64 + cc * 2; return st * 1024 + (ob ^ (((ob >> 9) & 1) << 5)); }
__host__ __device__ __forceinline__ void stage_rc(int b, int& R, int& C) { const int st = b / 1024, sb = b % 1024, swz = sb ^ (((sb >> 9) & 1) << 5); R = (st >> 1) * 16 + swz / 64; C = (st & 1) * 32 + (swz % 64) / 2; }
__host__ __device__ __forceinline__ int perm32(int rho) { const int n = rho >> 4, i = rho & 15; return 8 * (i >> 2) + 4 * n + (i & 3); }

struct Unit { int pm, pn, aux, nvalid, crow0; const char* a; const char* b; const int* rows; };

typedef int v4i32 __attribute__((ext_vector_type(4)));
template <class Epi, class Sched, bool ALIGN_EPI, bool GATHER, bool I8 = false, bool PAIRACC = false>
__device__ __forceinline__ void gemm_phase(LAS unsigned char* lds, const int K, const Sched& S, const Epi& E) {
    const int tid = threadIdx.x, wid = __builtin_amdgcn_readfirstlane(tid >> 6), lane = tid & 63, wr = wid >> 2, wc = wid & 3, fr = lane & 15, fq = lane >> 4;
    const int nt = K / BK;
    unsigned voffA[2][2], nvoffA[2][2], voffB[2]; int RA[2], CA[2];
#pragma unroll
    for (int i = 0; i < 2; ++i) { int R, C; stage_rc(tid * 16 + i * 8192, R, C); const int Rb = Epi::PERM ? ((R & ~31) + perm32(R & 31)) : R;
        RA[i] = R; CA[i] = C; voffB[i] = (unsigned)(Rb * K + C) * 2u;
#pragma unroll
        for (int h = 0; h < 2; ++h) { voffA[h][i] = (unsigned)((R + HALF * h) * K + C) * 2u; nvoffA[h][i] = voffA[h][i]; } }
    const size_t kstep = (size_t)(BK * 2);
    const size_t hstep = (size_t)HALF * K * 2;
    const unsigned ldsw = (unsigned)wid * 1024u;
    const int aoff = lds_byte(wr * 64 + fr, fq * 8), boff = lds_byte(wc * 32 + fr, fq * 8);
#define PG8_SA(b, h) (((b) * 2 + (h)) * HTB)
#define PG8_SB(b, h) ((4 + (b) * 2 + (h)) * HTB)
#define PG8_STAGE_B(bufoff, gbase) do { _Pragma("unroll") for (int _i = 0; _i < 2; ++_i) \
        __builtin_amdgcn_global_load_lds((const unsigned*)((const char*)(gbase) + voffB[_i]), (LAS unsigned*)(lds + (bufoff) + ldsw + _i * 8192), 16, 0, 0); } while (0)
#define PG8_STAGE_A(bufoff, gbase, h, NX) do { _Pragma("unroll") for (int _i = 0; _i < 2; ++_i) { const unsigned _o = (GATHER && (NX)) ? nvoffA[h][_i] : voffA[h][_i]; \
        __builtin_amdgcn_global_load_lds((const unsigned*)((const char*)(gbase) + _o), (LAS unsigned*)(lds + (bufoff) + ldsw + _i * 8192), 16, 0, 0); } } while (0)
#define PG8_LDA(dst, b, h) do { _Pragma("unroll") for (int m = 0; m < 4; ++m) _Pragma("unroll") for (int k = 0; k < 2; ++k) dst[m][k] = *(const LAS bf16x8*)(lds + PG8_SA(b, h) + aoff + m * 2048 + k * 1024); } while (0)
#define PG8_LDB(dst, b, h) do { _Pragma("unroll") for (int n = 0; n < 2; ++n) _Pragma("unroll") for (int k = 0; k < 2; ++k) dst[n][k] = *(const LAS bf16x8*)(lds + PG8_SB(b, h) + boff + n * 2048 + k * 1024); } while (0)
#define PG8_MMA(ai, bj, At, Bt) do { __builtin_amdgcn_s_setprio(1); _Pragma("unroll") for (int m = 0; m < 4; ++m) _Pragma("unroll") for (int n = 0; n < 2; ++n) _Pragma("unroll") for (int k = 0; k < 2; ++k) \
        { if constexpr (I8) acc[ai][bj][m][n] = __builtin_bit_cast(f32x4, __builtin_amdgcn_mfma_i32_16x16x64_i8(__builtin_bit_cast(v4i32, Bt[n][k]), __builtin_bit_cast(v4i32, At[m][k]), __builtin_bit_cast(v4i32, acc[ai][bj][m][n]), 0, 0, 0)); \
          else acc[ai][bj][m][n] = __builtin_amdgcn_mfma_f32_16x16x32_bf16(Bt[n][k], At[m][k], acc[ai][bj][m][n], 0, 0, 0); } __builtin_amdgcn_s_setprio(0); } while (0)
#define PG8_WAIT_V(n) asm volatile("s_waitcnt vmcnt(" #n ")" ::: "memory")
#define PG8_WAIT_L(n) asm volatile("s_waitcnt lgkmcnt(" #n ")" ::: "memory")
#define PG8_BAR __builtin_amdgcn_s_barrier()
#define PG8_SCHED __builtin_amdgcn_sched_barrier(0)
#define PG8_GATHER_OFFS(dst, u) do { _Pragma("unroll") for (int _i = 0; _i < 2; ++_i) _Pragma("unroll") for (int _h = 0; _h < 2; ++_h) { const int _r = RA[_i] + HALF * _h; \
        const int _tok = (_r < (u).nvalid) ? (u).rows[_r] : 0; dst[_h][_i] = (unsigned)(_tok * K + CA[_i]) * 2u; } } while (0)
    Unit cur, nxt; int ui = 0;
    if (!S.next(0, cur)) return;
    if constexpr (GATHER) { PG8_GATHER_OFFS(voffA, cur); }
    f32x4 acc[2][2][4][2];
#pragma unroll
    for (int a = 0; a < 2; ++a)
#pragma unroll
        for (int b = 0; b < 2; ++b)
#pragma unroll
            for (int m = 0; m < 4; ++m)
#pragma unroll
                for (int n = 0; n < 2; ++n) acc[a][b][m][n] = (f32x4){0.f, 0.f, 0.f, 0.f};
    bf16x8 At[4][2], B0[2][2], B1[2][2];
    const char* cA = cur.a; const char* cB = cur.b;
    PG8_STAGE_B(PG8_SB(0, 0), cB); PG8_STAGE_B(PG8_SB(0, 1), cB + hstep); PG8_STAGE_A(PG8_SA(0, 0), cA, 0, false); PG8_STAGE_A(PG8_SA(0, 1), cA, 1, false);
    if (wr == 1) PG8_BAR;
    PG8_WAIT_V(2); PG8_BAR;
    PG8_STAGE_B(PG8_SB(1, 0), cB + kstep); PG8_STAGE_A(PG8_SA(1, 0), cA + kstep, 0, false); PG8_STAGE_B(PG8_SB(1, 1), cB + hstep + kstep);
    PG8_WAIT_V(6); PG8_BAR;
    for (;;) {
        const bool has_next = S.next(ui + 1, nxt);
        if constexpr (GATHER) { if (has_next) { PG8_GATHER_OFFS(nvoffA, nxt); } else {
#pragma unroll
            for (int h = 0; h < 2; ++h)
#pragma unroll
                for (int i = 0; i < 2; ++i) nvoffA[h][i] = voffA[h][i]; } }
        const char* nA = has_next ? nxt.a : cA; const char* nB = has_next ? nxt.b : cB;
        for (int t = 0; t < nt; t += 2) {
            const bool last = (t == nt - 2);
            const char* a1 = cA + (size_t)(t + 1) * kstep;
            const char* a2 = last ? nA : cA + (size_t)(t + 2) * kstep; const char* b2 = last ? nB : cB + (size_t)(t + 2) * kstep;
            const char* a3 = a2 + kstep; const char* b3 = b2 + kstep;
            PG8_LDB(B0, 0, 0); PG8_LDB(B1, 0, 1); PG8_SCHED; PG8_LDA(At, 0, 0); PG8_STAGE_A(PG8_SA(1, 1), a1, 1, false);
            PG8_WAIT_V(8); PG8_WAIT_L(0); PG8_BAR; PG8_MMA(0, 0, At, B0); PG8_MMA(0, 1, At, B1); PG8_BAR; PG8_SCHED;
            PG8_LDA(At, 0, 1); PG8_STAGE_B(PG8_SB(0, 0), b2); PG8_STAGE_B(PG8_SB(0, 1), b2 + hstep); PG8_STAGE_A(PG8_SA(0, 0), a2, 0, last);
            PG8_WAIT_V(8); PG8_WAIT_L(0); PG8_BAR; PG8_MMA(1, 0, At, B0); PG8_MMA(1, 1, At, B1); PG8_BAR; PG8_SCHED;
            PG8_LDB(B0, 1, 0); PG8_LDB(B1, 1, 1); PG8_SCHED; PG8_LDA(At, 1, 0); PG8_STAGE_A(PG8_SA(0, 1), a2, 1, last);
            PG8_WAIT_V(8); PG8_WAIT_L(0); PG8_BAR; PG8_MMA(0, 0, At, B0); PG8_MMA(0, 1, At, B1); PG8_BAR; PG8_SCHED;
            PG8_LDA(At, 1, 1); PG8_STAGE_B(PG8_SB(1, 0), b3); PG8_STAGE_B(PG8_SB(1, 1), b3 + hstep); PG8_STAGE_A(PG8_SA(1, 0), a3, 0, last);
            PG8_WAIT_V(8); PG8_WAIT_L(0); PG8_BAR; PG8_MMA(1, 0, At, B0); PG8_MMA(1, 1, At, B1); PG8_BAR; PG8_SCHED;
        }
        if constexpr (ALIGN_EPI) { if (wr == 0) PG8_BAR; }
        bool keep = false;
        if constexpr (PAIRACC) { if (cur.aux == 0) { E.mid(acc, cur, wr, wc, fr, fq); keep = true; } }
        if (!keep) E(acc, cur, wr, wc, fr, fq);
        if (!has_next) break;
        if (!keep) {
#pragma unroll
        for (int a = 0; a < 2; ++a)
#pragma unroll
            for (int b = 0; b < 2; ++b)
#pragma unroll
                for (int m = 0; m < 4; ++m)
#pragma unroll
                    for (int n = 0; n < 2; ++n) acc[a][b][m][n] = (f32x4){0.f, 0.f, 0.f, 0.f}; }
        cur = nxt; cA = nA; cB = nB; ++ui;
        if constexpr (GATHER) {
#pragma unroll
            for (int h = 0; h < 2; ++h)
#pragma unroll
                for (int i = 0; i < 2; ++i) voffA[h][i] = nvoffA[h][i]; }
        if constexpr (ALIGN_EPI) { if (wr == 1) PG8_BAR; }
    }
    PG8_WAIT_V(0);
    if constexpr (!ALIGN_EPI) { if (wr == 0) PG8_BAR; }
    PG8_BAR;
#undef PG8_SA
#undef PG8_SB
#undef PG8_STAGE_A
#undef PG8_STAGE_B
#undef PG8_LDA
#undef PG8_LDB
#undef PG8_MMA
#undef PG8_WAIT_V
#undef PG8_WAIT_L
#undef PG8_BAR
#undef PG8_SCHED
#undef PG8_GATHER_OFFS
}

constexpr int NXCD = 8, WGM = 8;
struct DenseOrder {
    int nM, nN, nwg, G, c; const char* A; const char* B; size_t tstep;
    __device__ void init(const void* A_, const void* B_, int M, int N, int K, int G_, int c_) { A = (const char*)A_; B = (const char*)B_; nM = M / BM; nN = N / BM; nwg = nM * nN; G = G_; c = c_; tstep = (size_t)BM * K * 2; }
    __device__ bool next(int i, Unit& u) const {
        const long L = (long)i * G + c; if (L >= nwg) return false;
        int wgid = (int)L; { const int q = nwg / NXCD, r = nwg % NXCD, xcd = wgid % NXCD, off = wgid / NXCD; wgid = (xcd < r ? xcd * (q + 1) : r * (q + 1) + (xcd - r) * q) + off; }
        const int nig = WGM * nN, gid = wgid / nig, fm = gid * WGM, gsz = (nM - fm) < WGM ? (nM - fm) : WGM;
        u.pm = fm + ((wgid % nig) % gsz); u.pn = (wgid % nig) / gsz; u.aux = 0; u.nvalid = BM; u.crow0 = 0; u.rows = nullptr;
        u.a = A + (size_t)u.pm * tstep; u.b = B + (size_t)u.pn * tstep; return true;
    }
};
struct PairOrder {
    int nM, nN, ntile, G, c; const char* A0; const char* B0; const char* A1; const char* B1; size_t tstep;
    __device__ bool next(int i, Unit& u) const {
        const long L = (long)(i >> 1) * G + c; if (L >= ntile) return false;
        int wgid = (int)L; { const int q = ntile / NXCD, r = ntile % NXCD, xcd = wgid % NXCD, off = wgid / NXCD; wgid = (xcd < r ? xcd * (q + 1) : r * (q + 1) + (xcd - r) * q) + off; }
        const int nig = WGM * nN, gid = wgid / nig, fm = gid * WGM, gsz = (nM - fm) < WGM ? (nM - fm) : WGM;
        u.pm = fm + ((wgid % nig) % gsz); u.pn = (wgid % nig) / gsz; u.aux = i & 1; u.nvalid = BM; u.crow0 = 0; u.rows = nullptr;
        u.a = ((i & 1) ? A1 : A0) + (size_t)u.pm * tstep; u.b = ((i & 1) ? B1 : B0) + (size_t)u.pn * tstep; return true;
    }
};
struct MoeOrder {
    const LAS int* pblk; const LAS int* cnt; int rb_lo, rb_hi, G, c, K, gather;
    const char* Abase; const char* Wbase; size_t wstride; const int* idx; int kpass;
    __device__ bool next(int i, Unit& u) const {
        const long L = (long)i * G + c; const int rb = rb_lo + (int)(L >> 2);
        if (rb >= rb_hi) return false;
        int bkt = 0;
#pragma unroll
        for (int st = 32; st > 0; st >>= 1) if (pblk[bkt + st] <= rb) bkt += st;
        const int j = rb - pblk[bkt], e = bkt & 31;
        u.pm = rb; u.pn = (int)(L & 3); u.aux = bkt >> 5; const int left = cnt[bkt] - 256 * j; u.nvalid = left < 256 ? left : 256; u.crow0 = gather ? e : cnt[64 + bkt] + 256 * j;
        u.rows = idx + (size_t)bkt * MTOK + 256 * j;
        u.a = gather ? Abase : Abase + (size_t)rb * 256 * K * 2;
        u.b = Wbase + (size_t)e * wstride + (size_t)u.pn * 256 * K * 2;
        return true;
    }
};

struct EpiAct {
    static constexpr bool PERM = true;
    bf16* o0; size_t gstride; int acts; int ldc;
    const float* sa; const float* sb;
    __device__ __forceinline__ void operator()(const f32x4 (&acc)[2][2][4][2], const Unit& u, int wr, int wc, int fr, int fq) const {
        const int grp = (u.pn * BM) >> 10; const int colt = u.pn * BM - (grp << 10);
        bf16* base = o0 + (size_t)grp * gstride; const int act = (acts >> (4 * grp)) & 15;
        const int row0 = u.pm * BM + wr * 64 + fr, col0 = colt + wc * 32 + 8 * fq;
        float sbv[2][8];
        if (sa) {
#pragma unroll
            for (int bj = 0; bj < 2; ++bj) { const f32x4 b0 = *(const f32x4*)(sb + u.pn * BM + bj * HALF + wc * 32 + 8 * fq), b1 = *(const f32x4*)(sb + u.pn * BM + bj * HALF + wc * 32 + 8 * fq + 4);
                sbv[bj][0] = b0[0]; sbv[bj][1] = b0[1]; sbv[bj][2] = b0[2]; sbv[bj][3] = b0[3]; sbv[bj][4] = b1[0]; sbv[bj][5] = b1[1]; sbv[bj][6] = b1[2]; sbv[bj][7] = b1[3]; } }
        float sarv[8];
#pragma unroll
        for (int g = 0; g < 8; ++g) sarv[g] = sa ? sa[row0 + (g >> 2) * HALF + (g & 3) * 16] : 1.0f;
#pragma unroll
        for (int ai = 0; ai < 2; ++ai)
#pragma unroll
            for (int m = 0; m < 4; ++m) { const int row = row0 + ai * HALF + m * 16; bf16* rowp = base + (size_t)row * ldc + col0; const float sar = sarv[ai * 4 + m];
#pragma unroll
                for (int bj = 0; bj < 2; ++bj) { const f32x4 a0 = acc[ai][bj][m][0], a1 = acc[ai][bj][m][1];
                    float v[8] = {a0[0], a0[1], a0[2], a0[3], a1[0], a1[1], a1[2], a1[3]};
                    if (sa) {
#pragma unroll
                        for (int e = 0; e < 8; ++e) v[e] = (float)__float_as_int(v[e]) * (sar * sbv[bj][e]); }
                    if (act == 1) {
#pragma unroll
                        for (int e = 0; e < 8; ++e) v[e] = gelu_tanh_f(v[e]); }
                    else if (act == 2) {
#pragma unroll
                        for (int e = 0; e < 8; ++e) v[e] = sigmoid_f(v[e]); }
                    u32x4 w; w.x = cvt_pk_bf16(v[0], v[1]); w.y = cvt_pk_bf16(v[2], v[3]); w.z = cvt_pk_bf16(v[4], v[5]); w.w = cvt_pk_bf16(v[6], v[7]);
                    *(u32x4*)(rowp + bj * HALF) = w; } }
    }
};
struct EpiQKV {
    static constexpr bool PERM = true;
    bf16* o0; size_t gstride; const float* sa; const float* sb; const float* qg; const float* kg; const float* rope; float qscale; unsigned char* sg8;
    __device__ __forceinline__ void operator()(const f32x4 (&acc)[2][2][4][2], const Unit& u, int wr, int wc, int fr, int fq) const {
        const int grp = (u.pn * BM) >> 10; const int pnl = u.pn & 3;
        bf16* base = o0 + (size_t)grp * gstride;
        const int row0 = u.pm * BM + wr * 64 + fr;
        float sbv[2][8];
#pragma unroll
        for (int bj = 0; bj < 2; ++bj) { const f32x4 b0 = *(const f32x4*)(sb + u.pn * BM + bj * HALF + wc * 32 + 8 * fq), b1 = *(const f32x4*)(sb + u.pn * BM + bj * HALF + wc * 32 + 8 * fq + 4);
            sbv[bj][0] = b0[0]; sbv[bj][1] = b0[1]; sbv[bj][2] = b0[2]; sbv[bj][3] = b0[3]; sbv[bj][4] = b1[0]; sbv[bj][5] = b1[1]; sbv[bj][6] = b1[2]; sbv[bj][7] = b1[3]; }
#define QKV_SARV float sarv[8]; _Pragma("unroll") for (int g = 0; g < 8; ++g) sarv[g] = sa[row0 + (g >> 2) * HALF + (g & 3) * 16]
        if (grp >= 3) { QKV_SARV;
            unsigned char* b8 = sg8 + (size_t)(grp - 3) * ((size_t)MTOK * DM) + ((size_t)(u.pm * 4 + pnl) << 16) + (wr * 4 + wc) * 8192 + (fq * 16 + fr) * 16;
            f32x2 sbn[2][4];
#pragma unroll
            for (int bj = 0; bj < 2; ++bj)
#pragma unroll
                for (int p = 0; p < 4; ++p) sbn[bj][p] = (f32x2){sbv[bj][2 * p], sbv[bj][2 * p + 1]} * (-LOG2E);
#pragma unroll
            for (int ai = 0; ai < 2; ++ai)
#pragma unroll
                for (int m = 0; m < 4; ++m) { const float sar = sarv[ai * 4 + m]; u32x4 w4;
#pragma unroll
                    for (int bj = 0; bj < 2; ++bj) { const f32x4 a0 = acc[ai][bj][m][0], a1 = acc[ai][bj][m][1];
                        const float v[8] = {a0[0], a0[1], a0[2], a0[3], a1[0], a1[1], a1[2], a1[3]};
                        unsigned pw_[4];
#pragma unroll
                        for (int p = 0; p < 4; ++p) {
                            const f32x2 z = (f32x2){(float)__float_as_int(v[2 * p]), (float)__float_as_int(v[2 * p + 1])} * (sbn[bj][p] * sar);
                            const f32x2 d = (f32x2){fast_exp2(z.x), fast_exp2(z.y)} * (1.0f / 255.0f) + (1.0f / 255.0f);
                            const f32x2 qf = (f32x2){fast_rcp(d.x), fast_rcp(d.y)} + 12582912.0f;
                            pw_[p] = __builtin_amdgcn_perm(__float_as_uint(qf.y), __float_as_uint(qf.x), 0x0c0c0400u); }
                        const unsigned lo = __builtin_amdgcn_perm(pw_[1], pw_[0], 0x05040100u), hi = __builtin_amdgcn_perm(pw_[3], pw_[2], 0x05040100u);
                        if (bj == 0) { w4.x = lo; w4.y = hi; } else { w4.z = lo; w4.w = hi; } }
                    *(u32x4*)(b8 + (ai * 4 + m) * 1024) = w4; }
            return;
        }
        if (grp == 2) { QKV_SARV;
            const int col0 = pnl * BM + wc * 32 + 8 * fq;
#pragma unroll
            for (int ai = 0; ai < 2; ++ai)
#pragma unroll
                for (int m = 0; m < 4; ++m) { const int row = row0 + ai * HALF + m * 16; const float sar = sarv[ai * 4 + m]; bf16* rowp = base + (size_t)row * DM + col0;
#pragma unroll
                    for (int bj = 0; bj < 2; ++bj) { const f32x4 a0 = acc[ai][bj][m][0], a1 = acc[ai][bj][m][1];
                        float v[8] = {a0[0], a0[1], a0[2], a0[3], a1[0], a1[1], a1[2], a1[3]};
#pragma unroll
                        for (int e = 0; e < 8; ++e) v[e] = (float)__float_as_int(v[e]) * (sar * sbv[bj][e]);
                        u32x4 w; w.x = cvt_pk_bf16(v[0], v[1]); w.y = cvt_pk_bf16(v[2], v[3]); w.z = cvt_pk_bf16(v[4], v[5]); w.w = cvt_pk_bf16(v[6], v[7]);
                        *(u32x4*)(rowp + bj * HALF) = w; } }
            return;
        }
        const float* gp = grp == 0 ? qg : kg; const float gs = grp == 0 ? qscale : 1.0f;
        float gv[2][8];
#pragma unroll
        for (int bj = 0; bj < 2; ++bj) { const f32x4 g0 = *(const f32x4*)(gp + 32 * bj + 8 * fq), g1 = *(const f32x4*)(gp + 32 * bj + 8 * fq + 4);
            gv[bj][0] = g0[0] * gs; gv[bj][1] = g0[1] * gs; gv[bj][2] = g0[2] * gs; gv[bj][3] = g0[3] * gs; gv[bj][4] = g1[0] * gs; gv[bj][5] = g1[1] * gs; gv[bj][6] = g1[2] * gs; gv[bj][7] = g1[3] * gs; }
        const int colL = (pnl * 4 + wc) * 64 + 8 * fq;
        f32x4 rp[4];
#pragma unroll
        for (int q = 0; q < 4; ++q) rp[q] = *(const f32x4*)(rope + (size_t)row0 * 16 + 4 * q);
        float sarn = sa[row0];
#pragma unroll
        for (int ai = 0; ai < 2; ++ai)
#pragma unroll
            for (int m = 0; m < 4; ++m) { const int row = row0 + ai * HALF + m * 16; const float sar = sarn;
                const int gi = ai * 4 + m;
                float y[2][8]; float ss = 0.f;
#pragma unroll
                for (int bj = 0; bj < 2; ++bj) { const f32x4 a0 = acc[ai][bj][m][0], a1 = acc[ai][bj][m][1];
                    const float t[8] = {a0[0], a0[1], a0[2], a0[3], a1[0], a1[1], a1[2], a1[3]};
#pragma unroll
                    for (int e = 0; e < 8; ++e) { y[bj][e] = (float)__float_as_int(t[e]) * (sar * sbv[bj][e]); ss += y[bj][e] * y[bj][e]; } }
                ss += __shfl_xor(ss, 16); ss += __shfl_xor(ss, 32);
                const float rstd = rsqrtf(ss * (1.f / 64.f) + EPS);
#pragma unroll
                for (int bj = 0; bj < 2; ++bj)
#pragma unroll
                    for (int e = 0; e < 8; ++e) y[bj][e] *= rstd * gv[bj][e];
                const f32x4 c0 = rp[0], c1 = rp[1], s0 = rp[2], s1 = rp[3];
                const float cs[8] = {c0[0], c0[1], c0[2], c0[3], c1[0], c1[1], c1[2], c1[3]}, sn[8] = {s0[0], s0[1], s0[2], s0[3], s1[0], s1[1], s1[2], s1[3]};
#pragma unroll
                for (int e = 0; e < 8; ++e) { const float px = __shfl_xor(y[0][e], 16);
                    const float r0 = y[0][e] * cs[e] - px * sn[e], r1 = y[0][e] * cs[e] + px * sn[e];
                    y[0][e] = fq == 0 ? r0 : (fq == 1 ? r1 : y[0][e]); }
                if (gi < 7) { const int rown = row0 + ((gi + 1) >> 2) * HALF + ((gi + 1) & 3) * 16;
#pragma unroll
                    for (int q = 0; q < 4; ++q) rp[q] = *(const f32x4*)(rope + (size_t)rown * 16 + 4 * q);
                    sarn = sa[rown]; }
                bf16* rowp = base + (size_t)row * DM + colL;
#pragma unroll
                for (int bj = 0; bj < 2; ++bj) { u32x4 w; w.x = cvt_pk_bf16(y[bj][0], y[bj][1]); w.y = cvt_pk_bf16(y[bj][2], y[bj][3]); w.z = cvt_pk_bf16(y[bj][4], y[bj][5]); w.w = cvt_pk_bf16(y[bj][6], y[bj][7]);
                    *(u32x4*)(rowp + 32 * bj) = w; } }
#undef QKV_SARV
    }
};
struct EpiRowScale {
    static constexpr bool PERM = true;
    bf16* out; int ldc; const float* rss;
    __device__ __forceinline__ void operator()(const f32x4 (&acc)[2][2][4][2], const Unit& u, int wr, int wc, int fr, int fq) const {
        const int row0 = u.pm * BM + wr * 64 + fr, col0 = u.pn * BM + wc * 32 + 8 * fq;
        float rstdv[8];
#pragma unroll
        for (int g = 0; g < 8; ++g) { const f32x4* p = (const f32x4*)(rss + (size_t)(row0 + (g >> 2) * HALF + (g & 3) * 16) * 16);
            const f32x4 s0 = p[0], s1 = p[1], s2 = p[2], s3 = p[3];
            const float ss = ((s0[0] + s0[1]) + (s0[2] + s0[3])) + ((s1[0] + s1[1]) + (s1[2] + s1[3])) + ((s2[0] + s2[1]) + (s2[2] + s2[3])) + ((s3[0] + s3[1]) + (s3[2] + s3[3]));
            rstdv[g] = rsqrtf(ss * (1.0f / DM) + EPS); }
#pragma unroll
        for (int ai = 0; ai < 2; ++ai)
#pragma unroll
            for (int m = 0; m < 4; ++m) { const int row = row0 + ai * HALF + m * 16; const float rstd = rstdv[ai * 4 + m];
                bf16* rowp = out + (size_t)row * ldc + col0;
#pragma unroll
                for (int bj = 0; bj < 2; ++bj) { const f32x4 v0 = acc[ai][bj][m][0] * rstd, v1 = acc[ai][bj][m][1] * rstd;
                    u32x4 w; w.x = cvt_pk_bf16(v0[0], v0[1]); w.y = cvt_pk_bf16(v0[2], v0[3]); w.z = cvt_pk_bf16(v1[0], v1[1]); w.w = cvt_pk_bf16(v1[2], v1[3]);
                    *(u32x4*)(rowp + bj * HALF) = w; } }
    }
};
struct EpiMix {
    static constexpr bool PERM = true;
    const unsigned char* g0; const unsigned char* g1; bf16* mix;
    __device__ __forceinline__ void mid(f32x4 (&acc)[2][2][4][2], const Unit& u, int wr, int wc, int fr, int fq) const {
        const size_t goff = ((size_t)(u.pm * 4 + u.pn) << 16) + (wr * 4 + wc) * 8192 + (fq * 16 + fr) * 16;
#pragma unroll
        for (int ai = 0; ai < 2; ++ai)
#pragma unroll
            for (int m = 0; m < 4; ++m) { const u32x4 a4 = *(const u32x4*)(g0 + goff + (ai * 4 + m) * 1024), b4 = *(const u32x4*)(g1 + goff + (ai * 4 + m) * 1024);
#pragma unroll
                for (int bj = 0; bj < 2; ++bj) {
#pragma unroll
                    for (int e = 0; e < 8; ++e) { const unsigned aw = bj == 0 ? (e < 4 ? a4.x : a4.y) : (e < 4 ? a4.z : a4.w), bw = bj == 0 ? (e < 4 ? b4.x : b4.y) : (e < 4 ? b4.z : b4.w); const int sh = 8 * (e & 3);
                        const float ga = (float)((aw >> sh) & 0xffu), gb = fmaxf((float)((bw >> sh) & 0xffu), 1.0f);
                        acc[ai][bj][m][e >> 2][e & 3] *= ga * fast_rcp(gb); } } }
    }
    __device__ __forceinline__ void operator()(const f32x4 (&acc)[2][2][4][2], const Unit& u, int wr, int wc, int fr, int fq) const {
        const int row0 = u.pm * BM + wr * 64 + fr, col0 = u.pn * BM + wc * 32 + 8 * fq;
        const size_t goff = ((size_t)(u.pm * 4 + u.pn) << 16) + (wr * 4 + wc) * 8192 + (fq * 16 + fr) * 16;
        u32x4 gb8[8];
#pragma unroll
        for (int g = 0; g < 8; ++g) gb8[g] = *(const u32x4*)(g1 + goff + g * 1024);
#pragma unroll
        for (int ai = 0; ai < 2; ++ai)
#pragma unroll
            for (int m = 0; m < 4; ++m) { const size_t off = (size_t)(row0 + ai * HALF + m * 16) * DM + col0; const u32x4 b4 = gb8[ai * 4 + m];
#pragma unroll
                for (int bj = 0; bj < 2; ++bj) { float v[8];
#pragma unroll
                    for (int e = 0; e < 8; ++e) { const unsigned bw = bj == 0 ? (e < 4 ? b4.x : b4.y) : (e < 4 ? b4.z : b4.w); const float gb = fmaxf((float)((bw >> (8 * (e & 3))) & 0xffu), 1.0f) * (1.0f / 255.0f);
                        v[e] = acc[ai][bj][m][e >> 2][e & 3] * gb; }
                    u32x4 w; w.x = cvt_pk_bf16(v[0], v[1]); w.y = cvt_pk_bf16(v[2], v[3]); w.z = cvt_pk_bf16(v[4], v[5]); w.w = cvt_pk_bf16(v[6], v[7]);
                    *(u32x4*)(mix + off + bj * HALF) = w; } }
    }
};
template <bool XF32> struct EpiResid {
    static constexpr bool PERM = true;
    const void* xin; bf16* xb; float* rss; float* amx;
    __device__ __forceinline__ void operator()(const f32x4 (&acc)[2][2][4][2], const Unit& u, int wr, int wc, int fr, int fq) const {
        const int row0 = u.pm * BM + wr * 64 + fr, col0 = u.pn * BM + wc * 32 + 8 * fq;
        constexpr int D = XF32 ? 3 : 4;
        f32x4 xv[D][XF32 ? 4 : 1]; u32x4 xw[D][XF32 ? 1 : 2];
#define ER_LOAD(g) do { const size_t o_ = (size_t)(row0 + ((g) >> 2) * HALF + ((g) & 3) * 16) * DM + col0; _Pragma("unroll") for (int q_ = 0; q_ < 2; ++q_) { const size_t oo_ = o_ + q_ * HALF; \
            if (XF32) { xv[(g) % D][XF32 ? 2 * q_ : 0] = __builtin_nontemporal_load((const f32x4*)((const float*)xin + oo_)); xv[(g) % D][XF32 ? 2 * q_ + 1 : 0] = __builtin_nontemporal_load((const f32x4*)((const float*)xin + oo_ + 4)); } \
            else xw[(g) % D][XF32 ? 0 : q_] = *(const u32x4*)((const bf16*)xin + oo_); } } while (0)
#pragma unroll
        for (int g = 0; g < D - 1; ++g) ER_LOAD(g);
#pragma unroll
        for (int ai = 0; ai < 2; ++ai)
#pragma unroll
            for (int m = 0; m < 4; ++m) { const int row = row0 + ai * HALF + m * 16; const size_t off = (size_t)row * DM + col0; float ss = 0.f, am = 0.f;
                const int gi = ai * 4 + m;
                if (gi + D - 1 < 8) ER_LOAD(gi + D - 1);
#pragma unroll
                for (int bj = 0; bj < 2; ++bj) { f32x4 v0, v1;
                    if (XF32) { v0 = xv[gi % D][XF32 ? 2 * bj : 0]; v1 = xv[gi % D][XF32 ? 2 * bj + 1 : 0]; }
                    else { const u32x4 w = xw[gi % D][XF32 ? 0 : bj]; v0 = (f32x4){bflo(w.x), bfhi(w.x), bflo(w.y), bfhi(w.y)}; v1 = (f32x4){bflo(w.z), bfhi(w.z), bflo(w.w), bfhi(w.w)}; }
                    v0 = v0 + acc[ai][bj][m][0]; v1 = v1 + acc[ai][bj][m][1];
                    u32x4 w; w.x = cvt_pk_bf16(v0[0], v0[1]); w.y = cvt_pk_bf16(v0[2], v0[3]); w.z = cvt_pk_bf16(v1[0], v1[1]); w.w = cvt_pk_bf16(v1[2], v1[3]); *(u32x4*)(xb + off + bj * HALF) = w;
                    ss += ((v0[0] * v0[0] + v0[1] * v0[1]) + (v0[2] * v0[2] + v0[3] * v0[3])) + ((v1[0] * v1[0] + v1[1] * v1[1]) + (v1[2] * v1[2] + v1[3] * v1[3]));
                    am = fmaxf(am, fmaxf(fmaxf(fmaxf(fabsf(v0[0]), fabsf(v0[1])), fmaxf(fabsf(v0[2]), fabsf(v0[3]))), fmaxf(fmaxf(fabsf(v1[0]), fabsf(v1[1])), fmaxf(fabsf(v1[2]), fabsf(v1[3]))))); }
                ss += __shfl_xor(ss, 16); ss += __shfl_xor(ss, 32);
                if (fq == 0) rss[(size_t)row * 16 + u.pn * 4 + wc] = ss;
                if (amx) { am = fmaxf(am, __shfl_xor(am, 16)); am = fmaxf(am, __shfl_xor(am, 32)); if (fq == 0) amx[(size_t)row * 16 + u.pn * 4 + wc] = am; } }
#undef ER_LOAD
    }
};
struct EpiLogit {
    static constexpr bool PERM = false;
    float* logit;
    __device__ __forceinline__ void operator()(const f32x4 (&acc)[2][2][4][2], const Unit& u, int wr, int wc, int fr, int fq) const {
        if (wc >= 2) return;
        const int row0 = u.pm * BM + wr * 64 + fr, col0 = wc * 32 + 4 * fq;
#pragma unroll
        for (int ai = 0; ai < 2; ++ai)
#pragma unroll
            for (int m = 0; m < 4; ++m) { float* rowp = logit + (size_t)(row0 + ai * HALF + m * 16) * 64 + col0;
#pragma unroll
                for (int n = 0; n < 2; ++n) *(f32x4*)(rowp + n * 16) = acc[ai][0][m][n]; }
    }
};
struct EpiGateUp {
    static constexpr bool PERM = true;
    bf16* H; const float* rstd; const float* xs; const float* wsc;
    __device__ __forceinline__ void operator()(const f32x4 (&acc)[2][2][4][2], const Unit& u, int wr, int wc, int fr, int fq) const {
        const int col0 = u.pn * 128 + wc * 32 + 8 * fq;
        int tok[8]; float rs[8];
#pragma unroll
        for (int i = 0; i < 8; ++i) { const int rt = (i >> 2) * HALF + wr * 64 + (i & 3) * 16 + fr; tok[i] = u.rows[rt < u.nvalid ? rt : 0]; }
#pragma unroll
        for (int i = 0; i < 8; ++i) rs[i] = rstd[tok[i]] * xs[tok[i]];
        const float* wcol = wsc + (size_t)u.crow0 * 1024 + u.pn * BM + wc * 32 + 8 * fq;
        float sg[8], su[8];
        { const f32x4 g0 = *(const f32x4*)wcol, g1 = *(const f32x4*)(wcol + 4), u0 = *(const f32x4*)(wcol + HALF), u1 = *(const f32x4*)(wcol + HALF + 4);
          sg[0] = g0[0]; sg[1] = g0[1]; sg[2] = g0[2]; sg[3] = g0[3]; sg[4] = g1[0]; sg[5] = g1[1]; sg[6] = g1[2]; sg[7] = g1[3];
          su[0] = u0[0]; su[1] = u0[1]; su[2] = u0[2]; su[3] = u0[3]; su[4] = u1[0]; su[5] = u1[1]; su[6] = u1[2]; su[7] = u1[3]; }
#pragma unroll
        for (int ai = 0; ai < 2; ++ai)
#pragma unroll
            for (int m = 0; m < 4; ++m) { const int rt = ai * HALF + wr * 64 + m * 16 + fr; const float r_ = rt < u.nvalid ? rs[ai * 4 + m] : 0.f;
                float h[8];
#pragma unroll
                for (int n = 0; n < 2; ++n)
#pragma unroll
                    for (int e = 0; e < 4; ++e) { const float g = (float)__float_as_int(acc[ai][0][m][n][e]) * (r_ * sg[n * 4 + e]), up = (float)__float_as_int(acc[ai][1][m][n][e]) * (r_ * su[n * 4 + e]); h[n * 4 + e] = g * sigmoid_f(g) * up; }
                u32x4 w; w.x = cvt_pk_bf16(h[0], h[1]); w.y = cvt_pk_bf16(h[2], h[3]); w.z = cvt_pk_bf16(h[4], h[5]); w.w = cvt_pk_bf16(h[6], h[7]);
                *(u32x4*)(H + (size_t)(u.pm * BM + rt) * EFF + col0) = w; }
    }
};
struct EpiY {
    static constexpr bool PERM = true;
    bf16* y0; bf16* y1;
    __device__ __forceinline__ void operator()(const f32x4 (&acc)[2][2][4][2], const Unit& u, int wr, int wc, int fr, int fq) const {
        bf16* base = (u.aux ? y1 : y0) + (size_t)u.crow0 * DM + u.pn * BM;
        const unsigned loff = (unsigned)((wr * 64 + fr) * DM + wc * 32 + 8 * fq); const int rt0 = wr * 64 + fr;
#pragma unroll
        for (int ai = 0; ai < 2; ++ai)
#pragma unroll
            for (int m = 0; m < 4; ++m) {
                if (rt0 + ai * HALF + m * 16 < u.nvalid) {
#pragma unroll
                    for (int bj = 0; bj < 2; ++bj) { const f32x4 v0 = acc[ai][bj][m][0], v1 = acc[ai][bj][m][1];
                        u32x4 w; w.x = cvt_pk_bf16(v0[0], v0[1]); w.y = cvt_pk_bf16(v0[2], v0[3]); w.z = cvt_pk_bf16(v1[0], v1[1]); w.w = cvt_pk_bf16(v1[2], v1[3]);
                        *(u32x4*)(base + loff + (unsigned)((ai * HALF + m * 16) * DM + bj * HALF)) = w; } } }
    }
};
}

#define XB_TMO      128
#define XB_XCNT(j)  (256  + 64 * (j))
#define XB_XSUB(j)  (1280 + 64 * (j))
#define XB_XGEN(j)  (2304 + 64 * (j))
#define XB_TOP      3328
#define XB_TOPGEN   3392
#define XCD_BAR_WORDS 3456
#define XB_SPIN_CAP (1u << 18)
__device__ __forceinline__ unsigned xb_ld(unsigned* p)              { return __hip_atomic_load(p, __ATOMIC_RELAXED, __HIP_MEMORY_SCOPE_AGENT); }
__device__ __forceinline__ unsigned xb_add(unsigned* p, unsigned v) { return __hip_atomic_fetch_add(p, v, __ATOMIC_RELAXED, __HIP_MEMORY_SCOPE_AGENT); }
__device__ __forceinline__ unsigned xb_xcc_id() { return (unsigned)__builtin_amdgcn_s_getreg((3 << 11) | 20) & 0xFu; }
#define XB_SPIN(cond, bar) do { unsigned _sp = 0; while (cond) { __builtin_amdgcn_s_sleep(1); \
    if ((++_sp & 255u) == 0u) { if (xb_ld(&(bar)[XB_TMO])) break; if (_sp > XB_SPIN_CAP) { atomicAdd(&(bar)[XB_TMO], 1u); break; } } } } while (0)
struct XcdBarrier { unsigned* bar; unsigned x; volatile LAS unsigned* st; };
__device__ __forceinline__ XcdBarrier xcd_barrier_post(unsigned* bar, volatile LAS unsigned* st) {
    XcdBarrier b; b.bar = bar; b.x = xb_xcc_id(); b.st = st;
    if (threadIdx.x == 0) (void)xb_add(&bar[XB_XCNT(b.x)], 1u);
    return b;
}
__device__ __forceinline__ void xcd_barrier_complete(unsigned* bar, unsigned x, unsigned& nloc, unsigned& nx) {
    const unsigned G = gridDim.x * gridDim.y * gridDim.z;
    unsigned sum, cnt, mine, sp = 0u;
    for (;;) {
        sum = 0u; cnt = 0u; mine = 0u;
#pragma unroll
        for (unsigned j = 0; j < 16; ++j) { const unsigned c = xb_ld(&bar[XB_XCNT(j)]); sum += c; cnt += (c > 0u) ? 1u : 0u; mine = (j == x) ? c : mine; }
        if (sum == G) break;
        __builtin_amdgcn_s_sleep(1);
        if ((++sp & 255u) == 0u) { if (xb_ld(&bar[XB_TMO])) break; if (sp > XB_SPIN_CAP) { atomicAdd(&bar[XB_TMO], 1u); break; } }
    }
    nloc = mine > 0u ? mine : 1u; nx = cnt > 0u ? cnt : 1u;
}
__device__ __forceinline__ void xcd_barrier(const XcdBarrier& b) {
    asm volatile("s_waitcnt vmcnt(0)" ::: "memory");
    __syncthreads();
    if (threadIdx.x == 0) {
        unsigned* bar = b.bar;
        __builtin_amdgcn_s_waitcnt(0);
        unsigned nloc = b.st[0], nx = b.st[1];
        if (nloc == 0u) { xcd_barrier_complete(bar, b.x, nloc, nx); b.st[0] = nloc; b.st[1] = nx; }
        const unsigned old = xb_add(&bar[XB_XSUB(b.x)], 1u);
        const unsigned gen = old / nloc;
        if (old + 1u == (gen + 1u) * nloc) {
            __builtin_amdgcn_fence(__ATOMIC_RELEASE, "agent");
            asm volatile("s_waitcnt vmcnt(0)" ::: "memory");
            const unsigned og = xb_add(&bar[XB_TOP], 1u);
            const unsigned tg = og / nx;
            if (og + 1u == (tg + 1u) * nx) xb_add(&bar[XB_TOPGEN], 1u);
            else XB_SPIN(xb_ld(&bar[XB_TOPGEN]) == tg, bar);
            __builtin_amdgcn_fence(__ATOMIC_ACQUIRE, "agent");
            xb_add(&bar[XB_XGEN(b.x)], 1u);
            asm volatile("s_waitcnt vmcnt(0)" ::: "memory");
        } else {
            XB_SPIN(xb_ld(&bar[XB_XGEN(b.x)]) == gen, bar);
            __builtin_amdgcn_fence(__ATOMIC_ACQUIRE, "agent");
            asm volatile("s_waitcnt vmcnt(0)" ::: "memory");
        }
    }
    __syncthreads();
}

struct Args { const void* in[36]; float* out; unsigned char* ws; int ph_lo, ph_hi, li, pad; };
enum { I_X = 0, I_MEM, I_POS, I_NORM_MIX, I_W_IN, I_CONV_W, I_CONV_B, I_LRU_WA, I_LRU_BA, I_LRU_WX, I_LRU_BX, I_LRU_LAMBDA, I_W_LRU_O, I_Q_NORM, I_K_NORM,
       I_LQ1, I_LK1, I_LQ2, I_LK2, I_SUBLN, I_W_ATTN_O, I_W_OUT, I_NORM_CX, I_NORM_MEM, I_W_CQ, I_W_CKV, I_CQ_NORM, I_CK_NORM, I_W_CO, I_NORM_FFN,
       I_W_GROUP, I_B_GROUP, I_W_ROUTER, I_B_ROUTER, I_W_GATE_UP, I_W_DOWN };

template <int MODE>
__device__ __forceinline__ void transpose_item(const float* W, int K, int N, bf16* WT, int row_off, const float* gain, LAS float* scr, int item, int lane) {
    const int nblk = N / 32, kb = item / nblk, nb = item % nblk, k0 = 64 * kb, n0 = 32 * nb;
    float tv[32];
#pragma unroll
    for (int i = 0; i < 32; ++i) { const int kk = 2 * i + (lane >> 5); tv[i] = W[(size_t)(k0 + kk) * N + n0 + (lane & 31)]; }
#pragma unroll
    for (int i = 0; i < 32; ++i) { const int kk = 2 * i + (lane >> 5); float v = tv[i]; if (gain) v *= gain[k0 + kk]; scr[kk * 33 + (lane & 31)] = v; }
    LDS_WAIT(); asm volatile("" ::: "memory");
    const int c = lane & 7;
#pragma unroll
    for (int j = 0; j < 4; ++j) { const int n = (lane >> 3) + 8 * j; const LAS float* s = scr + (8 * c) * 33 + n;
        u32x4 o; o.x = cvt_pk_bf16(s[0 * 33], s[1 * 33]); o.y = cvt_pk_bf16(s[2 * 33], s[3 * 33]); o.z = cvt_pk_bf16(s[4 * 33], s[5 * 33]); o.w = cvt_pk_bf16(s[6 * 33], s[7 * 33]);
        const int ng = n0 + n; int dr;
        if (MODE == 0) dr = row_off + ng; else { const int jj = ng & 511, up = ng >> 9; dr = row_off + (jj >> 7) * 256 + up * 128 + (jj & 127); }
        *(u32x4*)(WT + (size_t)dr * K + k0 + 8 * c) = o; }
    LDS_WAIT(); asm volatile("" ::: "memory");
}
__device__ __forceinline__ unsigned pack_i8x4(float a, float b, float c, float d) {
    const int ia = max(-127, min(127, __float2int_rn(a))), ib = max(-127, min(127, __float2int_rn(b))), ic = max(-127, min(127, __float2int_rn(c))), id = max(-127, min(127, __float2int_rn(d)));
    return (unsigned)(ia & 0xff) | ((unsigned)(ib & 0xff) << 8) | ((unsigned)(ic & 0xff) << 16) | ((unsigned)(id & 0xff) << 24);
}
__device__ __forceinline__ void rms_row_to_i8(const float* xrow, const float* g, unsigned char* orow, float* xs, int lane) {
    const f32x4* xr = (const f32x4*)xrow + lane; const f32x4* gr = (const f32x4*)g + lane;
    f32x4 v[4]; float s = 0.f;
#pragma unroll
    for (int j = 0; j < 4; ++j) { v[j] = __builtin_nontemporal_load(xr + 64 * j); s += (v[j].x * v[j].x + v[j].y * v[j].y) + (v[j].z * v[j].z + v[j].w * v[j].w); }
    const float rstd = rsqrtf(wave_sum(s) * (1.f / DM) + EPS); float mx = 0.f;
#pragma unroll
    for (int j = 0; j < 4; ++j) { const f32x4 gg = gr[64 * j]; v[j] = v[j] * gg * rstd; mx = fmaxf(mx, fmaxf(fmaxf(fabsf(v[j].x), fabsf(v[j].y)), fmaxf(fabsf(v[j].z), fabsf(v[j].w)))); }
    mx = wave_max(mx); const float sc = mx > 0.f ? mx * (1.0f / 127.0f) : 1.0f, inv = 1.0f / sc;
    if (lane == 0) *xs = sc;
    unsigned* o4 = (unsigned*)orow + lane;
#pragma unroll
    for (int j = 0; j < 4; ++j) o4[64 * j] = pack_i8x4(v[j].x * inv, v[j].y * inv, v[j].z * inv, v[j].w * inv);
}
__device__ __forceinline__ int win_dest(int n0) { if (n0 >= 2048 && n0 < 4096) { const int l0 = n0 & 255; return (n0 & ~255) + 128 * ((l0 >> 5) & 1) + 32 * (l0 >> 6); } return n0; }
__device__ __forceinline__ void win_absmax_item(const float* W, unsigned* wmax, int item, int lane) {
    constexpr int nblk = NWIN / 32; const int kb = item / nblk, nb = item % nblk, k0 = 64 * kb, n0 = 32 * nb;
    float tv[32], mx = 0.f;
#pragma unroll
    for (int i = 0; i < 32; ++i) { const int kk = 2 * i + (lane >> 5); tv[i] = W[(size_t)(k0 + kk) * NWIN + n0 + (lane & 31)]; }
#pragma unroll
    for (int i = 0; i < 32; ++i) mx = fmaxf(mx, fabsf(tv[i]));
    mx = fmaxf(mx, __shfl_xor(mx, 32));
    if (lane < 32) atomicMax(wmax + win_dest(n0) + lane, __float_as_uint(mx));
}
__device__ __forceinline__ void win_quant_item(const float* W, unsigned char* WT, const unsigned* wmax, float* wsc, LAS float* scr, int item, int lane) {
    constexpr int nblk = NWIN / 32; const int kb = item / nblk, nb = item % nblk, k0 = 64 * kb, n0 = 32 * nb, d0 = win_dest(n0);
    float tv[32];
#pragma unroll
    for (int i = 0; i < 32; ++i) { const int kk = 2 * i + (lane >> 5); tv[i] = W[(size_t)(k0 + kk) * NWIN + n0 + (lane & 31)]; }
    if (lane < 32) { const float mx = __uint_as_float(__hip_atomic_load(wmax + d0 + lane, __ATOMIC_RELAXED, __HIP_MEMORY_SCOPE_AGENT)); const float sc = mx > 0.f ? mx * (1.0f / 127.0f) : 1.0f;
        scr[64 * 33 + lane] = 1.0f / sc; if (kb == 0) wsc[d0 + lane] = sc; }
#pragma unroll
    for (int i = 0; i < 32; ++i) { const int kk = 2 * i + (lane >> 5); scr[kk * 33 + (lane & 31)] = tv[i]; }
    LDS_WAIT(); asm volatile("" ::: "memory");
    const int c = lane & 7;
#pragma unroll
    for (int j = 0; j < 4; ++j) { const int n = (lane >> 3) + 8 * j; const LAS float* sp = scr + (8 * c) * 33 + n; const float inv = scr[64 * 33 + n];
        u32x2 o; o.x = pack_i8x4(sp[0 * 33] * inv, sp[1 * 33] * inv, sp[2 * 33] * inv, sp[3 * 33] * inv); o.y = pack_i8x4(sp[4 * 33] * inv, sp[5 * 33] * inv, sp[6 * 33] * inv, sp[7 * 33] * inv);
        *(u32x2*)(WT + (size_t)(d0 + n) * DM + k0 + 8 * c) = o; }
    LDS_WAIT(); asm volatile("" ::: "memory");
}
__device__ __forceinline__ int gu_dest(int n) { const int jj = n & 511, up = n >> 9; return (jj >> 7) * 256 + up * 128 + (jj & 127); }
__device__ __forceinline__ void gu_absmax_item(const float* W, const float* gain, unsigned* wmax  , int item, int lane) {
    const int kb = item >> 5, nb = item & 31, k0 = 64 * kb, n0 = 32 * nb;
    float tv[32], mx = 0.f;
#pragma unroll
    for (int i = 0; i < 32; ++i) { const int kk = 2 * i + (lane >> 5); tv[i] = W[(size_t)(k0 + kk) * 1024 + n0 + (lane & 31)]; }
#pragma unroll
    for (int i = 0; i < 32; ++i) { const int kk = 2 * i + (lane >> 5); mx = fmaxf(mx, fabsf(tv[i] * gain[k0 + kk])); }
    mx = fmaxf(mx, __shfl_xor(mx, 32));
    if (lane < 32) atomicMax(wmax + gu_dest(n0) + lane, __float_as_uint(mx));
}
__device__ __forceinline__ void gu_quant_item(const float* W, const float* gain, unsigned char* WT  , const unsigned* wmax, float* wsc, LAS float* scr, int item, int lane) {
    const int kb = item >> 5, nb = item & 31, k0 = 64 * kb, n0 = 32 * nb, d0 = gu_dest(n0);
    float tv[32];
#pragma unroll
    for (int i = 0; i < 32; ++i) { const int kk = 2 * i + (lane >> 5); tv[i] = W[(size_t)(k0 + kk) * 1024 + n0 + (lane & 31)]; }
    if (lane < 32) { const float mx = __uint_as_float(__hip_atomic_load(wmax + d0 + lane, __ATOMIC_RELAXED, __HIP_MEMORY_SCOPE_AGENT)); const float sc = mx > 0.f ? mx * (1.0f / 127.0f) : 1.0f;
        scr[64 * 33 + lane] = 1.0f / sc; if (kb == 0) wsc[d0 + lane] = sc; }
#pragma unroll
    for (int i = 0; i < 32; ++i) { const int kk = 2 * i + (lane >> 5); scr[kk * 33 + (lane & 31)] = tv[i] * gain[k0 + kk]; }
    LDS_WAIT(); asm volatile("" ::: "memory");
    const int c = lane & 7;
#pragma unroll
    for (int j = 0; j < 4; ++j) { const int n = (lane >> 3) + 8 * j; const LAS float* sp = scr + (8 * c) * 33 + n; const float inv = scr[64 * 33 + n];
        u32x2 o; o.x = pack_i8x4(sp[0 * 33] * inv, sp[1 * 33] * inv, sp[2 * 33] * inv, sp[3 * 33] * inv); o.y = pack_i8x4(sp[4 * 33] * inv, sp[5 * 33] * inv, sp[6 * 33] * inv, sp[7 * 33] * inv);
        *(u32x2*)(WT + (size_t)(d0 + n) * DM + k0 + 8 * c) = o; }
    LDS_WAIT(); asm volatile("" ::: "memory");
}
__device__ __forceinline__ void rms_row_to_bf16(const float* xrow, const float* g, bf16* orow, int lane) {
    const f32x4* xr = (const f32x4*)xrow + lane; const f32x4* gr = (const f32x4*)g + lane;
    f32x4 v[4]; float s = 0.f;
#pragma unroll
    for (int j = 0; j < 4; ++j) { v[j] = xr[64 * j]; s += (v[j].x * v[j].x + v[j].y * v[j].y) + (v[j].z * v[j].z + v[j].w * v[j].w); }
    const float rstd = rsqrtf(wave_sum(s) * (1.f / DM) + EPS);
    u32x2* o8 = (u32x2*)orow + lane;
#pragma unroll
    for (int j = 0; j < 4; ++j) { const f32x4 gg = gr[64 * j]; u32x2 w; w.x = cvt_pk_bf16(v[j].x * rstd * gg.x, v[j].y * rstd * gg.y); w.y = cvt_pk_bf16(v[j].z * rstd * gg.z, v[j].w * rstd * gg.w); o8[64 * j] = w; }
}
__device__ __forceinline__ void colquant_wg_item(const float* W, int N, int n0, int d0, const LAS float* gain_l  , unsigned char* WT, float* wsc, LAS float* red, int tid) {
    const int ks = tid >> 5, nl = tid & 31;
    float v[64];
    const float* src = W + (size_t)(64 * ks) * N + n0 + nl;
#pragma unroll
    for (int i = 0; i < 64; ++i) v[i] = src[(size_t)i * N];
    if (gain_l) {
#pragma unroll
        for (int i = 0; i < 16; ++i) { const f32x4 g4 = *(const LAS f32x4*)(gain_l + 64 * ks + 4 * i); v[4 * i] *= g4[0]; v[4 * i + 1] *= g4[1]; v[4 * i + 2] *= g4[2]; v[4 * i + 3] *= g4[3]; } }
    float mx = 0.f;
#pragma unroll
    for (int i = 0; i < 64; ++i) mx = fmaxf(mx, fabsf(v[i]));
    red[ks * 32 + nl] = mx;
    __syncthreads();
    float cm = 0.f;
#pragma unroll
    for (int j = 0; j < 16; ++j) cm = fmaxf(cm, red[j * 32 + nl]);
    const float sc = cm > 0.f ? cm * (1.0f / 127.0f) : 1.0f, inv = 1.0f / sc;
    if (ks == 0) wsc[d0 + nl] = sc;
    unsigned char* dst = WT + (size_t)(d0 + nl) * DM + 64 * ks;
#pragma unroll
    for (int q = 0; q < 4; ++q) { u32x4 o;
        o.x = pack_i8x4(v[16 * q] * inv, v[16 * q + 1] * inv, v[16 * q + 2] * inv, v[16 * q + 3] * inv); o.y = pack_i8x4(v[16 * q + 4] * inv, v[16 * q + 5] * inv, v[16 * q + 6] * inv, v[16 * q + 7] * inv);
        o.z = pack_i8x4(v[16 * q + 8] * inv, v[16 * q + 9] * inv, v[16 * q + 10] * inv, v[16 * q + 11] * inv); o.w = pack_i8x4(v[16 * q + 12] * inv, v[16 * q + 13] * inv, v[16 * q + 14] * inv, v[16 * q + 15] * inv);
        *(u32x4*)(dst + 16 * q) = o; }
    __syncthreads();
}
__device__ __forceinline__ void prologue_phase(const Args& args, LAS unsigned char* lds, int vcu, int G, int wave, int lane) {
    unsigned char* ws = args.ws;
    LAS float* scr = (LAS float*)(lds + wave * 16384);
    const int gw = vcu * NWAVES + wave, NGW = G * NWAVES;
    constexpr int I0 = 0  , I1 = 512, I4 = 256, I5 = 512, I6 = 256, I7 = 0, I8 = 256  , I9 = 8  ;
    constexpr int E0 = I0, E1 = E0 + 3 * I1, E4 = E1 + I4, E5 = E4 + I5, E6 = E5 + I6, E7 = E6 + NEXP * I7, E8 = E7 + NEXP * I8, E9 = E8 + 16 * I9;
    for (int it = gw; it < E9; it += NGW) {
        if (it < E0) { win_absmax_item((const float*)args.in[I_W_IN], (unsigned*)(ws + WS_CTL) + CW_WMAX, it, lane); continue; }
        if (it < E1) { const int r = it - E0, w = r / I1; const float* src = (const float*)args.in[w == 0 ? I_W_LRU_O : (w == 1 ? I_W_ATTN_O : I_W_OUT)];
            bf16* dst = (bf16*)(ws + (w == 0 ? WS_WLRUO : (w == 1 ? WS_WATTNO : WS_WOUT))); transpose_item<0>(src, DM, DM, dst, 0, nullptr, scr, r % I1, lane); continue; }
        if (it < E4) { transpose_item<0>((const float*)args.in[I_W_CQ], DM, 512, (bf16*)(ws + WS_WCQ), 0, (const float*)args.in[I_NORM_CX], scr, it - E1, lane); continue; }
        if (it < E5) { transpose_item<0>((const float*)args.in[I_W_CKV], DM, DM, (bf16*)(ws + WS_WCKV), 0, nullptr, scr, it - E4, lane); continue; }
        if (it < E6) { transpose_item<0>((const float*)args.in[I_W_CO], 512, DM, (bf16*)(ws + WS_WCO), 0, nullptr, scr, it - E5, lane); continue; }
        if (it < E7) { const int r = it - E6, e = r / I7; gu_absmax_item((const float*)args.in[I_W_GATE_UP] + (size_t)e * DM * 1024, (const float*)args.in[I_NORM_FFN], (unsigned*)(ws + WS_CTL) + CW_WMAX2 + e * 1024, r % I7, lane); continue; }
        if (it < E8) { const int r = it - E7, e = r / I8; transpose_item<0>((const float*)args.in[I_W_DOWN] + (size_t)e * EFF * DM, EFF, DM, (bf16*)(ws + WS_WDN) + (size_t)e * DM * EFF, 0, nullptr, scr, r % I8, lane); continue; }
        { const int r = it - E8, blk = r / (2 * I9), which = (r / I9) & 1; const float* src = (const float*)args.in[which ? I_LRU_WX : I_LRU_WA] + (size_t)blk * 128 * 128;
          transpose_item<0>(src, 128, 128, (bf16*)(ws + WS_WLRU) + (size_t)blk * 256 * 128, which * 128, nullptr, scr, r % I9, lane); }
    }
    { const float* wg = (const float*)args.in[I_W_GROUP]; const float* wr_ = (const float*)args.in[I_W_ROUTER]; const float* gf = (const float*)args.in[I_NORM_FFN]; bf16* dst = (bf16*)(ws + WS_WRT);
      for (int idx = gw * 64 + lane; idx < 256 * DM; idx += NGW * 64) { const int n = idx >> 10, k = idx & 1023; float v = 0.f;
          if (n < 4) v = wg[k * 4 + n] * gf[k]; else if (n < 36) v = wr_[k * 32 + (n - 4)] * gf[k];
          dst[idx] = (bf16)(cvt_pk_bf16(v, 0.f) & 0xffffu); } }
    { const int* pos = (const int*)args.in[I_POS]; float* rope = (float*)(ws + WS_ROPE);
      for (int idx = gw * 64 + lane; idx < MTOK * 8; idx += NGW * 64) { const int row = idx >> 3, i = idx & 7;
          const float invf = expf(-13.122363377404328f * (float)i * 0.125f); float sn, cs; sincosf((float)pos[row] * invf, &sn, &cs);
          rope[(size_t)row * 16 + i] = cs; rope[(size_t)row * 16 + 8 + i] = sn; } }
    for (int m = gw; m < MTOK; m += 2 * NGW) {
        rms_row_to_i8((const float*)args.in[I_X] + (size_t)m * DM, (const float*)args.in[I_NORM_MIX], ws + WS_XN + (size_t)m * DM, (float*)(ws + WS_XS) + m, lane);
        if (m + NGW < MTOK) rms_row_to_i8((const float*)args.in[I_X] + (size_t)(m + NGW) * DM, (const float*)args.in[I_NORM_MIX], ws + WS_XN + (size_t)(m + NGW) * DM, (float*)(ws + WS_XS) + m + NGW, lane); }
    for (int m = gw; m < MEMROWS; m += NGW) rms_row_to_bf16((const float*)args.in[I_MEM] + (size_t)m * DM, (const float*)args.in[I_NORM_MEM], (bf16*)(ws + WS_MEMN) + (size_t)m * DM, lane);
}

__device__ __forceinline__ void qk16_process(const bf16* p, bf16* po, const float (&g)[16], const float (&cs)[8], const float (&sn)[8], int lane) {
    const u32x4 w0 = *(const u32x4*)p, w1 = *(const u32x4*)(p + 8);
    float v[16] = { bflo(w0.x), bfhi(w0.x), bflo(w0.y), bfhi(w0.y), bflo(w0.z), bfhi(w0.z), bflo(w0.w), bfhi(w0.w), bflo(w1.x), bfhi(w1.x), bflo(w1.y), bfhi(w1.y), bflo(w1.z), bfhi(w1.z), bflo(w1.w), bfhi(w1.w) };
    float ss = 0.f;
#pragma unroll
    for (int d = 0; d < 16; ++d) ss += v[d] * v[d];
    ss += __shfl_xor(ss, 1); ss += __shfl_xor(ss, 2);
    const float rstd = rsqrtf(ss * (1.f / 64.f) + EPS);
#pragma unroll
    for (int d = 0; d < 16; ++d) v[d] = v[d] * rstd * g[d];
    if ((lane & 3) == 0) {
#pragma unroll
        for (int i = 0; i < 8; ++i) { const float x1 = v[i], x2 = v[8 + i]; v[i] = x1 * cs[i] - x2 * sn[i]; v[8 + i] = x2 * cs[i] + x1 * sn[i]; } }
    u32x4 o0, o1; o0.x = cvt_pk_bf16(v[0], v[1]); o0.y = cvt_pk_bf16(v[2], v[3]); o0.z = cvt_pk_bf16(v[4], v[5]); o0.w = cvt_pk_bf16(v[6], v[7]);
    o1.x = cvt_pk_bf16(v[8], v[9]); o1.y = cvt_pk_bf16(v[10], v[11]); o1.z = cvt_pk_bf16(v[12], v[13]); o1.w = cvt_pk_bf16(v[14], v[15]);
    *(u32x4*)po = o0; *(u32x4*)(po + 8) = o1;
}
__device__ __forceinline__ void qknorm_phase(const bf16* Q, const bf16* Kb, bf16* Qo, bf16* Ko, const int* pos, const float* qg, const float* kg, int gw, int NGW, int lane) {
    float gq[16], gk[16];
#pragma unroll
    for (int d = 0; d < 16; ++d) { gq[d] = qg[16 * (lane & 3) + d] * (0.125f * LOG2E); gk[d] = kg[16 * (lane & 3) + d]; }
    const float invf = expf(-13.122363377404328f * (float)(lane & 7) * 0.125f);
    for (int row = gw; row < MTOK; row += NGW) {
        const float ang = (float)pos[row] * invf; float s_, c_; sincosf(ang, &s_, &c_);
        float cs[8], sn[8];
#pragma unroll
        for (int i = 0; i < 8; ++i) { cs[i] = __uint_as_float(__builtin_amdgcn_readlane(__float_as_uint(c_), i)); sn[i] = __uint_as_float(__builtin_amdgcn_readlane(__float_as_uint(s_), i)); }
        qk16_process(Q + (size_t)row * DM + 16 * lane, Qo + (size_t)row * DM + 16 * lane, gq, cs, sn, lane);
        qk16_process(Kb + (size_t)row * DM + 16 * lane, Ko + (size_t)row * DM + 16 * lane, gk, cs, sn, lane);
    }
}
__device__ __forceinline__ void headnorm128_phase(const bf16* X, bf16* Xo, int pitch, int nrows, const float* g, float scale, int gw, int NGW, int lane) {
    float gg[8];
#pragma unroll
    for (int e = 0; e < 8; ++e) gg[e] = g[8 * (lane & 15) + e] * scale;
    for (int row = gw; row < nrows; row += NGW) {
        const bf16* p = X + (size_t)row * pitch + 8 * lane; const u32x4 w = *(const u32x4*)p;
        float v[8] = { bflo(w.x), bfhi(w.x), bflo(w.y), bfhi(w.y), bflo(w.z), bfhi(w.z), bflo(w.w), bfhi(w.w) };
        float ss = 0.f;
#pragma unroll
        for (int e = 0; e < 8; ++e) ss += v[e] * v[e];
        ss += __shfl_xor(ss, 1); ss += __shfl_xor(ss, 2); ss += __shfl_xor(ss, 4); ss += __shfl_xor(ss, 8);
        const float rstd = rsqrtf(ss * (1.f / 128.f) + EPS);
        u32x4 o; o.x = cvt_pk_bf16(v[0] * rstd * gg[0], v[1] * rstd * gg[1]); o.y = cvt_pk_bf16(v[2] * rstd * gg[2], v[3] * rstd * gg[3]);
        o.z = cvt_pk_bf16(v[4] * rstd * gg[4], v[5] * rstd * gg[5]); o.w = cvt_pk_bf16(v[6] * rstd * gg[6], v[7] * rstd * gg[7]);
        *(u32x4*)(Xo + (size_t)row * pitch + 8 * lane) = o;
    }
}

constexpr int LRU_RAW = 0, LRU_RAWP = 528  , LRU_XC = 128 * LRU_RAWP, LRU_XCP = 272, LRU_GG = LRU_XC + 64 * 272, LRU_GGP = 144, LRU_UT = LRU_GG + 2 * 64 * 144;
static_assert(LRU_UT + 64 * 144 <= RING_BYTES, "LRU LDS map");
__device__ __forceinline__ float dpp_shr(float v, float old, int n) {
    const int o = __float_as_int(old), s = __float_as_int(v); int r;
    switch (n) { case 1: r = __builtin_amdgcn_update_dpp(o, s, 0x111, 0xf, 0xf, false); break; case 2: r = __builtin_amdgcn_update_dpp(o, s, 0x112, 0xf, 0xf, false); break;
                 case 4: r = __builtin_amdgcn_update_dpp(o, s, 0x114, 0xf, 0xf, false); break; default: r = __builtin_amdgcn_update_dpp(o, s, 0x118, 0xf, 0xf, false); break; }
    return __int_as_float(r);
}
__device__ __forceinline__ void lru_phase(const Args& args, LAS unsigned char* lds, int vcu, int G) {
    unsigned char* ws = args.ws;
    const int tid = threadIdx.x, lane = tid & 63, wid = __builtin_amdgcn_readfirstlane(tid >> 6), j16 = lane & 15, g4 = lane >> 4;
    const bf16* LIN = (const bf16*)(ws + WS_LIN); const bf16* GGb = (const bf16*)(ws + WS_GG); bf16* U = (bf16*)(ws + WS_U);
    const float* convw = (const float*)args.in[I_CONV_W]; const float* convb = (const float*)args.in[I_CONV_B];
    for (int unit = vcu; unit < NB * 16; unit += G) {
        const int b = unit >> 4, n = (unit >> 1) & 7, hh = unit & 1;
        const int cg = tid & 15;
        float cw[4][8], cb[8];
#pragma unroll
        for (int e = 0; e < 8; ++e) { cb[e] = convb[128 * n + 8 * cg + e];
#pragma unroll
            for (int k = 0; k < 4; ++k) cw[k][e] = convw[k * DM + 128 * n + 8 * cg + e]; }
        bf16x8 wf[4];
        { const int i = j16, grp = i >> 2, chl = (grp >> 1) * 4 + (i & 3), iswx = grp & 1, col = iswx * 128 + 64 * hh + 8 * wid + chl;
          const bf16* wp = (const bf16*)(ws + WS_WLRU) + ((size_t)n * 256 + col) * 128 + 8 * g4;
#pragma unroll
          for (int ks = 0; ks < 4; ++ks) wf[ks] = *(const bf16x8*)(wp + 32 * ks); }
        const int chl0 = 8 * wid + 4 * (g4 >> 1) + 2 * (g4 & 1);
        const int chg0 = 128 * n + 64 * hh + chl0;
        float ba[2], bx[2], sp8[2];
#pragma unroll
        for (int q = 0; q < 2; ++q) { ba[q] = ((const float*)args.in[I_LRU_BA])[chg0 + q]; bx[q] = ((const float*)args.in[I_LRU_BX])[chg0 + q];
            const float lam = ((const float*)args.in[I_LRU_LAMBDA])[chg0 + q]; sp8[q] = 8.0f * log1pf(expf(-lam)); }
        float hprev[2] = {0.f, 0.f};
        const size_t rowbase = (size_t)b * SEQ;
        const int lrow[2] = { tid >> 4, (tid + 512) >> 4 }, lpc = tid & 15;
        const int grow = tid >> 3, gpc = tid & 7, grho = (grow & 3) * 16 + (grow >> 2);
        u32x4 rl[2], rg;
#define LRU_FILL(row_, pc_, w_) do { LAS unsigned char* d_ = lds + LRU_RAW + (row_) * LRU_RAWP + (pc_) * 16; \
            *(LAS f32x4*)d_ = (f32x4){bflo((w_).x), bfhi((w_).x), bflo((w_).y), bfhi((w_).y)}; *(LAS f32x4*)(d_ + 256) = (f32x4){bflo((w_).z), bfhi((w_).z), bflo((w_).w), bfhi((w_).w)}; } while (0)
        if (tid < 3 * 32) *(LAS u32x4*)(lds + LRU_RAW + (125 + tid / 32) * LRU_RAWP + (tid & 31) * 16) = (u32x4){0u, 0u, 0u, 0u};
#pragma unroll
        for (int i = 0; i < 2; ++i) rl[i] = *(const u32x4*)(LIN + (rowbase + lrow[i]) * DM + 128 * n + 8 * lpc);
        rg = *(const u32x4*)(GGb + (rowbase + grow) * DM + 128 * n + 64 * hh + 8 * gpc);
#pragma unroll
        for (int i = 0; i < 2; ++i) LRU_FILL(lrow[i], lpc, rl[i]);
        *(LAS u32x4*)(lds + LRU_GG + grho * LRU_GGP + gpc * 16) = rg;
#pragma unroll
        for (int i = 0; i < 2; ++i) rl[i] = *(const u32x4*)(LIN + (rowbase + 64 + lrow[i]) * DM + 128 * n + 8 * lpc);
        rg = *(const u32x4*)(GGb + (rowbase + 64 + grow) * DM + 128 * n + 64 * hh + 8 * gpc);
        __syncthreads();
        for (int it = 0; it < SEQ / 64; ++it) {
            const int t0 = 64 * it;
#pragma unroll
            for (int i = 0; i < 2; ++i) { const int t = (tid >> 4) + 32 * i; f32x2 a2[4];
#pragma unroll
                for (int e = 0; e < 4; ++e) a2[e] = (f32x2){cb[2 * e], cb[2 * e + 1]};
#pragma unroll
                for (int k = 0; k < 4; ++k) { const int rr = (t0 + t - 3 + k) & 127; const LAS unsigned char* rp_ = lds + LRU_RAW + rr * LRU_RAWP + cg * 16;
                    const f32x4 xa = *(const LAS f32x4*)rp_, xb4 = *(const LAS f32x4*)(rp_ + 256);
                    a2[0] = __builtin_elementwise_fma((f32x2){cw[k][0], cw[k][1]}, (f32x2){xa.x, xa.y}, a2[0]); a2[1] = __builtin_elementwise_fma((f32x2){cw[k][2], cw[k][3]}, (f32x2){xa.z, xa.w}, a2[1]);
                    a2[2] = __builtin_elementwise_fma((f32x2){cw[k][4], cw[k][5]}, (f32x2){xb4.x, xb4.y}, a2[2]); a2[3] = __builtin_elementwise_fma((f32x2){cw[k][6], cw[k][7]}, (f32x2){xb4.z, xb4.w}, a2[3]); }
                u32x4 o; o.x = cvt_pk_bf16(a2[0].x, a2[0].y); o.y = cvt_pk_bf16(a2[1].x, a2[1].y); o.z = cvt_pk_bf16(a2[2].x, a2[2].y); o.w = cvt_pk_bf16(a2[3].x, a2[3].y);
                const int rho = (t & 3) * 16 + (t >> 2);
                *(LAS u32x4*)(lds + LRU_XC + rho * LRU_XCP + cg * 16) = o; }
            __syncthreads();
            if (it + 1 < SEQ / 64) {
#pragma unroll
                for (int i = 0; i < 2; ++i) LRU_FILL((t0 + 64 + lrow[i]) & 127, lpc, rl[i]);
                *(LAS u32x4*)(lds + LRU_GG + ((it + 1) & 1) * 64 * LRU_GGP + grho * LRU_GGP + gpc * 16) = rg;
                if (it + 2 < SEQ / 64) {
#pragma unroll
                    for (int i = 0; i < 2; ++i) rl[i] = *(const u32x4*)(LIN + (rowbase + t0 + 128 + lrow[i]) * DM + 128 * n + 8 * lpc);
                    rg = *(const u32x4*)(GGb + (rowbase + t0 + 128 + grow) * DM + 128 * n + 64 * hh + 8 * gpc); } }
            f32x4 acc[4];
#pragma unroll
            for (int tb = 0; tb < 4; ++tb) { acc[tb] = (f32x4){0.f, 0.f, 0.f, 0.f};
#pragma unroll
                for (int ks = 0; ks < 4; ++ks) { const bf16x8 xf = *(const LAS bf16x8*)(lds + LRU_XC + (tb * 16 + j16) * LRU_XCP + (32 * ks + 8 * g4) * 2);
                    acc[tb] = __builtin_amdgcn_mfma_f32_16x16x32_bf16(wf[ks], xf, acc[tb], 0, 0, 0); } }
            float pr[4][2], pi[4][2];
#pragma unroll
            for (int tb = 0; tb < 4; ++tb)
#pragma unroll
                for (int q = 0; q < 2; ++q) {
                    const auto sw_ = __builtin_amdgcn_permlane16_swap(__float_as_uint(acc[tb][q]), __float_as_uint(acc[tb][2 + q]), false, false);
                    pr[tb][q] = __uint_as_float(sw_[0]); pi[tb][q] = __uint_as_float(sw_[1]); }
            const LAS unsigned char* ggp = lds + LRU_GG + (it & 1) * 64 * LRU_GGP;
            unsigned uo[4];
            f32x2 hq2[4];
            { const f32x2 ba2 = (f32x2){ba[0], ba[1]}, bx2 = (f32x2){bx[0], bx[1]}, nsp2 = (f32x2){-sp8[0], -sp8[1]};
              f32x2 a2v[4], bb2[4];
#pragma unroll
              for (int tb = 0; tb < 4; ++tb) {
                  const f32x2 zr = ((f32x2){pr[tb][0], pr[tb][1]} + ba2) * (-LOG2E), zi = ((f32x2){pi[tb][0], pi[tb][1]} + bx2) * (-LOG2E);
                  const f32x2 er = (f32x2){fast_exp2(zr.x), fast_exp2(zr.y)} + 1.0f, ei = (f32x2){fast_exp2(zi.x), fast_exp2(zi.y)} + 1.0f;
                  const f32x2 r = (f32x2){fast_rcp(er.x), fast_rcp(er.y)}, ig = (f32x2){fast_rcp(ei.x), fast_rcp(ei.y)};
                  const f32x2 la = nsp2 * r, lal = la * LOG2E, x2v = la + la;
                  const f32x2 av = (f32x2){fast_exp2(lal.x), fast_exp2(lal.y)}; a2v[tb] = av;
                  f32x2 pe = x2v * 0.0013888889f + 0.0083333338f; pe = pe * x2v + 0.041666668f; pe = pe * x2v + 0.16666667f; pe = pe * x2v + 0.5f; pe = pe * x2v + 1.0f;
                  f32x2 emv = -x2v * pe;
                  if (__builtin_amdgcn_ballot_w64(fminf(x2v.x, x2v.y) <= -0.25f) != 0ull) { const f32x2 dv = 1.0f - av * av;
                      emv.x = x2v.x > -0.25f ? emv.x : dv.x; emv.y = x2v.y > -0.25f ? emv.y : dv.y; }
                  const f32x2 coef = (f32x2){__builtin_amdgcn_sqrtf(emv.x), __builtin_amdgcn_sqrtf(emv.y)};
                  const unsigned xw = *(const LAS unsigned*)(lds + LRU_XC + (tb * 16 + j16) * LRU_XCP + (64 * hh + chl0) * 2);
                  bb2[tb] = coef * ig * (f32x2){bflo(xw), bfhi(xw)}; }
              f32x2 A = a2v[0], H = bb2[0];
#pragma unroll
              for (int tb = 1; tb < 4; ++tb) { H = __builtin_elementwise_fma(a2v[tb], H, bb2[tb]); A = A * a2v[tb]; }
#pragma unroll
              for (int sft = 1; sft < 16; sft <<= 1) { const f32x2 As = (f32x2){dpp_shr(A.x, 1.0f, sft), dpp_shr(A.y, 1.0f, sft)}, Hs = (f32x2){dpp_shr(H.x, 0.0f, sft), dpp_shr(H.y, 0.0f, sft)};
                  H = __builtin_elementwise_fma(A, Hs, H); A = A * As; }
              const f32x2 Aex = (f32x2){dpp_shr(A.x, 1.0f, 1), dpp_shr(A.y, 1.0f, 1)}, Hex = (f32x2){dpp_shr(H.x, 0.0f, 1), dpp_shr(H.y, 0.0f, 1)};
              f32x2 h = __builtin_elementwise_fma(Aex, (f32x2){hprev[0], hprev[1]}, Hex);
#pragma unroll
              for (int tb = 0; tb < 4; ++tb) { h = __builtin_elementwise_fma(a2v[tb], h, bb2[tb]); hq2[tb] = h; }
              hprev[0] = __shfl(h.x, (lane & 48) | 15); hprev[1] = __shfl(h.y, (lane & 48) | 15);
            }
#pragma unroll
            for (int tb = 0; tb < 4; ++tb) { const unsigned gw2 = *(const LAS unsigned*)(ggp + (tb * 16 + j16) * LRU_GGP + chl0 * 2);
                const f32x2 gv = (f32x2){bflo(gw2), bfhi(gw2)};
                const f32x2 uu = (gv + (gv * gv * gv) * 0.044715f) * (-2.0f * 0.7978845608028654f * LOG2E);
                const f32x2 den = (f32x2){fast_exp2(uu.x), fast_exp2(uu.y)} + 1.0f;
                const f32x2 outv = hq2[tb] * gv * (f32x2){fast_rcp(den.x), fast_rcp(den.y)};
                uo[tb] = cvt_pk_bf16(outv.x, outv.y);
                *(LAS unsigned*)(lds + LRU_UT + (tb * 16 + j16) * LRU_GGP + chl0 * 2) = uo[tb]; }
            __syncthreads();
            { const u32x4 v = *(const LAS u32x4*)(lds + LRU_UT + grho * LRU_GGP + gpc * 16);
              *(u32x4*)(U + (rowbase + t0 + grow) * DM + 128 * n + 64 * hh + 8 * gpc) = v; }
        }
        __syncthreads();
    }
}

constexpr int AT_SLOT = 32768, AT_V = 16384, AT_STG = 3 * AT_SLOT;
static_assert(AT_STG + 8 * 4096 <= RING_BYTES, "attention LDS map");
__device__ __forceinline__ void glds16(const void* gsrc, unsigned lds_dst) { unsigned keep;
    asm volatile("s_mov_b32 %0, m0\n\ts_mov_b32 m0, %2\n\ts_nop 0\n\tglobal_load_lds_dwordx4 %1, off\n\ts_mov_b32 m0, %0" : "=&s"(keep) : "v"(gsrc), "s"(lds_dst) : "memory"); }
__device__ __forceinline__ int crow(int r, int hi) { return (r & 3) + 8 * (r >> 2) + 4 * hi; }
typedef short v4i16_t __attribute__((ext_vector_type(4)));
__device__ __forceinline__ s16x4 vtr(const LAS unsigned char* p) { return __builtin_bit_cast(s16x4, __builtin_amdgcn_ds_read_tr16_b64_v4i16((LAS v4i16_t*)p)); }

template <int K> __device__ __forceinline__ float swz_xor(float v) { return __int_as_float(__builtin_amdgcn_ds_swizzle(__float_as_int(v), (K << 10) | 0x1f)); }
__device__ __forceinline__ float xor32_sum(float v) { auto rr = __builtin_amdgcn_permlane32_swap(__float_as_uint(v), __float_as_uint(v), false, false); return __uint_as_float(rr[0]) + __uint_as_float(rr[1]); }
template <int NMAP>
__device__ __forceinline__ void attn_unit(LAS unsigned char* ldsb, const bf16* Qw  , int pitchQ,
                                          const bf16* Kp, int pitchK, const bf16* Vp, int pitchV, int NT, int ntv,
                                          bf16* Ow, int pitchO, float cref, float lam, const float* subln, float oscale, const float* qgain = nullptr, float qscale = 1.0f) {
    int tid = threadIdx.x; asm volatile("" : "+v"(tid));
    const int lane = tid & 63, r32 = lane & 31, hi = lane >> 5; const int wid = __builtin_amdgcn_readfirstlane(tid >> 6);
    const unsigned lds0 = (unsigned)(size_t)ldsb;
    constexpr int NQR = (NMAP == 2) ? 4 : 8;
    bf16x8 qr[NQR];
#pragma unroll
    for (int j = 0; j < NQR; ++j) qr[j] = *(const bf16x8*)(Qw + (size_t)r32 * pitchQ + 16 * j + 8 * hi);
    if (NMAP == 1 && qgain) {
        float ss = 0.f;
#pragma unroll
        for (int j = 0; j < 8; ++j) { const u32x4 w = __builtin_bit_cast(u32x4, qr[j]);
            ss += bflo(w.x) * bflo(w.x) + bfhi(w.x) * bfhi(w.x) + bflo(w.y) * bflo(w.y) + bfhi(w.y) * bfhi(w.y) + bflo(w.z) * bflo(w.z) + bfhi(w.z) * bfhi(w.z) + bflo(w.w) * bflo(w.w) + bfhi(w.w) * bfhi(w.w); }
        ss = xor32_sum(ss);
        const float rs = rsqrtf(ss * (1.f / 128.f) + EPS) * qscale;
#pragma unroll
        for (int j = 0; j < 8; ++j) { const u32x4 w = __builtin_bit_cast(u32x4, qr[j]); const f32x4 g0 = *(const f32x4*)(qgain + 16 * j + 8 * hi), g1 = *(const f32x4*)(qgain + 16 * j + 8 * hi + 4);
            u32x4 o; o.x = cvt_pk_bf16(bflo(w.x) * rs * g0[0], bfhi(w.x) * rs * g0[1]); o.y = cvt_pk_bf16(bflo(w.y) * rs * g0[2], bfhi(w.y) * rs * g0[3]);
            o.z = cvt_pk_bf16(bflo(w.z) * rs * g1[0], bfhi(w.z) * rs * g1[1]); o.w = cvt_pk_bf16(bflo(w.w) * rs * g1[2], bfhi(w.w) * rs * g1[3]);
            qr[j] = __builtin_bit_cast(bf16x8, o); }
    }
    const LAS unsigned char* qpark = ldsb + AT_STG + wid * 4096 + lane * 16;
    if (NMAP == 2) {
#pragma unroll
        for (int j = 4; j < 8; ++j) { const bf16x8 t_ = *(const bf16x8*)(Qw + (size_t)r32 * pitchQ + 16 * j + 8 * hi); *(LAS bf16x8*)(ldsb + AT_STG + wid * 4096 + lane * 16 + (j - 4) * 1024) = t_; } }
    const bf16* ksrc = Kp + (size_t)lane * pitchK + wid * 8;
    const bf16* vsrc = Vp + (size_t)(16 * (wid & 3) + (lane >> 2)) * pitchV + (wid >> 2) * 32 + (lane & 3) * 8;
#define AT_DMA(t, slot) do { const unsigned _sb = lds0 + (unsigned)(slot) * AT_SLOT; \
        glds16(ksrc + (size_t)(t) * 64 * pitchK, (unsigned)__builtin_amdgcn_readfirstlane(_sb + wid * 1024)); \
        glds16(ksrc + (size_t)(t) * 64 * pitchK + 64, (unsigned)__builtin_amdgcn_readfirstlane(_sb + (wid + 8) * 1024)); \
        glds16(vsrc + (size_t)(t) * 64 * pitchV, (unsigned)__builtin_amdgcn_readfirstlane(_sb + AT_V + wid * 1024)); \
        glds16(vsrc + (size_t)(t) * 64 * pitchV + 64, (unsigned)__builtin_amdgcn_readfirstlane(_sb + AT_V + (wid + 8) * 1024)); } while (0)
    const LAS unsigned char* kp0 = ldsb + hi * 1024 + r32 * 16;
    const LAS unsigned char* vp0 = ldsb + AT_V + ((lane >> 4) & 1) * 32 + (lane & 3) * 8 + (4 * hi + ((lane & 15) >> 2)) * 64;
    f32x16 o[NMAP][4];
#pragma unroll
    for (int m = 0; m < NMAP; ++m)
#pragma unroll
        for (int d = 0; d < 4; ++d) o[m][d] = (f32x16){};
    float lsum[NMAP];
#pragma unroll
    for (int m = 0; m < NMAP; ++m) lsum[m] = 0.f;
    AT_DMA(0, 0);
    if (NT > 1) AT_DMA(1, 1);
    int slot = 0;
#pragma unroll 1
    for (int t = 0; t < NT; ++t) {
        if (t + 1 < NT) asm volatile("s_waitcnt vmcnt(4)" ::: "memory"); else asm volatile("s_waitcnt vmcnt(0)" ::: "memory");
        __builtin_amdgcn_s_barrier(); asm volatile("" ::: "memory");
        if (t + 2 < NT) { const int s2 = slot == 0 ? 2 : slot - 1; AT_DMA(t + 2, s2); }
        if (t < ntv) {
            const LAS unsigned char* kp = kp0 + slot * AT_SLOT; const LAS unsigned char* vp = vp0 + slot * AT_SLOT;
#define AT_SB() __builtin_amdgcn_sched_barrier(0)
#pragma unroll
            for (int m = 0; m < NMAP; ++m) {
                constexpr int JN = 8 / NMAP;
#pragma unroll
                for (int hk = 0; hk < 2; ++hk) {
                    f32x16 p = (f32x16){};
                    bf16x8 kb = *(const LAS bf16x8*)(kp + (m * JN) * 2048 + hk * 512);
                    AT_SB();
#pragma unroll
                    for (int jj = 0; jj < JN; ++jj) { const int j = m * JN + jj; bf16x8 nb = kb;
                        if (jj + 1 < JN) nb = *(const LAS bf16x8*)(kp + (j + 1) * 2048 + hk * 512);
                        const bf16x8 qf = (NMAP == 2 && m == 1) ? *(const LAS bf16x8*)(qpark + jj * 1024) : qr[(NMAP == 2 && m == 1) ? 0 : j];
                        p = __builtin_amdgcn_mfma_f32_32x32x16_bf16(kb, qf, p, 0, 0, 0);
                        AT_SB(); kb = nb; }
                    s16x4 lo = vtr(vp + (2 * hk) * 1024), hh = vtr(vp + (2 * hk) * 1024 + 512);
                    float s = 0.f;
#pragma unroll
                    for (int r = 0; r < 16; ++r) { p[r] = fast_exp2(p[r]); s += p[r]; }
                    lsum[m] += s;
                    u32x4 pw[2];
                    pw[0] = (u32x4){cvt_pk_bf16(p[0], p[1]), cvt_pk_bf16(p[2], p[3]), cvt_pk_bf16(p[4], p[5]), cvt_pk_bf16(p[6], p[7])};
                    pw[1] = (u32x4){cvt_pk_bf16(p[8], p[9]), cvt_pk_bf16(p[10], p[11]), cvt_pk_bf16(p[12], p[13]), cvt_pk_bf16(p[14], p[15])};
                    AT_SB();
#pragma unroll
                    for (int idx = 0; idx < 8; ++idx) { const int d0 = idx >> 1, ksl = idx & 1;
                        const bf16x8 vf = (bf16x8){lo[0], lo[1], lo[2], lo[3], hh[0], hh[1], hh[2], hh[3]};
                        if (idx + 1 < 8) { const int nd0 = (idx + 1) >> 1, nks = 2 * hk + ((idx + 1) & 1); lo = vtr(vp + (nd0 * 4 + nks) * 1024); hh = vtr(vp + (nd0 * 4 + nks) * 1024 + 512); }
                        o[m][d0] = __builtin_amdgcn_mfma_f32_32x32x16_bf16(__builtin_bit_cast(bf16x8, pw[ksl]), vf, o[m][d0], 0, 0, 0);
                        AT_SB(); }
                }
            }
#undef AT_SB
        }
        slot = slot == 2 ? 0 : slot + 1;
    }
#undef AT_DMA
    int hie = hi, r32e = r32, lanee = lane;
    asm volatile("" : "+v"(hie), "+v"(r32e), "+v"(lanee));
    float inv[NMAP];
#pragma unroll
    for (int m = 0; m < NMAP; ++m) { const float l = xor32_sum(lsum[m]); inv[m] = 1.0f / l; }
    float gsub[4];
#pragma unroll
    for (int d0 = 0; d0 < 4; ++d0) gsub[d0] = (NMAP == 2) ? subln[32 * d0 + r32e] * oscale : oscale;
    LAS bf16* stg = (LAS bf16*)(ldsb + AT_STG + wid * 4096);
#pragma unroll
    for (int half = 0; half < 2; ++half) {
#pragma unroll
        for (int rr = 0; rr < 8; ++rr) { const int r = half * 8 + rr; const int orow = crow(r, hie);
            const float i0 = __shfl(inv[0], orow); float val[4];
            if (NMAP == 2) { const float i1 = __shfl(inv[NMAP - 1], orow) * lam; float ss = 0.f;
#pragma unroll
                for (int d0 = 0; d0 < 4; ++d0) { val[d0] = o[0][d0][r] * i0 - o[NMAP - 1][d0][r] * i1; ss += val[d0] * val[d0]; }
                ss += swz_xor<1>(ss); ss += swz_xor<2>(ss); ss += swz_xor<4>(ss); ss += swz_xor<8>(ss); ss += swz_xor<16>(ss);
                const float rstd = rsqrtf(ss * (1.f / 128.f) + EPS);
#pragma unroll
                for (int d0 = 0; d0 < 4; ++d0) val[d0] *= rstd;
            } else {
#pragma unroll
                for (int d0 = 0; d0 < 4; ++d0) val[d0] = o[0][d0][r] * i0; }
#pragma unroll
            for (int d0 = 0; d0 < 4; ++d0) stg[(orow & 15) * 128 + d0 * 32 + r32e] = (bf16)(cvt_pk_bf16(val[d0] * gsub[d0], 0.f) & 0xffffu);
            __builtin_amdgcn_sched_barrier(0); }
        LDS_WAIT();
#pragma unroll
        for (int i = 0; i < 4; ++i) { const int id = i * 64 + lanee, row = id >> 4, ch = id & 15; const u32x4 v = *(const LAS u32x4*)(stg + row * 128 + ch * 8);
            *(u32x4*)(Ow + (size_t)(16 * half + row) * pitchO + ch * 8) = v; }
        LDS_WAIT();
    }
    asm volatile("s_waitcnt lgkmcnt(0)" ::: "memory"); __builtin_amdgcn_s_barrier(); asm volatile("" ::: "memory");
}

__device__ __forceinline__ float softmax_cref(const float* gq, const float* gk, int n, float dotscale, int lane) {
    float a = 0.f, b = 0.f;
    for (int d = lane; d < n; d += 64) { a = fmaxf(a, fabsf(gq[d])); b = fmaxf(b, fabsf(gk[d])); }
    a = wave_max(a); b = wave_max(b);
    return fmaxf(0.f, (float)n * dotscale * a * b * LOG2E - 100.f);
}

#ifndef PROBE_VAR
#define PROBE_VAR 0
#endif
constexpr int A2_KS = 16384, A2_V = 3 * 16384, A2_NV = 5;
static_assert(A2_V + A2_NV * 16384 <= RING_BYTES, "attention LDS map");
#define A2_SB() __builtin_amdgcn_sched_barrier(0)
#define A2_PV(S_, PWA) do { const int s_ = (S_); \
              const bf16x8 vf_ = (bf16x8){vl_[s_ & 1][0], vl_[s_ & 1][1], vl_[s_ & 1][2], vl_[s_ & 1][3], vh_[s_ & 1][0], vh_[s_ & 1][1], vh_[s_ & 1][2], vh_[s_ & 1][3]}; \
              if (s_ + 2 < 16) { const int pc_ = ((s_ + 2) & 3) * 4 + ((s_ + 2) >> 2); vl_[s_ & 1] = vtr(vp_ + pc_ * 1024); vh_[s_ & 1] = vtr(vp_ + pc_ * 1024 + 512); } \
              o[s_ & 3] = __builtin_amdgcn_mfma_f32_32x32x16_bf16(__builtin_bit_cast(bf16x8, PWA[s_ >> 2]), vf_, o[s_ & 3], 0, 0, 0); } while (0)
#define A2_ITER(t, PC0, PC1, PN0, PN1, PW, PWN, VISX, MAINX) do { \
        if (MAINX) {              \
            asm volatile("s_waitcnt vmcnt(4)" ::: "memory"); \
            __builtin_amdgcn_s_barrier(); asm volatile("" ::: "memory"); \
            A2_DMA((t) + 2, (ks3_ == 0 ? 2 : ks3_ - 1), (vs5_ >= 3 ? vs5_ - 3 : vs5_ + 2)); \
        } else if ((t) < NT) { \
            if ((t) + 1 < NT) asm volatile("s_waitcnt vmcnt(4)" ::: "memory"); else asm volatile("s_waitcnt vmcnt(0)" ::: "memory"); \
            __builtin_amdgcn_s_barrier(); asm volatile("" ::: "memory"); \
            if ((t) + 2 < NT) { A2_DMA((t) + 2, (ks3_ == 0 ? 2 : ks3_ - 1), (vs5_ >= 3 ? vs5_ - 3 : vs5_ + 2)); } \
        } \
        const bool vis_ = (VISX); \
        const LAS unsigned char* kp_ = ldsb + ks3_ * A2_KS; \
        const LAS unsigned char* vp_ = vp0 + ((t) >= 2 ? (vs5_ >= 2 ? vs5_ - 2 : vs5_ + 3) : 0) * 16384; \
        ks3_ = ks3_ == 2 ? 0 : ks3_ + 1; vs5_ = vs5_ == 4 ? 0 : vs5_ + 1;        \
        bf16x8 kq_[2]; s16x4 vl_[2], vh_[2]; \
        kq_[0] = *(const LAS bf16x8*)(kp_ + kad[0]); kq_[1] = *(const LAS bf16x8*)(kp_ + kad[0] + 8192); \
        _Pragma("unroll") for (int i_ = 0; i_ < 2; ++i_) { vl_[i_] = vtr(vp_ + (i_ * 4) * 1024); vh_[i_] = vtr(vp_ + (i_ * 4) * 1024 + 512); } \
        A2_SB(); \
        _Pragma("unroll") for (int i_ = 0; i_ < 8; ++i_) { \
            { const bf16x8 kf_ = kq_[i_ & 1]; \
              if (i_ + 2 < 8) kq_[i_ & 1] = *(const LAS bf16x8*)(kp_ + kad[(i_ + 2) >> 1] + ((i_ + 2) & 1) * 8192); \
              if (vis_) { if (i_ == 0) PN0 = __builtin_amdgcn_mfma_f32_32x32x16_bf16(kf_, qr[0], (f32x16){}, 0, 0, 0); else if (i_ == 1) PN1 = __builtin_amdgcn_mfma_f32_32x32x16_bf16(kf_, qr[0], (f32x16){}, 0, 0, 0); \
                          else if (i_ & 1) PN1 = __builtin_amdgcn_mfma_f32_32x32x16_bf16(kf_, qr[i_ >> 1], PN1, 0, 0, 0); else PN0 = __builtin_amdgcn_mfma_f32_32x32x16_bf16(kf_, qr[i_ >> 1], PN0, 0, 0, 0); } \
              if (i_ == 0) KEEP_AB(PN0, kf_, qr[0]); if (i_ == 1) KEEP_AB(PN1, kf_, qr[0]); } \
            A2_SB(); \
              \
            float e0_ = fast_exp2(PC0[2 * i_]), e1_ = fast_exp2(PC0[2 * i_ + 1]); \
            asm volatile("" : "+v"(e0_), "+v"(e1_)); \
            A2_SB(); \
            A2_PV(2 * i_, PW); \
            A2_SB(); \
            float e2_ = fast_exp2(PC1[2 * i_]), e3_ = fast_exp2(PC1[2 * i_ + 1]); \
            asm volatile("" : "+v"(e2_), "+v"(e3_)); \
            A2_SB(); \
            A2_PV(2 * i_ + 1, PW); \
            A2_SB(); \
            s0 += e0_ + e1_; s1 += e2_ + e3_; asm volatile("" : "+v"(s0), "+v"(s1));        \
            PWN[i_ >> 2][i_ & 3] = cvt_pk_bf16(e0_, e1_); PWN[2 + (i_ >> 2)][i_ & 3] = cvt_pk_bf16(e2_, e3_); \
            A2_SB(); \
        } \
        if (!vis_) { _Pragma("unroll") for (int r_ = 0; r_ < 16; ++r_) { PN0[r_] = -INFINITY; PN1[r_] = -INFINITY; } } \
    } while (0)
template <int VAR>
__device__ __forceinline__ void attn2_unit(LAS unsigned char* ldsb, const bf16* Qw  , const bf16* Kp, const bf16* Vp,
                                           int NT, int ntv, bf16* Ow  , float lam, const float* subln) {
    int tid = threadIdx.x; asm volatile("" : "+v"(tid));
    const int lane = tid & 63, r32 = lane & 31, hi = lane >> 5; const int wid = __builtin_amdgcn_readfirstlane(tid >> 6); const int g = wid & 3, m = wid >> 2;
    const unsigned lds0 = (unsigned)(size_t)ldsb;
    bf16x8 qr[4];
#pragma unroll
    for (int j = 0; j < 4; ++j) qr[j] = *(const bf16x8*)(Qw + (size_t)r32 * DM + 16 * j + 8 * hi);
    asm volatile("s_waitcnt vmcnt(0)" : "+v"(qr[0]), "+v"(qr[1]), "+v"(qr[2]), "+v"(qr[3]) :: "memory");
    const int kkey = 4 * wid + (lane >> 4);
    const bf16* ksrc = Kp + (size_t)kkey * DM + (((lane & 15) ^ (kkey & 15)) << 3);
    const bf16* vsrc = Vp + (size_t)(16 * (wid & 3) + (lane >> 2)) * DM + (wid >> 2) * 32 + (lane & 3) * 8;
#define A2_DMA(t, ks, vs) do { const unsigned _kb = lds0 + (unsigned)(ks) * A2_KS, _vb = lds0 + A2_V + (unsigned)(vs) * 16384; \
        glds16(ksrc + (size_t)(t) * 64 * DM, (unsigned)__builtin_amdgcn_readfirstlane(_kb + wid * 1024)); \
        glds16(ksrc + (size_t)((t) * 64 + 32) * DM, (unsigned)__builtin_amdgcn_readfirstlane(_kb + (wid + 8) * 1024)); \
        glds16(vsrc + (size_t)(t) * 64 * DM, (unsigned)__builtin_amdgcn_readfirstlane(_vb + wid * 1024)); \
        glds16(vsrc + (size_t)(t) * 64 * DM + 64, (unsigned)__builtin_amdgcn_readfirstlane(_vb + (wid + 8) * 1024)); } while (0)
    unsigned kad[4];
#pragma unroll
    for (int jj = 0; jj < 4; ++jj) kad[jj] = (unsigned)(r32 * 256 + ((((8 * m + 2 * jj + hi) ^ (r32 & 15))) << 4));
    const LAS unsigned char* vp0 = ldsb + A2_V + ((lane >> 4) & 1) * 32 + (lane & 3) * 8 + (4 * hi + ((lane & 15) >> 2)) * 64;
    f32x16 o[4];
#pragma unroll
    for (int d = 0; d < 4; ++d) o[d] = (f32x16){};
    float s0 = 0.f, s1 = 0.f;
    u32x4 pwA[4], pwB[4];
#pragma unroll
    for (int i = 0; i < 4; ++i) { pwA[i] = (u32x4){0u, 0u, 0u, 0u}; pwB[i] = (u32x4){0u, 0u, 0u, 0u}; }
    f32x16 pA0, pA1, pB0, pB1;
#pragma unroll
    for (int r = 0; r < 16; ++r) { pA0[r] = -INFINITY; pA1[r] = -INFINITY; pB0[r] = -INFINITY; pB1[r] = -INFINITY; }
    A2_DMA(0, 0, 0);
    if (NT > 1) A2_DMA(1, 1, 1);
    int ks3_ = 0, vs5_ = 0;
    int t = 0;
#pragma unroll 1
    for (; t + 2 < NT; t += 2) {
        A2_ITER(t,     pA0, pA1, pB0, pB1, pwA, pwB, true, true);
        A2_ITER(t + 1, pB0, pB1, pA0, pA1, pwB, pwA, true, true);
    }
#pragma unroll 1
    for (; t < NT + 2; t += 2) {
        A2_ITER(t,     pA0, pA1, pB0, pB1, pwA, pwB, (t) < ntv, false);
        A2_ITER(t + 1, pB0, pB1, pA0, pA1, pwB, pwA, (t + 1) < ntv, false);
    }
#undef A2_DMA
    asm volatile("s_waitcnt lgkmcnt(0)" ::: "memory"); __builtin_amdgcn_s_barrier(); asm volatile("" ::: "memory");
    int tid2 = threadIdx.x; asm volatile("" : "+v"(tid2));
    const int lanee = tid2 & 63, r32e = lanee & 31, hie = lanee >> 5;
    const float inv = 1.0f / xor32_sum(s0 + s1);
    LAS float* exch = (LAS float*)(ldsb + g * 16384) + lanee;
    if (m == 1) {
#pragma unroll
        for (int r = 0; r < 16; ++r) { const float ir = __shfl(inv, crow(r, hie)) * lam;
#pragma unroll
            for (int d0 = 0; d0 < 4; ++d0) exch[(d0 * 16 + r) * 64] = o[d0][r] * ir; }
    }
    asm volatile("s_waitcnt lgkmcnt(0)" ::: "memory"); __builtin_amdgcn_s_barrier(); asm volatile("" ::: "memory");
    if (m == 0) {
        float gsub[4];
#pragma unroll
        for (int d0 = 0; d0 < 4; ++d0) gsub[d0] = subln[32 * d0 + r32e] * 0.8f;
        LAS bf16* stg = (LAS bf16*)(ldsb + 65536 + g * 4096);
#pragma unroll
        for (int half = 0; half < 2; ++half) {
#pragma unroll
            for (int rr = 0; rr < 8; ++rr) { const int r = half * 8 + rr; const int orow = crow(r, hie);
                const float i0 = __shfl(inv, orow); float val[4]; float ss = 0.f;
#pragma unroll
                for (int d0 = 0; d0 < 4; ++d0) { val[d0] = o[d0][r] * i0 - exch[(d0 * 16 + r) * 64]; ss += val[d0] * val[d0]; }
                ss += swz_xor<1>(ss); ss += swz_xor<2>(ss); ss += swz_xor<4>(ss); ss += swz_xor<8>(ss); ss += swz_xor<16>(ss);
                const float rstd = rsqrtf(ss * (1.f / 128.f) + EPS);
#pragma unroll
                for (int d0 = 0; d0 < 4; ++d0) stg[(orow & 15) * 128 + d0 * 32 + r32e] = (bf16)(cvt_pk_bf16(val[d0] * rstd * gsub[d0], 0.f) & 0xffffu);
                __builtin_amdgcn_sched_barrier(0); }
            LDS_WAIT();
#pragma unroll
            for (int i = 0; i < 4; ++i) { const int id = i * 64 + lanee, row = id >> 4, ch = id & 15; const u32x4 v = *(const LAS u32x4*)(stg + row * 128 + ch * 8);
                *(u32x4*)(Ow + (size_t)(16 * half + row) * DM + ch * 8) = v; }
            LDS_WAIT();
        }
    }
    asm volatile("s_waitcnt lgkmcnt(0)" ::: "memory"); __builtin_amdgcn_s_barrier(); asm volatile("" ::: "memory");
}
__device__ __forceinline__ void diffattn_phase(const Args& args, LAS unsigned char* lds, int vcu, int G, bf16* Oreal, bf16* Odmy, int nrep) {
    unsigned char* ws = args.ws;
    const int lane = threadIdx.x & 63, wid = __builtin_amdgcn_readfirstlane(threadIdx.x >> 6), g = wid & 3, m = wid >> 2;
    const bf16* Q = (const bf16*)(ws + WS_Q); const bf16* Kb = (const bf16*)(ws + WS_K); const bf16* Vb = (const bf16*)(ws + WS_V);
    float lam;
    { const float a = ((const float*)args.in[I_LQ1])[lane] * ((const float*)args.in[I_LK1])[lane], b = ((const float*)args.in[I_LQ2])[lane] * ((const float*)args.in[I_LK2])[lane];
      lam = expf(wave_sum(a)) - expf(wave_sum(b)) + 0.2f; lam = __uint_as_float(__builtin_amdgcn_readfirstlane(__float_as_uint(lam))); }
    for (int pp = vcu; pp < nrep * NB * 8 * 16; pp += G) {
        const int p = pp & 2047; bf16* O = (pp >> 11) ? Odmy : Oreal;
        const int bh = p >> 4, s = p & 15, b = bh >> 3, h = bh & 7;
#pragma unroll 1
        for (int half = 0; half < 2; ++half) {
            const int qb = half ? 31 - s : s;
            const size_t row0 = (size_t)b * SEQ + 128 * qb + 32 * g;
            if ((pp >> 11) == 0)
            attn2_unit<0>(lds, Q + row0 * DM + h * 128 + m * 64, Kb + (size_t)b * SEQ * DM + h * 128, Vb + (size_t)b * SEQ * DM + h * 128,
                       2 * qb + 2, 2 * qb + (g >> 1) + 1, O + row0 * DM + h * 128, lam, (const float*)args.in[I_SUBLN]);
#if PROBE_VAR
            else
            attn2_unit<PROBE_VAR>(lds, Q + row0 * DM + h * 128 + m * 64, Kb + (size_t)b * SEQ * DM + h * 128, Vb + (size_t)b * SEQ * DM + h * 128,
                       2 * qb + 2, 2 * qb + (g >> 1) + 1, O + row0 * DM + h * 128, lam, (const float*)args.in[I_SUBLN]);
#endif
        }
    }
}
__device__ __forceinline__ void crossattn_phase(const Args& args, LAS unsigned char* lds, int vcu, int G) {
    unsigned char* ws = args.ws;
    const int lane = threadIdx.x & 63, wid = __builtin_amdgcn_readfirstlane(threadIdx.x >> 6);
    const bf16* QC = (const bf16*)(ws + WS_QC); const bf16* KV = (const bf16*)(ws + WS_KVC); bf16* OC = (bf16*)(ws + WS_OC);
    const float cref = softmax_cref((const float*)args.in[I_CQ_NORM], (const float*)args.in[I_CK_NORM], 128, 0.08838834764831845f, lane);
#pragma unroll 1
    for (int p = vcu; p < NB * 4 * 16; p += G) {
        const int b = p >> 6, h = (p >> 4) & 3, qb = p & 15;
        const size_t row0 = (size_t)b * SEQ + 256 * qb + 32 * wid;
        attn_unit<1>(lds, QC + row0 * 512 + h * 128, 512, KV + (size_t)b * MEMTOK * DM + h * 128, DM, KV + (size_t)b * MEMTOK * DM + 512 + h * 128, DM,
                     4, 4, OC + row0 * 512 + h * 128, 512, cref, 0.f, nullptr, 1.0f, (const float*)args.in[I_CQ_NORM], 0.08838834764831845f * LOG2E);
    }
}

template <class Sched>
__device__ __forceinline__ void router_select(const Args& args, LAS unsigned char* lds, const Sched& S) {
    unsigned char* ws = args.ws;
    const int tid = threadIdx.x;
    LAS int* cnt_l = (LAS int*)lds; LAS int* base_l = cnt_l + 64;
    const float* logit = (const float*)(ws + WS_LOGIT); const float* rss = (const float*)(ws + WS_RSS2);
    float* rstd2 = (float*)(ws + WS_RSTD2); float* wts = (float*)(ws + WS_WTS); int* idx = (int*)(ws + WS_IDX); int* asg = (int*)(ws + WS_ASG); unsigned* gcnt = (unsigned*)(ws + WS_CTL) + CW_CNT;
    const float* bg = (const float*)args.in[I_B_GROUP]; const float* br = (const float*)args.in[I_B_ROUTER];
    VM_WAIT(); __syncthreads();
    __builtin_amdgcn_fence(__ATOMIC_ACQUIRE, "agent"); VM_WAIT();
    pg8::Unit u;
    for (int i = 0; S.next(i, u); ++i) {
        if (tid < 64) cnt_l[tid] = 0;
        __syncthreads();
        int row = 0, b0 = 0, b1 = 0, rk0 = 0, rk1 = 0; float w0 = 0.f, w1 = 0.f;
        if (tid < 256) {
            row = u.pm * 256 + tid;
            const f32x4* p = (const f32x4*)(rss + (size_t)row * 16); const f32x4 s0 = p[0], s1 = p[1], s2 = p[2], s3 = p[3];
            const float ss = ((s0[0] + s0[1]) + (s0[2] + s0[3])) + ((s1[0] + s1[1]) + (s1[2] + s1[3])) + ((s2[0] + s2[1]) + (s2[2] + s2[3])) + ((s3[0] + s3[1]) + (s3[2] + s3[3]));
            const float rstd = rsqrtf(ss * (1.0f / DM) + EPS); rstd2[row] = rstd;
            { const f32x4* q = (const f32x4*)((const float*)(ws + WS_RSS1) + (size_t)row * 16); const f32x4 m0 = q[0], m1 = q[1], m2 = q[2], m3 = q[3];
              const float mx = fmaxf(fmaxf(fmaxf(fmaxf(m0[0], m0[1]), fmaxf(m0[2], m0[3])), fmaxf(fmaxf(m1[0], m1[1]), fmaxf(m1[2], m1[3]))), fmaxf(fmaxf(fmaxf(m2[0], m2[1]), fmaxf(m2[2], m2[3])), fmaxf(fmaxf(m3[0], m3[1]), fmaxf(m3[2], m3[3]))));
              const float sc = mx > 0.f ? mx * (1.0f / 127.0f) : 1.0f; ((float*)(ws + WS_XS2))[row] = sc; ((LAS float*)(lds + 1024))[tid] = 1.0f / sc; }
            const f32x4* lp = (const f32x4*)(logit + (size_t)row * 64);
            const f32x4 gl4 = lp[0];
            float gl[4]; int gi = 0;
#pragma unroll
            for (int j = 0; j < 4; ++j) gl[j] = gl4[j] * rstd + bg[j];
            float gm = gl[0];
#pragma unroll
            for (int j = 1; j < 4; ++j) if (gl[j] > gm) { gm = gl[j]; gi = j; }
            float den = 0.f;
#pragma unroll
            for (int j = 0; j < 4; ++j) den += expf(gl[j] - gm);
            const float gval = 1.0f / den;
            const f32x4 e0 = lp[1 + 2 * gi], e1 = lp[2 + 2 * gi];
            float el[8];
#pragma unroll
            for (int j = 0; j < 4; ++j) { el[j] = e0[j] * rstd + br[gi * 8 + j]; el[4 + j] = e1[j] * rstd + br[gi * 8 + 4 + j]; }
            int i0 = 0; float v0 = el[0];
#pragma unroll
            for (int j = 1; j < 8; ++j) if (el[j] > v0) { v0 = el[j]; i0 = j; }
            int i1 = -1; float v1 = -INFINITY;
#pragma unroll
            for (int j = 0; j < 8; ++j) if (j != i0 && el[j] > v1) { v1 = el[j]; i1 = j; }
            const float ex = expf(v1 - v0); w0 = gval / (1.0f + ex); w1 = gval * ex / (1.0f + ex);
            b0 = gi * 8 + i0; b1 = 32 + gi * 8 + i1;
            rk0 = atomicAdd((int*)&cnt_l[b0], 1); rk1 = atomicAdd((int*)&cnt_l[b1], 1);
        }
        __syncthreads();
        if (tid < 64) base_l[tid] = (int)__hip_atomic_fetch_add(gcnt + tid, (unsigned)cnt_l[tid], __ATOMIC_RELAXED, __HIP_MEMORY_SCOPE_AGENT);
        __syncthreads();
        {
          const bf16* xb = (const bf16*)(ws + WS_X2B) + (size_t)u.pm * 256 * DM; unsigned char* xq = ws + WS_X2Q + (size_t)u.pm * 256 * DM; const LAS float* invs = (const LAS float*)(lds + 1024);
          for (int p = tid; p < 256 * 64; p += NWAVES * 64) { const int r = p >> 6, c = (p & 63) * 16; const float inv = invs[r];
              const u32x4 a = *(const u32x4*)(xb + (size_t)r * DM + c), b = *(const u32x4*)(xb + (size_t)r * DM + c + 8);
              u32x4 o; o.x = pack_i8x4(bflo(a.x) * inv, bfhi(a.x) * inv, bflo(a.y) * inv, bfhi(a.y) * inv); o.y = pack_i8x4(bflo(a.z) * inv, bfhi(a.z) * inv, bflo(a.w) * inv, bfhi(a.w) * inv);
              o.z = pack_i8x4(bflo(b.x) * inv, bfhi(b.x) * inv, bflo(b.y) * inv, bfhi(b.y) * inv); o.w = pack_i8x4(bflo(b.z) * inv, bfhi(b.z) * inv, bflo(b.w) * inv, bfhi(b.w) * inv);
              *(u32x4*)(xq + (size_t)r * DM + c) = o; } }
        if (tid < 256) { idx[(size_t)b0 * MTOK + base_l[b0] + rk0] = row; idx[(size_t)b1 * MTOK + base_l[b1] + rk1] = row; wts[(size_t)row * 2] = w0; wts[(size_t)row * 2 + 1] = w1;
            asg[(size_t)row * 2] = (b0 << 20) | (base_l[b0] + rk0); asg[(size_t)row * 2 + 1] = (b1 << 20) | (base_l[b1] + rk1); }
        __syncthreads();
    }
}
__device__ __forceinline__ void moe_tables(const Args& args, LAS int* pblk, LAS int* cntl) {
    const unsigned* gcnt = (const unsigned*)(args.ws + WS_CTL) + CW_CNT;
    if (threadIdx.x < 64) cntl[threadIdx.x] = (int)__hip_atomic_load(gcnt + threadIdx.x, __ATOMIC_RELAXED, __HIP_MEMORY_SCOPE_AGENT);
    __syncthreads();
    if (threadIdx.x == 0) { int acc = 0; for (int j = 0; j < 64; ++j) { pblk[j] = acc; acc += (cntl[j] + 255) >> 8; } pblk[64] = acc;
        LAS int* cst = cntl + 64; int a2 = 0; for (int j = 0; j < 64; ++j) { if (j == 32) a2 = 0; cst[j] = a2; a2 += cntl[j]; } }
    __syncthreads();
}

__device__ __forceinline__ void moe_combine_phase(const Args& args, const LAS int* cst, int gw, int NGW, int lane) {
    unsigned char* ws = args.ws;
    const bf16* x2b = (const bf16*)(ws + WS_X2B); const bf16* y0 = (const bf16*)(ws + WS_S0); const bf16* y1 = (const bf16*)(ws + WS_S4);
    const float* wts = (const float*)(ws + WS_WTS); const int* asg = (const int*)(ws + WS_ASG);
    int2 an[2]; float2 wn[2];
#pragma unroll
    for (int t = 0; t < 2; ++t) { const int tk = gw + t * NGW; const bool ok = tk < MTOK; an[t] = ok ? *(const int2*)(asg + (size_t)tk * 2) : make_int2(0, 0); wn[t] = ok ? *(const float2*)(wts + (size_t)tk * 2) : make_float2(0.f, 0.f); }
    for (int tok = gw; tok < MTOK; tok += 2 * NGW) {
        int2 ac[2]; float2 wc2[2];
#pragma unroll
        for (int t = 0; t < 2; ++t) { ac[t] = an[t]; wc2[t] = wn[t]; }
#pragma unroll
        for (int t = 0; t < 2; ++t) { const int tk = tok + (2 + t) * NGW; const bool ok = tk < MTOK; an[t] = ok ? *(const int2*)(asg + (size_t)tk * 2) : make_int2(0, 0); wn[t] = ok ? *(const float2*)(wts + (size_t)tk * 2) : make_float2(0.f, 0.f); }
        u32x2 xv[2][4], p[2][4], q[2][4];
#pragma unroll
        for (int t = 0; t < 2; ++t) { const int tk = tok + t * NGW; if (tk < MTOK) {
            const size_t r0 = (size_t)(cst[ac[t].x >> 20] + (ac[t].x & 0xfffff)), r1 = (size_t)(cst[ac[t].y >> 20] + (ac[t].y & 0xfffff));
#pragma unroll
            for (int k = 0; k < 4; ++k) { const int c = 4 * lane + 256 * k;
                xv[t][k] = *(const u32x2*)(x2b + (size_t)tk * DM + c); p[t][k] = *(const u32x2*)(y0 + r0 * DM + c); q[t][k] = *(const u32x2*)(y1 + r1 * DM + c); } } }
#pragma unroll
        for (int t = 0; t < 2; ++t) { const int tk = tok + t * NGW; if (tk < MTOK) { const float w0 = wc2[t].x, w1 = wc2[t].y;
#pragma unroll
            for (int k = 0; k < 4; ++k) { const int c = 4 * lane + 256 * k; const u32x2 X = xv[t][k], P = p[t][k], Q = q[t][k]; f32x4 o;
                o[0] = bflo(X.x) + w0 * bflo(P.x) + w1 * bflo(Q.x); o[1] = bfhi(X.x) + w0 * bfhi(P.x) + w1 * bfhi(Q.x); o[2] = bflo(X.y) + w0 * bflo(P.y) + w1 * bflo(Q.y); o[3] = bfhi(X.y) + w0 * bfhi(P.y) + w1 * bfhi(Q.y);
                __builtin_nontemporal_store(o, (f32x4*)(args.out + (size_t)tk * DM + c)); } } }
    }
}

constexpr int N_PHASES = 17;
__global__ void __launch_bounds__(NWAVES * 64, 2) fwd_kernel(Args args) {
    extern __shared__ __attribute__((aligned(16))) unsigned char lds_raw[];
    LAS unsigned char* lds = (LAS unsigned char*)lds_raw;
    volatile LAS unsigned* MISC = (volatile LAS unsigned*)(lds + MISC_OFF);
    const int tid = threadIdx.x, lane = tid & 63, wave = __builtin_amdgcn_readfirstlane(tid >> 6);
    const int G = gridDim.x; const int bx = blockIdx.x; const int vcu = (G % 8 == 0) ? (bx % 8) * (G / 8) + bx / 8 : bx;
    const int gw = vcu * NWAVES + wave, NGW = G * NWAVES;
    unsigned char* ws = args.ws;
    for (int u = tid; u < (LDS_BYTES - MISC_OFF) / 4; u += NWAVES * 64) MISC[u] = 0u;
    __syncthreads();
    const int lo = args.ph_lo, hi = args.ph_hi;
    XcdBarrier bar; bar.bar = (unsigned*)(ws + WS_CTL) + CW_BAR + args.li * XCD_BAR_WORDS; bar.x = 0; bar.st = nullptr;
    bar = xcd_barrier_post((unsigned*)(ws + WS_CTL) + CW_BAR + args.li * XCD_BAR_WORDS, MISC);
    LAS int* pblk = (LAS int*)(lds + MISC_OFF + 64); LAS int* cntl = pblk + 72;
#ifndef PH_MASK
#define PH_MASK 0x1ffff
#endif
#define IN(k) (((PH_MASK >> (k)) & 1) && lo <= (k) && (k) < hi)
#define SEAM(k) do { if (IN(k) && IN((k) + 1)) xcd_barrier(bar); } while (0)
    using namespace pg8;

#ifndef PROBE_DUP
#define PROBE_DUP 0
#endif
#define REPS(k) (1 + ((PROBE_DUP >> (k)) & 1))
    unsigned char* const dmyA = ws + WS_QC;
    if (IN(0)) { _Pragma("unroll") for (int rep = 0; rep < REPS(0); ++rep) prologue_phase(args, lds, vcu, G, wave, lane);
        xcd_barrier(bar);
        if (G >= 128 && bx < 64) {
            DenseOrder S; S.init(ws + WS_MEMN, ws + WS_WCKV, MEMROWS, DM, DM, 64, bx);
            EpiAct E{(bf16*)(ws + WS_KVC), 0, 0, DM, nullptr, nullptr};
            gemm_phase<EpiAct, DenseOrder, true, false>(lds, DM, S, E);
        } else {
          const bool split = G >= 128; const int qw = split ? bx - 64 : bx, QW = split ? G - 64 : G;
          LAS float* red = (LAS float*)lds; LAS float* gain_l = (LAS float*)(lds + 4096);
          for (int k = tid; k < DM; k += NWAVES * 64) gain_l[k] = ((const float*)args.in[I_NORM_FFN])[k];
          __syncthreads();
          for (int it = qw; it < NWIN / 32 + NEXP * 32; it += QW) {
              if (it < NWIN / 32) colquant_wg_item((const float*)args.in[I_W_IN], NWIN, 32 * it, win_dest(32 * it), nullptr, ws + WS_WIN, (float*)(ws + WS_WSC), red, tid);
              else { const int r = it - NWIN / 32, e = r >> 5, nb = r & 31;
                  colquant_wg_item((const float*)args.in[I_W_GATE_UP] + (size_t)e * DM * 1024, 1024, 32 * nb, gu_dest(32 * nb), gain_l, ws + WS_WGU + (size_t)e * 1024 * DM, (float*)(ws + WS_WSC2) + e * 1024, red, tid); } }
          if (!split) { DenseOrder S; S.init(ws + WS_MEMN, ws + WS_WCKV, MEMROWS, DM, DM, G, bx);
            EpiAct E{(bf16*)(ws + WS_KVC), 0, 0, DM, nullptr, nullptr};
            gemm_phase<EpiAct, DenseOrder, true, false>(lds, DM, S, E); }
        }
        SEAM(0); }

    if (IN(1)) {
        _Pragma("unroll") for (int rep = 0; rep < REPS(1); ++rep)
        { DenseOrder S; S.init(ws + WS_XN, ws + WS_WIN, MTOK, 2048, DM / 2, G, bx);
          EpiAct E{(bf16*)(ws + WS_LIN), SLOT_ELEMS, 0, DM, (const float*)(ws + WS_XS), (const float*)(ws + WS_WSC)};
          gemm_phase<EpiAct, DenseOrder, true, false, true>(lds, DM / 2, S, E); }
        SEAM(1);
#ifdef PROBE_BARRIERS
        for (int q_ = 0; q_ < 8; ++q_) xcd_barrier(bar);
#endif
    }
    if (IN(2)) {
        headnorm128_phase((const bf16*)(ws + WS_KVC), (bf16*)(ws + WS_KVC), DM, MEMROWS, (const float*)args.in[I_CK_NORM], 1.0f, gw, NGW, lane);
        _Pragma("unroll") for (int rep = 0; rep < REPS(2); ++rep) lru_phase(args, lds, vcu, G);
        SEAM(2);
    }
    if (IN(3)) {
        _Pragma("unroll") for (int rep = 0; rep < REPS(3); ++rep) {
        DenseOrder S; S.init(ws + WS_XN, ws + WS_WIN + (size_t)2048 * DM, MTOK, 5120, DM / 2, G, bx);
        EpiQKV E{(bf16*)(ws + WS_Q), SLOT_ELEMS, (const float*)(ws + WS_XS), (const float*)(ws + WS_WSC) + 2048, (const float*)args.in[I_Q_NORM], (const float*)args.in[I_K_NORM], (const float*)(ws + WS_ROPE), 0.125f * LOG2E, ws + WS_SG8};
        gemm_phase<EpiQKV, DenseOrder, true, false, true>(lds, DM / 2, S, E); }
        if (IN(3) && IN(5)) xcd_barrier(bar);
    }
    if (IN(5)) { diffattn_phase(args, lds, vcu, G, (bf16*)(ws + WS_Q), (bf16*)dmyA, REPS(5)); SEAM(5); }
    if (IN(7)) {
        _Pragma("unroll") for (int rep = 0; rep < REPS(7); ++rep) {
        PairOrder S; S.nM = MTOK / 256; S.nN = DM / 256; S.ntile = S.nM * S.nN; S.G = G; S.c = bx; S.tstep = (size_t)256 * DM * 2;
        S.A0 = (const char*)(ws + WS_U); S.B0 = (const char*)(ws + WS_WLRUO); S.A1 = (const char*)(ws + WS_Q); S.B1 = (const char*)(ws + WS_WATTNO);
        EpiMix E{ws + WS_SG8, ws + WS_SG8 + (size_t)MTOK * DM, (bf16*)(ws + WS_MIX)};
        gemm_phase<EpiMix, PairOrder, true, false, false, true>(lds, DM, S, E); }
        SEAM(7);
    }
    if (IN(8)) {
        _Pragma("unroll") for (int rep = 0; rep < REPS(8); ++rep) {
        DenseOrder S; S.init(ws + WS_MIX, ws + WS_WOUT, MTOK, DM, DM, G, bx);
        EpiResid<true> E{args.in[I_X], (bf16*)(ws + WS_X1B), (float*)(ws + WS_RSS1), nullptr};
        gemm_phase<EpiResid<true>, DenseOrder, true, false>(lds, DM, S, E); }
        SEAM(8);
    }
    if (IN(9)) {
        _Pragma("unroll") for (int rep = 0; rep < REPS(9); ++rep) {
        DenseOrder S; S.init(ws + WS_X1B, ws + WS_WCQ, MTOK, 512, DM, G, bx);
        EpiRowScale E{(bf16*)(ws + WS_QC), 512, (const float*)(ws + WS_RSS1)};
        gemm_phase<EpiRowScale, DenseOrder, true, false>(lds, DM, S, E); }
        if (IN(9) && IN(11)) xcd_barrier(bar);
    }
    if (IN(11)) { _Pragma("unroll") for (int rep = 0; rep < REPS(11); ++rep) crossattn_phase(args, lds, vcu, G); SEAM(11); }
    if (IN(12)) {
        _Pragma("unroll") for (int rep = 0; rep < REPS(12); ++rep) {
        DenseOrder S; S.init(ws + WS_OC, ws + WS_WCO, MTOK, DM, 512, G, bx);
        EpiResid<false> E{ws + WS_X1B, (bf16*)(ws + WS_X2B), (float*)(ws + WS_RSS2), (float*)(ws + WS_RSS1)};
        gemm_phase<EpiResid<false>, DenseOrder, true, false>(lds, 512, S, E); }
        SEAM(12);
    }
    if (IN(13)) {
        DenseOrder S; S.init(ws + WS_X2B, ws + WS_WRT, MTOK, 256, DM, G, bx);
        EpiLogit E{(float*)(ws + WS_LOGIT)};
        gemm_phase<EpiLogit, DenseOrder, true, false>(lds, DM, S, E);
        router_select(args, lds, S);
        SEAM(13);
    }
    if (IN(14)) {
        moe_tables(args, pblk, cntl);
        _Pragma("unroll") for (int rep = 0; rep < REPS(14); ++rep) {
        MoeOrder S{pblk, cntl, 0, 0, G, bx, DM / 2, 1, (const char*)(ws + WS_X2Q), (const char*)(ws + WS_WGU), (size_t)1024 * DM, (const int*)(ws + WS_IDX), 0};
        S.rb_hi = pblk[64];
        EpiGateUp E{(bf16*)(ws + WS_H), (const float*)(ws + WS_RSTD2), (const float*)(ws + WS_XS2), (const float*)(ws + WS_WSC2)};
        gemm_phase<EpiGateUp, MoeOrder, true, true, true>(lds, DM / 2, S, E); }
        SEAM(14);
    }
    if (IN(15)) {
        moe_tables(args, pblk, cntl);
        _Pragma("unroll") for (int rep = 0; rep < REPS(15); ++rep) {
        MoeOrder S{pblk, cntl, 0, 0, G, bx, EFF, 0, (const char*)(ws + WS_H), (const char*)(ws + WS_WDN), (size_t)DM * EFF * 2, (const int*)(ws + WS_IDX), 0};
        S.rb_lo = pblk[0]; S.rb_hi = pblk[64];
        EpiY E{(bf16*)(ws + WS_S0), (bf16*)(ws + WS_S4)};
        gemm_phase<EpiY, MoeOrder, true, false>(lds, EFF, S, E); }
        SEAM(15);
    }
    if (IN(16)) {
        moe_tables(args, pblk, cntl);
        _Pragma("unroll") for (int rep = 0; rep < REPS(16); ++rep) moe_combine_phase(args, cntl + 64, gw, NGW, lane);
    }
#undef REPS
#undef IN
#undef SEAM
}

#ifndef MK_CUTS
#define MK_CUTS 1
#endif
extern "C" void kernel_launch(void* const* d_in, const int* in_sizes, int n_in, void* d_out, int out_size, void* d_ws, size_t ws_size, hipStream_t stream) {
    static int grid = 0;
    if (grid == 0) {
        if (n_in != 36 || out_size != MTOK * DM || ws_size < WS_END) { fprintf(stderr, "kernel_launch: unexpected shapes / workspace (n_in %d out %d ws %zu, need %zu)\n", n_in, out_size, ws_size, (size_t)WS_END); grid = -1; return; }
        int dev = 0, cus = 0, per_cu = 0;
        if (hipGetDevice(&dev) != hipSuccess || hipDeviceGetAttribute(&cus, hipDeviceAttributeMultiprocessorCount, dev) != hipSuccess) { grid = -1; return; }
        if (hipFuncSetAttribute((const void*)fwd_kernel, hipFuncAttributeMaxDynamicSharedMemorySize, LDS_BYTES) != hipSuccess) { fprintf(stderr, "kernel_launch: hipFuncSetAttribute failed\n"); grid = -1; return; }
        if (hipOccupancyMaxActiveBlocksPerMultiprocessor(&per_cu, (const void*)fwd_kernel, NWAVES * 64, LDS_BYTES) != hipSuccess || per_cu < 1) { fprintf(stderr, "kernel_launch: occupancy query says %d blocks per CU\n", per_cu); }
        (void)hipGetLastError();
        grid = cus;
    }
    if (grid < 0) return;
    (void)hipMemsetAsync((char*)d_ws + WS_CTL, 0, CTL_ZERO_BYTES, stream);
    Args a{};
    for (int i = 0; i < 36; ++i) a.in[i] = d_in[i];
    a.out = (float*)d_out; a.ws = (unsigned char*)d_ws;
    constexpr int NL = MK_CUTS;
    for (int li = 0; li < NL; ++li) {
        a.ph_lo = (li * N_PHASES) / NL; a.ph_hi = ((li + 1) * N_PHASES) / NL; a.li = li;
        hipLaunchKernelGGL(fwd_kernel, dim3(grid), dim3(NWAVES * 64), LDS_BYTES, stream, a);
    }
}
```
